# Optimizing an MI355X kernel written in HIP

```python
import math
import jax
import jax.numpy as jnp
from jax import lax
import numpy as np

D_MODEL = 1024
BATCH = 4
SEQ = 8192
DEPTH = 2

D_MIX = D_MODEL
DIFF_HEADS = 4
DIFF_HD = 32
DIL_HEADS = 4
DIL_HD = 64
DIL_PATTERNS = ((128, 1), (512, 4), (2048, 16))
MLA_HEADS = 4
MLA_Q_LORA = 384
MLA_KV_LORA = 128
MLA_NOPE = 64
MLA_ROPE = 32
MLA_V = 64
ROPE_THETA = 10000.0
SWA_HEADS = 4
SWA_KV_HEADS = 2
SWA_HD = 64
SWA_WINDOW = 128
Q_BLOCK = 128
BAND_BLOCK = 128
D_FF = 2816
N_EXPERTS = 8
TOP_K = 2
D_FF_EXPERT = 3584
MOE_BLOCK = 256
RMS_EPS = 1e-6
NEG_INF = -1e30
N_ALIBI = DIFF_HEADS + DIL_HEADS + SWA_HEADS

IN_WIDTHS = (
    DIFF_HEADS * 2 * DIFF_HD, DIFF_HEADS * 2 * DIFF_HD, DIFF_HEADS * 2 * DIFF_HD,
    DIL_HEADS * DIL_HD, DIL_HEADS * DIL_HD, DIL_HEADS * DIL_HD,
    MLA_Q_LORA, MLA_KV_LORA, MLA_ROPE,
    SWA_HEADS * SWA_HD, SWA_KV_HEADS * SWA_HD, SWA_KV_HEADS * SWA_HD,
)
IN_COLS = 2592

kernel_name = 'hybrid_parallel_heads_diff_dilated_mla_swa_moe'


def _rmsnorm(x, g):
    xf = x.astype(jnp.float32)
    y = xf * lax.rsqrt(jnp.mean(xf * xf, axis=-1, keepdims=True) + RMS_EPS)
    return (y * g.astype(jnp.float32)).astype(x.dtype)


def _alibi_slopes():
    s = 2.0 ** (-8.0 * (np.arange(N_ALIBI) + 1) / N_ALIBI)
    f = lambda a: jnp.asarray(a, dtype=jnp.float32)
    return f(s[0::3]), f(s[1::3]), f(s[2::3])


def _split_heads(t, n, dh):
    b, s = t.shape[:2]
    return t.reshape(b, s, n, dh).transpose(0, 2, 1, 3)


def _merge_heads(t):
    b, h, s, dh = t.shape
    return t.transpose(0, 2, 1, 3).reshape(b, s, h * dh)


def _to_query_blocks(t):
    b, h, s, dh = t.shape
    return t.reshape(b, h, s // Q_BLOCK, Q_BLOCK, dh).transpose(2, 0, 1, 3, 4)


def _from_query_blocks(t):
    nb, b, h, qb, dh = t.shape
    return t.transpose(1, 2, 0, 3, 4).reshape(b, h, nb * qb, dh)


def _causal_block_probs(q_blk, k, q_start, scale, slopes):
    s = jnp.einsum('bhqd,bhkd->bhqk', q_blk, k).astype(jnp.float32) * scale
    dist = (q_start + jnp.arange(q_blk.shape[2]))[:, None] - jnp.arange(k.shape[2])[None, :]
    if slopes is not None:
        s = s - slopes[:, None, None] * dist.astype(jnp.float32)
    s = jnp.where(dist >= 0, s, NEG_INF)
    return jax.nn.softmax(s, axis=-1)


def _diff_attention(q1, q2, k1, k2, v, lam, slopes):
    scale = DIFF_HD ** -0.5
    nb = q1.shape[2] // Q_BLOCK

    def body(args):
        qa, qb, i = args
        start = i * Q_BLOCK
        p = (_causal_block_probs(qa, k1, start, scale, slopes)
             - lam * _causal_block_probs(qb, k2, start, scale, slopes))
        return jnp.einsum('bhqk,bhkd->bhqd', p.astype(v.dtype), v)

    o = lax.map(body, (_to_query_blocks(q1), _to_query_blocks(q2), jnp.arange(nb)))
    return _from_query_blocks(o)


def _dense_causal_attention(q, k, v, scale):
    nb = q.shape[2] // Q_BLOCK

    def body(args):
        qb, i = args
        p = _causal_block_probs(qb, k, i * Q_BLOCK, scale, None)
        return jnp.einsum('bhqk,bhkd->bhqd', p.astype(v.dtype), v)

    o = lax.map(body, (_to_query_blocks(q), jnp.arange(nb)))
    return _from_query_blocks(o)


def _banded_attention(q, k, v, max_dist, dist_unit, slopes, sinks):
    bn, g, r, n, dh = q.shape
    L = BAND_BLOCK
    pad = (-n) % L
    if pad:
        q = jnp.pad(q, ((0, 0), (0, 0), (0, 0), (0, pad), (0, 0)))
        k = jnp.pad(k, ((0, 0), (0, 0), (0, pad), (0, 0)))
        v = jnp.pad(v, ((0, 0), (0, 0), (0, pad), (0, 0)))
    npad = n + pad
    nb = npad // L
    qb = q.reshape(bn, g, r, nb, L, dh)

    def band(t):
        tb = t.reshape(bn, g, nb, L, dh)
        prev = jnp.pad(tb, ((0, 0), (0, 0), (1, 0), (0, 0), (0, 0)))[:, :, :nb]
        return jnp.concatenate([prev, tb], axis=3)

    kk, vv = band(k), band(v)
    s = jnp.einsum('bgrnqd,bgnkd->bgrnqk', qb, kk).astype(jnp.float32) * (dh ** -0.5)
    dist = jnp.arange(L)[:, None] + L - jnp.arange(2 * L)[None, :]
    k_pos = jnp.arange(nb)[:, None, None] * L + jnp.arange(2 * L)[None, None, :] - L
    valid = (dist >= 0) & (dist <= max_dist) & (k_pos >= 0)
    if slopes is not None:
        s = s - slopes[None, :, :, None, None, None] * (dist * dist_unit).astype(jnp.float32)
    s = jnp.where(valid, s, NEG_INF)
    m = jnp.max(s, axis=-1)
    if sinks is not None:
        sk = sinks.astype(jnp.float32)[None, :, :, None, None]
        m = jnp.maximum(m, sk)
    p = jnp.exp(s - m[..., None])
    denom = jnp.sum(p, axis=-1)
    if sinks is not None:
        denom = denom + jnp.exp(sk - m)
    o = jnp.einsum('bgrnqk,bgnkd->bgrnqd', p.astype(vv.dtype), vv)
    o = (o.astype(jnp.float32) / denom[..., None]).astype(v.dtype)
    lse = m + jnp.log(denom)
    o = o.reshape(bn, g, r, npad, dh)[:, :, :, :n]
    lse = lse.reshape(bn, g, r, npad)[..., :n]
    return o, lse


def _to_strided(t, d):
    b, h, s, dh = t.shape
    return t.reshape(b, h, s // d, d, dh).transpose(0, 3, 1, 2, 4).reshape(b * d, h, s // d, dh)


def _from_strided(t, d, b):
    _, h, n, dh = t.shape
    return t.reshape(b, d, h, n, dh).transpose(0, 2, 3, 1, 4).reshape(b, h, n * d, dh)


def _dilated_attention(q, k, v, slopes):
    bn = q.shape[0]
    outs, lses = [], []
    for window, d in DIL_PATTERNS:
        qs, ks, vs = _to_strided(q, d), _to_strided(k, d), _to_strided(v, d)
        o, lse = _banded_attention(qs[:, :, None], ks, vs, window // d, d, slopes[:, None], None)
        outs.append(_from_strided(o[:, :, 0], d, bn))
        lses.append(_from_strided(lse[:, :, 0][..., None], d, bn)[..., 0])
    w = jax.nn.softmax(jnp.stack(lses), axis=0)
    return jnp.einsum('gbhs,gbhsd->bhsd', w.astype(q.dtype), jnp.stack(outs))


def _rope_tables(s, dtype):
    inv = ROPE_THETA ** (-jnp.arange(0, MLA_ROPE, 2, dtype=jnp.float32) / MLA_ROPE)
    ang = jnp.arange(s, dtype=jnp.float32)[:, None] * inv[None, :]
    return jnp.cos(ang).astype(dtype), jnp.sin(ang).astype(dtype)


def _rope(t, cos, sin):
    half = MLA_ROPE // 2
    t1, t2 = t[..., :half], t[..., half:]
    return jnp.concatenate([t1 * cos - t2 * sin, t2 * cos + t1 * sin], axis=-1)


def _diff_mixer(qa, ka, va, lam_params, subln, layer_idx, slopes):
    bn, s, _ = qa.shape
    q12 = qa.reshape(bn, s, DIFF_HEADS, 2, DIFF_HD).transpose(3, 0, 2, 1, 4)
    k12 = ka.reshape(bn, s, DIFF_HEADS, 2, DIFF_HD).transpose(3, 0, 2, 1, 4)
    v = _split_heads(va, DIFF_HEADS, 2 * DIFF_HD)
    lam_init = 0.8 - 0.6 * math.exp(-0.3 * layer_idx)
    lp = lam_params.astype(jnp.float32)
    lam = jnp.exp(jnp.sum(lp[0] * lp[1])) - jnp.exp(jnp.sum(lp[2] * lp[3])) + lam_init
    o = _diff_attention(q12[0], q12[1], k12[0], k12[1], v, lam, slopes)
    o = _rmsnorm(o, subln) * (1.0 - lam_init)
    return _merge_heads(o)


def _dilated_mixer(qb, kb, vb, slopes):
    q = _split_heads(qb, DIL_HEADS, DIL_HD)
    k = _split_heads(kb, DIL_HEADS, DIL_HD)
    v = _split_heads(vb, DIL_HEADS, DIL_HD)
    return _merge_heads(_dilated_attention(q, k, v, slopes))


def _mla_mixer(cq, ckv, kpe, q_norm, w_uq, kv_norm, w_ukv):
    bn, s, _ = cq.shape
    q = _split_heads(_rmsnorm(cq, q_norm) @ w_uq, MLA_HEADS, MLA_NOPE + MLA_ROPE)
    kv = _split_heads(_rmsnorm(ckv, kv_norm) @ w_ukv, MLA_HEADS, MLA_NOPE + MLA_V)
    cos, sin = _rope_tables(s, cq.dtype)
    q = jnp.concatenate([q[..., :MLA_NOPE], _rope(q[..., MLA_NOPE:], cos, sin)], axis=-1)
    k_pe = jnp.broadcast_to(_rope(kpe[:, None], cos, sin), (bn, MLA_HEADS, s, MLA_ROPE))
    k = jnp.concatenate([kv[..., :MLA_NOPE], k_pe], axis=-1)
    v = kv[..., MLA_NOPE:]
    return _merge_heads(_dense_causal_attention(q, k, v, (MLA_NOPE + MLA_ROPE) ** -0.5))


def _swa_mixer(qd, kd, vd, sinks, slopes):
    bn, s, _ = qd.shape
    rep = SWA_HEADS // SWA_KV_HEADS
    q = qd.reshape(bn, s, SWA_KV_HEADS, rep, SWA_HD).transpose(0, 2, 3, 1, 4)
    k = _split_heads(kd, SWA_KV_HEADS, SWA_HD)
    v = _split_heads(vd, SWA_KV_HEADS, SWA_HD)
    o, _ = _banded_attention(q, k, v, SWA_WINDOW - 1, 1,
                             slopes.reshape(SWA_KV_HEADS, rep), sinks.reshape(SWA_KV_HEADS, rep))
    return o.transpose(0, 3, 1, 2, 4).reshape(bn, s, SWA_HEADS * SWA_HD)


def _swiglu(h, w1, w3, w2):
    return (jax.nn.silu(h @ w1) * (h @ w3)) @ w2


def _moe_swiglu(h, router, w1, w3, w2):
    bn, s, d = h.shape
    t = bn * s
    xt = h.reshape(t, d)
    logits = (xt @ router).astype(jnp.float32)
    top_v, top_i = lax.top_k(logits, TOP_K)
    gates = jax.nn.softmax(top_v, axis=-1)
    a = t * TOP_K
    e_flat = top_i.reshape(a)
    tok_flat = jnp.repeat(jnp.arange(t, dtype=jnp.int32), TOP_K)
    g_flat = gates.reshape(a)
    order = jnp.argsort(e_flat)
    e_s, tok_s, g_s = e_flat[order], tok_flat[order], g_flat[order]
    counts = jnp.bincount(e_flat, length=N_EXPERTS)
    starts = jnp.cumsum(counts) - counts
    padded = (counts + MOE_BLOCK - 1) // MOE_BLOCK * MOE_BLOCK
    pends = jnp.cumsum(padded)
    pstarts = pends - padded
    dest = pstarts[e_s] + jnp.arange(a) - starts[e_s]
    nb = -(-a // MOE_BLOCK) + N_EXPERTS
    rows = nb * MOE_BLOCK
    row_tok = jnp.zeros((rows,), jnp.int32).at[dest].set(tok_s)
    row_gate = jnp.zeros((rows,), jnp.float32).at[dest].set(g_s)
    blk_expert = jnp.clip(jnp.searchsorted(pends, jnp.arange(nb) * MOE_BLOCK, side='right'), 0, N_EXPERTS - 1)

    def body(args):
        tok, g, e = args
        xb = xt[tok]
        y = (jax.nn.silu(xb @ w1[e]) * (xb @ w3[e])) @ w2[e]
        return y * g[:, None].astype(y.dtype)

    ys = lax.map(body, (row_tok.reshape(nb, MOE_BLOCK), row_gate.reshape(nb, MOE_BLOCK), blk_expert))
    out = jnp.zeros((t, d), h.dtype).at[row_tok].add(ys.reshape(rows, d).astype(h.dtype))
    return out.reshape(bn, s, d)


def setup_inputs(seed: int = 0) -> dict:
    key = jax.random.key(seed)
    ks = jax.random.split(key, 24)
    n_dense = (DEPTH + 1) // 2
    n_moe = DEPTH // 2
    nrm = lambda k, shape, sc: jax.random.normal(k, shape, jnp.float32) * sc
    gain = lambda k, shape: 1.0 + 0.02 * jax.random.normal(k, shape, jnp.float32)
    return {
        'x': nrm(ks[0], (BATCH, SEQ, D_MODEL), 1.0),
        'attn_norm': gain(ks[1], (DEPTH, D_MODEL)),
        'w_in': nrm(ks[2], (DEPTH, D_MODEL, IN_COLS), D_MODEL ** -0.5),
        'w_out': nrm(ks[3], (DEPTH, D_MIX, D_MODEL), D_MIX ** -0.5),
        'diff_lambda': nrm(ks[4], (DEPTH, 4, DIFF_HD), 0.1),
        'diff_subln': gain(ks[5], (DEPTH, 2 * DIFF_HD)),
        'mla_q_norm': gain(ks[6], (DEPTH, MLA_Q_LORA)),
        'mla_w_uq': nrm(ks[7], (DEPTH, MLA_Q_LORA, MLA_HEADS * (MLA_NOPE + MLA_ROPE)), MLA_Q_LORA ** -0.5),
        'mla_kv_norm': gain(ks[8], (DEPTH, MLA_KV_LORA)),
        'mla_w_ukv': nrm(ks[9], (DEPTH, MLA_KV_LORA, MLA_HEADS * (MLA_NOPE + MLA_V)), MLA_KV_LORA ** -0.5),
        'swa_sinks': nrm(ks[10], (DEPTH, SWA_HEADS), 0.5),
        'ffn_norm': gain(ks[11], (DEPTH, D_MODEL)),
        'ffn_w1': nrm(ks[12], (n_dense, D_MODEL, D_FF), D_MODEL ** -0.5),
        'ffn_w3': nrm(ks[13], (n_dense, D_MODEL, D_FF), D_MODEL ** -0.5),
        'ffn_w2': nrm(ks[14], (n_dense, D_FF, D_MODEL), D_FF ** -0.5),
        'moe_router': nrm(ks[15], (n_moe, D_MODEL, N_EXPERTS), D_MODEL ** -0.5),
        'moe_w1': nrm(ks[16], (n_moe, N_EXPERTS, D_MODEL, D_FF_EXPERT), D_MODEL ** -0.5),
        'moe_w3': nrm(ks[17], (n_moe, N_EXPERTS, D_MODEL, D_FF_EXPERT), D_MODEL ** -0.5),
        'moe_w2': nrm(ks[18], (n_moe, N_EXPERTS, D_FF_EXPERT, D_MODEL), D_FF_EXPERT ** -0.5),
        'final_norm': gain(ks[19], (D_MODEL,)),
    }


def reference(x, attn_norm, w_in, w_out, diff_lambda, diff_subln, mla_q_norm, mla_w_uq, mla_kv_norm,
              mla_w_ukv, swa_sinks, ffn_norm, ffn_w1, ffn_w3, ffn_w2, moe_router, moe_w1, moe_w3, moe_w2,
              final_norm):
    slopes_a, slopes_b, slopes_d = _alibi_slopes()
    split_points = [int(c) for c in np.cumsum(IN_WIDTHS)[:-1]]
    for l in range(DEPTH):
        h = _rmsnorm(x, attn_norm[l])
        (qa, ka, va, qb, kb, vb, cq, ckv, kpe, qd, kd, vd) = jnp.split(h @ w_in[l], split_points, axis=-1)
        o_a = _diff_mixer(qa, ka, va, diff_lambda[l], diff_subln[l], l, slopes_a)
        o_b = _dilated_mixer(qb, kb, vb, slopes_b)
        o_c = _mla_mixer(cq, ckv, kpe, mla_q_norm[l], mla_w_uq[l], mla_kv_norm[l], mla_w_ukv[l])
        o_d = _swa_mixer(qd, kd, vd, swa_sinks[l], slopes_d)
        x = x + jnp.concatenate([o_a, o_b, o_c, o_d], axis=-1) @ w_out[l]
        h2 = _rmsnorm(x, ffn_norm[l])
        if l % 2 == 0:
            j = l // 2
            x = x + _swiglu(h2, ffn_w1[j], ffn_w3[j], ffn_w2[j])
        else:
            j = l // 2
            x = x + _moe_swiglu(h2, moe_router[j], moe_w1[j], moe_w3[j], moe_w2[j])
    return _rmsnorm(x, final_norm)
```

```cpp
#include <hip/hip_runtime.h>
#include <hip/hip_bf16.h>
#include <cstdio>
#include <cstdint>
#include <cstddef>
#include <cmath>

namespace pg8 {
#define PG8_LAS __attribute__((address_space(3)))
typedef unsigned short bf16_t;
typedef short bf16x8 __attribute__((ext_vector_type(8)));
typedef float f32x4 __attribute__((ext_vector_type(4)));
typedef float f32x2 __attribute__((ext_vector_type(2)));
typedef unsigned u32x4 __attribute__((ext_vector_type(4)));
constexpr int BM = 256, BK = 64, HALF = 128, HTB = HALF * BK * 2  , STAGE_BYTES = 8 * HTB, NXCD = 8, WGM = 8;

__host__ __device__ __forceinline__ int lds_byte(int r, int c) { const int st = (r >> 4) * 2 + (c >> 5), rr = r & 15, cc = c & 31, ob = rr * 64 + cc * 2; return st * 1024 + (ob ^ (((ob >> 9) & 1) << 5)); }
__host__ __device__ __forceinline__ void stage_rc(int b, int& R, int& C) { const int st = b / 1024, sb = b % 1024, swz = sb ^ (((sb >> 9) & 1) << 5); R = (st >> 1) * 16 + swz / 64; C = (st & 1) * 32 + (swz % 64) / 2; }
__host__ __device__ __forceinline__ int perm32(int rho) { const int n = rho >> 4, i = rho & 15; return 8 * (i >> 2) + 4 * n + (i & 3); }

struct Unit { int pm, pn, pa; };
struct Gemm { const bf16_t* A; const bf16_t* Bt; int K, lda; const int* gidx; };

struct StaticOrder {
    int nM, nN, nwg, G, c, wgm;
    __host__ __device__ void init(int M, int N, int G_, int c_, int wgm_ = WGM) { nM = M / BM; nN = N / BM; nwg = nM * nN; G = G_; c = c_; wgm = wgm_; }
    __host__ __device__ bool next(int i, Unit& u) const {
        const long L = (long)i * G + c; if (L >= nwg) return false;
        int wgid = (int)L; { const int q = nwg / NXCD, r = nwg % NXCD, xcd = wgid % NXCD, off = wgid / NXCD; wgid = (xcd < r ? xcd * (q + 1) : r * (q + 1) + (xcd - r) * q) + off; }
        const int nig = wgm * nN, gid = wgid / nig, fm = gid * wgm, gsz = (nM - fm) < wgm ? (nM - fm) : wgm;
        u.pm = fm + ((wgid % nig) % gsz); u.pn = (wgid % nig) / gsz; u.pa = u.pm; return true;
    }
};

__device__ __forceinline__ unsigned cvt_pk_bf16(float lo, float hi) { unsigned r; asm volatile("v_cvt_pk_bf16_f32 %0, %1, %2" : "=v"(r) : "v"(lo), "v"(hi)); return r; }

__device__ __forceinline__ float rms_scale16(const float* ssq, int row) { const f32x4* p = (const f32x4*)(ssq + (size_t)row * 16); const f32x4 a = p[0], b = p[1], c = p[2], d = p[3];
    const float s = ((a[0] + a[1]) + (a[2] + a[3])) + ((b[0] + b[1]) + (b[2] + b[3])) + ((c[0] + c[1]) + (c[2] + c[3])) + ((d[0] + d[1]) + (d[2] + d[3])); return 1.0f / sqrtf(s * (1.0f / 1024.0f) + 1e-6f); }
struct RowScale { float r0, r1;
    __device__ __forceinline__ void init(const float* ssq, int unit_row0, int wr, int lane) { r0 = rms_scale16(ssq, unit_row0 + wr * 64 + lane); r1 = rms_scale16(ssq, unit_row0 + HALF + wr * 64 + lane); }
    __device__ __forceinline__ float get(int ai, int m, int fr) const { return __int_as_float(__builtin_amdgcn_ds_bpermute((m * 16 + fr) << 2, __float_as_int(ai ? r1 : r0))); } };
template <int OFF, int CNT> __device__ __forceinline__ float rms_part(const float* ssq, int row) { const float* p = ssq + (size_t)row * 16 + OFF; float s = 0.f;
#pragma unroll
    for (int i = 0; i < CNT; i += 4) { const f32x4 a = *(const f32x4*)(p + i); s += (a[0] + a[1]) + (a[2] + a[3]); }
    return 1.0f / sqrtf(s * (1.0f / (32.0f * CNT)) + 1e-6f); }
template <int OFF, int CNT> struct RowScaleP { float r0, r1;
    __device__ __forceinline__ void init(const float* ssq, int unit_row0, int wr, int lane) { r0 = rms_part<OFF, CNT>(ssq, unit_row0 + wr * 64 + lane); r1 = rms_part<OFF, CNT>(ssq, unit_row0 + HALF + wr * 64 + lane); }
    __device__ __forceinline__ float get(int ai, int m, int fr) const { return __int_as_float(__builtin_amdgcn_ds_bpermute((m * 16 + fr) << 2, __float_as_int(ai ? r1 : r0))); } };
struct EpiBf16Q {
    static constexpr bool PERM = true;
    bf16_t* O; int ldc; int ncols; const float* ssq; float* ssq2;
    __device__ __forceinline__ void operator()(const f32x4 (&acc)[2][2][4][2], const Unit& u, int wr, int wc, int fr, int fq) const {
        const int row0 = u.pm * BM + wr * 64 + fr; const int col0 = u.pn * BM + wc * 32 + 8 * fq; const int ln = fq * 16 + fr;
        const bool lat = (u.pn == 8 || u.pn == 9);
        RowScale R; if (ssq) R.init(ssq, u.pm * BM, wr, fq * 16 + fr);
#pragma unroll
        for (int ai = 0; ai < 2; ++ai)
#pragma unroll
            for (int m = 0; m < 4; ++m) { const int row = row0 + ai * HALF + m * 16; bf16_t* rowp = O + (size_t)row * ldc + col0; const float rs = ssq ? R.get(ai, m, fr) : 1.0f;
#pragma unroll
                for (int bj = 0; bj < 2; ++bj) { const f32x4 v0 = acc[ai][bj][m][0] * rs, v1 = acc[ai][bj][m][1] * rs;
                    u32x4 w; w.x = cvt_pk_bf16(v0[0], v0[1]); w.y = cvt_pk_bf16(v0[2], v0[3]); w.z = cvt_pk_bf16(v1[0], v1[1]); w.w = cvt_pk_bf16(v1[2], v1[3]);
                    if (col0 + bj * HALF < ncols) *(u32x4*)(rowp + bj * HALF) = w;
                    if (lat) { float ss = ((v0[0] * v0[0] + v0[1] * v0[1]) + (v0[2] * v0[2] + v0[3] * v0[3])) + ((v1[0] * v1[0] + v1[1] * v1[1]) + (v1[2] * v1[2] + v1[3] * v1[3]));
                        ss += __int_as_float(__builtin_amdgcn_ds_bpermute((ln ^ 16) << 2, __float_as_int(ss))); ss += __int_as_float(__builtin_amdgcn_ds_bpermute((ln ^ 32) << 2, __float_as_int(ss)));
                        if (fq == 0) ssq2[(size_t)row * 16 + (u.pn - 8) * 8 + bj * 4 + wc] = ss; } } }
    }
};
struct EpiBf16R {
    static constexpr bool PERM = true;
    bf16_t* O; const float* ssq2;
    __device__ __forceinline__ void operator()(const f32x4 (&acc)[2][2][4][2], const Unit& u, int wr, int wc, int fr, int fq) const {
        const int row0 = u.pm * BM + wr * 64 + fr; const int col0 = u.pn * BM + wc * 32 + 8 * fq;
        RowScaleP<0, 12> R; R.init(ssq2, u.pm * BM, wr, fq * 16 + fr);
#pragma unroll
        for (int ai = 0; ai < 2; ++ai)
#pragma unroll
            for (int m = 0; m < 4; ++m) { const int row = row0 + ai * HALF + m * 16; bf16_t* rowp = O + (size_t)row * 384 + col0; const float rs = R.get(ai, m, fr);
#pragma unroll
                for (int bj = 0; bj < 2; ++bj) { const f32x4 v0 = acc[ai][bj][m][0] * rs, v1 = acc[ai][bj][m][1] * rs;
                    u32x4 w; w.x = cvt_pk_bf16(v0[0], v0[1]); w.y = cvt_pk_bf16(v0[2], v0[3]); w.z = cvt_pk_bf16(v1[0], v1[1]); w.w = cvt_pk_bf16(v1[2], v1[3]);
                    if (col0 + bj * HALF < 384) *(u32x4*)(rowp + bj * HALF) = w; } }
    }
};
struct EpiBf16 {
    static constexpr bool PERM = true;
    bf16_t* O; int ldc; int ncols; int nt; float sc = 1.0f; const float* ssq = nullptr;
    __device__ __forceinline__ void operator()(const f32x4 (&acc)[2][2][4][2], const Unit& u, int wr, int wc, int fr, int fq) const {
        const int row0 = u.pm * BM + wr * 64 + fr; const int col0 = (nt ? u.pn % nt : u.pn) * BM + wc * 32 + 8 * fq;
        RowScale R; if (ssq) R.init(ssq, u.pm * BM, wr, fq * 16 + fr);
#pragma unroll
        for (int ai = 0; ai < 2; ++ai)
#pragma unroll
            for (int m = 0; m < 4; ++m) { const int row = row0 + ai * HALF + m * 16; bf16_t* rowp = O + (size_t)row * ldc + col0; const float rs = ssq ? sc * R.get(ai, m, fr) : sc;
#pragma unroll
                for (int bj = 0; bj < 2; ++bj) { const f32x4 v0 = acc[ai][bj][m][0] * rs, v1 = acc[ai][bj][m][1] * rs;
                    u32x4 w; w.x = cvt_pk_bf16(v0[0], v0[1]); w.y = cvt_pk_bf16(v0[2], v0[3]); w.z = cvt_pk_bf16(v1[0], v1[1]); w.w = cvt_pk_bf16(v1[2], v1[3]);
                    if (col0 + bj * HALF < ncols) *(u32x4*)(rowp + bj * HALF) = w; } }
    }
};
struct EpiBf16K {
    static constexpr bool PERM = true;
    bf16_t* O; unsigned* kmax; const float* ssq2;
    __device__ __forceinline__ void operator()(const f32x4 (&acc)[2][2][4][2], const Unit& u, int wr, int wc, int fr, int fq) const {
        const int row0 = u.pm * BM + wr * 64 + fr; const int col0 = u.pn * BM + wc * 32 + 8 * fq; const int ln = fq * 16 + fr;
        float mx0 = 0.f, mx1 = 0.f;
        RowScaleP<12, 4> R; R.init(ssq2, u.pm * BM, wr, ln);
#pragma unroll
        for (int ai = 0; ai < 2; ++ai)
#pragma unroll
            for (int m = 0; m < 4; ++m) { const int row = row0 + ai * HALF + m * 16; bf16_t* rowp = O + (size_t)row * 512 + col0; const float rs = R.get(ai, m, fr);
#pragma unroll
                for (int bj = 0; bj < 2; ++bj) { const f32x4 v0 = acc[ai][bj][m][0] * rs, v1 = acc[ai][bj][m][1] * rs;
                    u32x4 w; w.x = cvt_pk_bf16(v0[0], v0[1]); w.y = cvt_pk_bf16(v0[2], v0[3]); w.z = cvt_pk_bf16(v1[0], v1[1]); w.w = cvt_pk_bf16(v1[2], v1[3]);
                    *(u32x4*)(rowp + bj * HALF) = w;
                    if (wc < 2) { float ss = ((v0[0] * v0[0] + v0[1] * v0[1]) + (v0[2] * v0[2] + v0[3] * v0[3])) + ((v1[0] * v1[0] + v1[1] * v1[1]) + (v1[2] * v1[2] + v1[3] * v1[3]));
                        ss += __int_as_float(__builtin_amdgcn_ds_bpermute((ln ^ 16) << 2, __float_as_int(ss))); ss += __int_as_float(__builtin_amdgcn_ds_bpermute((ln ^ 32) << 2, __float_as_int(ss)));
                        if (bj == 0) mx0 = __builtin_fmaxf(mx0, ss); else mx1 = __builtin_fmaxf(mx1, ss); } } }
        if (wc < 2) {
#pragma unroll
            for (int o_ = 1; o_ < 16; o_ <<= 1) { mx0 = __builtin_fmaxf(mx0, __int_as_float(__builtin_amdgcn_ds_bpermute((ln ^ o_) << 2, __float_as_int(mx0)))); mx1 = __builtin_fmaxf(mx1, __int_as_float(__builtin_amdgcn_ds_bpermute((ln ^ o_) << 2, __float_as_int(mx1)))); }
            if (ln == 0) { unsigned* kp = kmax + (((u.pm * BM) >> 13) * 4 + 2 * u.pn) * 2 + wc;
                __hip_atomic_fetch_max(kp, __float_as_uint(mx0), __ATOMIC_RELAXED, __HIP_MEMORY_SCOPE_AGENT); __hip_atomic_fetch_max(kp + 2, __float_as_uint(mx1), __ATOMIC_RELAXED, __HIP_MEMORY_SCOPE_AGENT); } }
    }
};
struct EpiRope {
    static constexpr bool PERM = true;
    bf16_t* O; const f32x2* rope;
    __device__ __forceinline__ void operator()(const f32x4 (&acc)[2][2][4][2], const Unit& u, int wr, int wc, int fr, int fq) const {
        const int row0 = u.pm * BM + wr * 64 + fr; const int col0 = u.pn * BM + wc * 32 + 8 * fq;
#pragma unroll
        for (int bj = 0; bj < 2; ++bj) { const int col = col0 + bj * HALF; if (col >= 384) continue;
            const int dd = col % 96; const bool rp = dd >= 64; const int j0 = rp ? ((dd - 64) >> 1) : 0;
            const f32x2* rt0 = rope + (size_t)(row0 & 8191) * 16 + j0; bf16_t* op0 = O + (size_t)row0 * 384 + col;
#pragma unroll
            for (int ai = 0; ai < 2; ++ai)
#pragma unroll
                for (int m = 0; m < 4; ++m) { const int dr = ai * HALF + m * 16; f32x4 v0 = acc[ai][bj][m][0], v1 = acc[ai][bj][m][1];
                    { const f32x2* rt = rt0 + dr * 16; f32x2 c0 = rt[0], c1 = rt[1], c2 = rt[2], c3 = rt[3];
                        if (!rp) { c0 = (f32x2){1.f, 0.f}; c1 = c0; c2 = c0; c3 = c0; }
                        f32x4 a, b; a[0] = v0[0] * c0.x - v0[1] * c0.y; a[1] = v0[1] * c0.x + v0[0] * c0.y; a[2] = v0[2] * c1.x - v0[3] * c1.y; a[3] = v0[3] * c1.x + v0[2] * c1.y;
                        b[0] = v1[0] * c2.x - v1[1] * c2.y; b[1] = v1[1] * c2.x + v1[0] * c2.y; b[2] = v1[2] * c3.x - v1[3] * c3.y; b[3] = v1[3] * c3.x + v1[2] * c3.y; v0 = a; v1 = b; }
                    u32x4 w; w.x = cvt_pk_bf16(v0[0], v0[1]); w.y = cvt_pk_bf16(v0[2], v0[3]); w.z = cvt_pk_bf16(v1[0], v1[1]); w.w = cvt_pk_bf16(v1[2], v1[3]);
                    *(u32x4*)(op0 + (size_t)dr * 384) = w; asm volatile("" ::: "memory"); } }
    }
};
struct EpiResid {
    static constexpr bool PERM = true;
    const float* base; float* out; int ldc; bf16_t* xb = nullptr; float* ssq = nullptr; float sc = 1.0f; bool xb8 = false;
    __device__ __forceinline__ void operator()(const f32x4 (&acc)[2][2][4][2], const Unit& u, int wr, int wc, int fr, int fq) const {
        const int row0 = u.pm * BM + wr * 64 + fr; const int col0 = u.pn * BM + wc * 32 + 8 * fq;
#pragma unroll
        for (int ai = 0; ai < 2; ++ai)
#pragma unroll
            for (int mp = 0; mp < 4; mp += 2) {
                f32x4 bb[2][2][2];
#pragma unroll
                for (int mi = 0; mi < 2; ++mi) { const size_t off = (size_t)(row0 + ai * HALF + (mp + mi) * 16) * ldc + col0;
                    bb[mi][0][0] = *(const f32x4*)(base + off); bb[mi][0][1] = *(const f32x4*)(base + off + 4); bb[mi][1][0] = *(const f32x4*)(base + off + HALF); bb[mi][1][1] = *(const f32x4*)(base + off + HALF + 4); }
#pragma unroll
                for (int mi = 0; mi < 2; ++mi) { const int m = mp + mi; const int row = row0 + ai * HALF + m * 16; const size_t off = (size_t)row * ldc + col0; float ss = 0.f;
#pragma unroll
                    for (int bj = 0; bj < 2; ++bj) { const f32x4 b0 = bb[mi][bj][0], b1 = bb[mi][bj][1];
                        const f32x4 x0 = b0 + acc[ai][bj][m][0] * sc, x1 = b1 + acc[ai][bj][m][1] * sc;
                        *(f32x4*)(out + off + bj * HALF) = x0; *(f32x4*)(out + off + bj * HALF + 4) = x1;
                        if (xb) { if (xb8) { int w0 = __builtin_amdgcn_cvt_pk_fp8_f32(x0[0], x0[1], 0, false); w0 = __builtin_amdgcn_cvt_pk_fp8_f32(x0[2], x0[3], w0, true);
                                int w1 = __builtin_amdgcn_cvt_pk_fp8_f32(x1[0], x1[1], 0, false); w1 = __builtin_amdgcn_cvt_pk_fp8_f32(x1[2], x1[3], w1, true);
                                typedef int i32x2 __attribute__((ext_vector_type(2))); *(i32x2*)((char*)xb + off + bj * HALF) = (i32x2){w0, w1}; }
                            else { u32x4 w; w.x = cvt_pk_bf16(x0[0], x0[1]); w.y = cvt_pk_bf16(x0[2], x0[3]); w.z = cvt_pk_bf16(x1[0], x1[1]); w.w = cvt_pk_bf16(x1[2], x1[3]); *(u32x4*)(xb + off + bj * HALF) = w; }
                            ss += ((x0[0] * x0[0] + x0[1] * x0[1]) + (x0[2] * x0[2] + x0[3] * x0[3])) + ((x1[0] * x1[0] + x1[1] * x1[1]) + (x1[2] * x1[2] + x1[3] * x1[3])); } }
                    if (xb) { const int ln = fq * 16 + fr;
                        ss += __int_as_float(__builtin_amdgcn_ds_bpermute((ln ^ 16) << 2, __float_as_int(ss))); ss += __int_as_float(__builtin_amdgcn_ds_bpermute((ln ^ 32) << 2, __float_as_int(ss)));
                        if (fq == 0) ssq[(size_t)row * 16 + u.pn * 4 + wc] = ss; } }
                asm volatile("" ::: "memory"); }
    }
};
template <bool F8OUT> struct EpiSwigluT {
    static constexpr bool PERM = true;
    void* G; int ldc; int ntile; float sc; const float* ssq = nullptr;
    __device__ __forceinline__ void operator()(const f32x4 (&acc)[2][2][4][2], const Unit& u, int wr, int wc, int fr, int fq) const {
        const int row0 = u.pm * BM + wr * 64 + fr; const int col0 = (u.pn % ntile) * HALF + wc * 32 + 8 * fq;
        RowScale R; if (ssq) R.init(ssq, u.pm * BM, wr, fq * 16 + fr);
#pragma unroll
        for (int ai = 0; ai < 2; ++ai)
#pragma unroll
            for (int m = 0; m < 4; ++m) { float g[8]; const float rs = ssq ? sc * R.get(ai, m, fr) : sc;
#pragma unroll
                for (int n = 0; n < 2; ++n)
#pragma unroll
                    for (int e = 0; e < 4; ++e) { const float a = acc[ai][0][m][n][e] * rs, b = acc[ai][1][m][n][e] * rs;
                        const float s = __builtin_amdgcn_rcpf(1.0f + __builtin_amdgcn_exp2f(-1.4426950408889634f * a)); g[n * 4 + e] = a * s * b; }
                if constexpr (F8OUT) { int w0 = __builtin_amdgcn_cvt_pk_fp8_f32(g[0], g[1], 0, false); w0 = __builtin_amdgcn_cvt_pk_fp8_f32(g[2], g[3], w0, true);
                    int w1 = __builtin_amdgcn_cvt_pk_fp8_f32(g[4], g[5], 0, false); w1 = __builtin_amdgcn_cvt_pk_fp8_f32(g[6], g[7], w1, true);
                    typedef int i32x2 __attribute__((ext_vector_type(2)));
                    *(i32x2*)((char*)G + (size_t)(row0 + ai * HALF + m * 16) * ldc + col0) = (i32x2){w0, w1}; }
                else { u32x4 w; w.x = cvt_pk_bf16(g[0], g[1]); w.y = cvt_pk_bf16(g[2], g[3]); w.z = cvt_pk_bf16(g[4], g[5]); w.w = cvt_pk_bf16(g[6], g[7]);
                    *(u32x4*)((bf16_t*)G + (size_t)(row0 + ai * HALF + m * 16) * ldc + col0) = w; } }
    }
};
typedef EpiSwigluT<false> EpiSwiglu;
typedef EpiSwigluT<true> EpiSwiglu8;

__device__ __forceinline__ void glds_s(unsigned voff, const char* sbase, unsigned lds_dst) { unsigned keep;
    asm volatile("s_mov_b32 %0, m0\n\ts_mov_b32 m0, %3\n\ts_nop 0\n\tglobal_load_lds_dwordx4 %1, %2\n\ts_mov_b32 m0, %0" : "=&s"(keep) : "v"(voff), "s"(sbase), "s"(lds_dst) : "memory"); }
template <class Epi, class Sched, bool GATHER = false, bool FP8 = false>
__device__ __forceinline__ void gemm_phase(PG8_LAS unsigned char* lds, const Gemm g, const Sched& S, const Epi& E, const int wave_id) {
    int lane_; asm volatile("v_mbcnt_lo_u32_b32 %0, -1, 0\n\tv_mbcnt_hi_u32_b32 %0, -1, %0" : "=v"(lane_));
    const int wid = wave_id, lane = lane_, tid = wid * 64 + lane, wr = wid >> 2, wc = wid & 3, fr = lane & 15, fq = lane >> 4;
    const int K = g.K, nt = K / BK;
    Unit cur, nxt; int ui = 0;
    if (!S.next(0, cur)) return;
    unsigned offA[2][2], voffB[2];
#pragma unroll
    for (int i = 0; i < 2; ++i) { int R, C; stage_rc(tid * 16 + i * 8192, R, C); const int Rb = Epi::PERM ? ((R & ~31) + perm32(R & 31)) : R;
        voffB[i] = (unsigned)(Rb * K + C) * 2u;
#pragma unroll
        for (int h = 0; h < 2; ++h) {
            if constexpr (GATHER) { const int tok = g.gidx[h * HALF + R]; offA[h][i] = (unsigned)tok * (unsigned)(g.lda * 2) + (unsigned)C * 2u; }
            else offA[h][i] = (unsigned)((h * HALF + R) * g.lda + C) * 2u; } }
    if constexpr (GATHER) asm volatile("s_waitcnt vmcnt(0)" ::: "memory");
    const size_t kstep = (size_t)(BK * 2);
    const size_t hstep = (size_t)HALF * K * 2;
    const size_t tstepB = 2 * hstep, tstepA = (size_t)BM * g.lda * 2;
    const unsigned ldsw = (unsigned)wid * 1024u; const unsigned lds0 = (unsigned)(uintptr_t)lds;
    int scl1 = 0x7f7f7f7f; asm volatile("" : "+v"(scl1));
    const int aoff = lds_byte(wr * 64 + fr, fq * 8), boff = lds_byte(wc * 32 + fr, fq * 8);
#define PG8_SA(b, h) (((b) * 2 + (h)) * HTB)
#define PG8_SB(b, h) ((4 + (b) * 2 + (h)) * HTB)
#define PG8_STAGE(bufoff, gbase, voff) do { _Pragma("unroll") for (int _i = 0; _i < 2; ++_i) \
        glds_s((voff)[_i], (const char*)(gbase), lds0 + (unsigned)(bufoff) + ldsw + _i * 8192u); } while (0)
#define PG8_LDA(dst, b, h) do { if constexpr (FP8) { _Pragma("unroll") for (int m = 0; m < 4; ++m) { const i32x4 lo_ = *(const PG8_LAS i32x4*)(lds + PG8_SA(b, h) + aoff + m * 2048), hi_ = *(const PG8_LAS i32x4*)(lds + PG8_SA(b, h) + aoff + m * 2048 + 1024); \
        dst##8[m] = (i32x8){lo_[0], lo_[1], lo_[2], lo_[3], hi_[0], hi_[1], hi_[2], hi_[3]}; } } \
    else { _Pragma("unroll") for (int m = 0; m < 4; ++m) _Pragma("unroll") for (int k = 0; k < 2; ++k) dst[m][k] = *(const PG8_LAS bf16x8*)(lds + PG8_SA(b, h) + aoff + m * 2048 + k * 1024); } } while (0)
#define PG8_LDB(dst, b, h) do { if constexpr (FP8) { _Pragma("unroll") for (int n = 0; n < 2; ++n) { const i32x4 lo_ = *(const PG8_LAS i32x4*)(lds + PG8_SB(b, h) + boff + n * 2048), hi_ = *(const PG8_LAS i32x4*)(lds + PG8_SB(b, h) + boff + n * 2048 + 1024); \
        dst##8[n] = (i32x8){lo_[0], lo_[1], lo_[2], lo_[3], hi_[0], hi_[1], hi_[2], hi_[3]}; } } \
    else { _Pragma("unroll") for (int n = 0; n < 2; ++n) _Pragma("unroll") for (int k = 0; k < 2; ++k) dst[n][k] = *(const PG8_LAS bf16x8*)(lds + PG8_SB(b, h) + boff + n * 2048 + k * 1024); } } while (0)
#define PG8_MMA(ai, bj, At, Bt) do { __builtin_amdgcn_s_setprio(1); _Pragma("unroll") for (int m = 0; m < 4; ++m) _Pragma("unroll") for (int n = 0; n < 2; ++n) { \
        if constexpr (FP8) asm volatile("v_mfma_scale_f32_16x16x128_f8f6f4 %0, %1, %2, %0, %3, %3 op_sel_hi:[0,0,0]" : "+v"(acc[ai][bj][m][n]) : "v"(Bt##8[n]), "v"(At##8[m]), "v"(scl1));   \
        else { _Pragma("unroll") for (int k = 0; k < 2; ++k) acc[ai][bj][m][n] = __builtin_amdgcn_mfma_f32_16x16x32_bf16(Bt[n][k], At[m][k], acc[ai][bj][m][n], 0, 0, 0); } } \
        __builtin_amdgcn_s_setprio(0); } while (0)
#define PG8_WAIT_V(n) asm volatile("s_waitcnt vmcnt(" #n ")" ::: "memory")
#define PG8_WAIT_L(n) asm volatile("s_waitcnt lgkmcnt(" #n ")" ::: "memory")
#define PG8_BAR __builtin_amdgcn_s_barrier()
#define PG8_SCHED __builtin_amdgcn_sched_barrier(0)
    f32x4 acc[2][2][4][2];
#pragma unroll
    for (int a = 0; a < 2; ++a)
#pragma unroll
        for (int b = 0; b < 2; ++b)
#pragma unroll
            for (int m = 0; m < 4; ++m)
#pragma unroll
                for (int n = 0; n < 2; ++n) acc[a][b][m][n] = (f32x4){0.f, 0.f, 0.f, 0.f};
    typedef int i32x8 __attribute__((ext_vector_type(8))); typedef int i32x4 __attribute__((ext_vector_type(4)));
    const char* cA = (const char*)g.A + (size_t)cur.pa * tstepA; const char* cB = (const char*)g.Bt + (size_t)cur.pn * tstepB;
    PG8_STAGE(PG8_SB(0, 0), cB, voffB); PG8_STAGE(PG8_SB(0, 1), cB + hstep, voffB); PG8_STAGE(PG8_SA(0, 0), cA, offA[0]); PG8_STAGE(PG8_SA(0, 1), cA, offA[1]);
    if (wr == 1) PG8_BAR;
    PG8_WAIT_V(2); PG8_BAR;
    PG8_STAGE(PG8_SB(1, 0), cB + kstep, voffB); PG8_STAGE(PG8_SA(1, 0), cA + kstep, offA[0]); PG8_STAGE(PG8_SB(1, 1), cB + hstep + kstep, voffB);
    PG8_WAIT_V(6); PG8_BAR;
    for (;;) {
        const bool has_next = S.next(ui + 1, nxt);
        const char* nA = has_next ? (const char*)g.A + (size_t)nxt.pa * tstepA : cA; const char* nB = has_next ? (const char*)g.Bt + (size_t)nxt.pn * tstepB : cB;
#pragma unroll 1
        for (int t = 0; t < nt; t += 2) {
            const bool last = (t == nt - 2);
            bf16x8 At[4][2], B0[2][2], B1[2][2]; i32x8 At8[4], B08[2], B18[2];
            const char* a1 = cA + (size_t)(t + 1) * kstep;
            const char* a2 = last ? nA : cA + (size_t)(t + 2) * kstep; const char* b2 = last ? nB : cB + (size_t)(t + 2) * kstep;
            const char* a3 = a2 + kstep; const char* b3 = b2 + kstep;
            PG8_LDB(B0, 0, 0); PG8_LDB(B1, 0, 1); PG8_SCHED; PG8_LDA(At, 0, 0); PG8_STAGE(PG8_SA(1, 1), a1, offA[1]);
            PG8_WAIT_V(8); PG8_WAIT_L(0); PG8_BAR; PG8_MMA(0, 0, At, B0); PG8_MMA(0, 1, At, B1); PG8_BAR; PG8_SCHED;
            PG8_LDA(At, 0, 1); PG8_STAGE(PG8_SB(0, 0), b2, voffB); PG8_STAGE(PG8_SB(0, 1), b2 + hstep, voffB); PG8_STAGE(PG8_SA(0, 0), a2, offA[0]);
            PG8_WAIT_V(8); PG8_WAIT_L(0); PG8_BAR; PG8_MMA(1, 0, At, B0); PG8_MMA(1, 1, At, B1); PG8_BAR; PG8_SCHED;
            PG8_LDB(B0, 1, 0); PG8_LDB(B1, 1, 1); PG8_SCHED; PG8_LDA(At, 1, 0); PG8_STAGE(PG8_SA(0, 1), a2, offA[1]);
            PG8_WAIT_V(8); PG8_WAIT_L(0); PG8_BAR; PG8_MMA(0, 0, At, B0); PG8_MMA(0, 1, At, B1); PG8_BAR; PG8_SCHED;
            PG8_LDA(At, 1, 1); PG8_STAGE(PG8_SB(1, 0), b3, voffB); PG8_STAGE(PG8_SB(1, 1), b3 + hstep, voffB); PG8_STAGE(PG8_SA(1, 0), a3, offA[0]);
            PG8_WAIT_V(8); PG8_WAIT_L(0); PG8_BAR; PG8_MMA(1, 0, At, B0); PG8_MMA(1, 1, At, B1); PG8_BAR; PG8_SCHED;
        }
        if (wr == 0) PG8_BAR;
        if constexpr (FP8) asm volatile("s_nop 15\n\ts_nop 15\n\ts_nop 15\n\ts_nop 15" ::: "memory");
        { int l2_; asm volatile("v_mbcnt_lo_u32_b32 %0, -1, 0\n\tv_mbcnt_hi_u32_b32 %0, -1, %0" : "=v"(l2_)); E(acc, cur, wr, wc, l2_ & 15, l2_ >> 4); }
        if (!has_next) break;
#pragma unroll
        for (int a = 0; a < 2; ++a)
#pragma unroll
            for (int b = 0; b < 2; ++b)
#pragma unroll
                for (int m = 0; m < 4; ++m)
#pragma unroll
                    for (int n = 0; n < 2; ++n) acc[a][b][m][n] = (f32x4){0.f, 0.f, 0.f, 0.f};
        cur = nxt; cA = nA; cB = nB; ++ui;
        if (wr == 1) PG8_BAR;
    }
    PG8_WAIT_V(0);
    PG8_BAR;
#undef PG8_SA
#undef PG8_SB
#undef PG8_STAGE
#undef PG8_LDA
#undef PG8_LDB
#undef PG8_MMA
#undef PG8_WAIT_V
#undef PG8_WAIT_L
#undef PG8_BAR
#undef PG8_SCHED
}
}
namespace att {
using bf16_t = unsigned short;
using bf16x8 = __attribute__((ext_vector_type(8))) short;
using s16x4 = __attribute__((ext_vector_type(4))) short;
using f32x16 = __attribute__((ext_vector_type(16))) float;
using u32x4 = __attribute__((ext_vector_type(4))) unsigned;
typedef short v4i16_t __attribute__((ext_vector_type(4)));
typedef __attribute__((address_space(3))) const char* lds_cptr;
typedef float f32x2_t __attribute__((ext_vector_type(2))); typedef __bf16 bf16x2_t __attribute__((ext_vector_type(2)));
constexpr int NW = 8, QBLK = 32, QB = 256, KVBLK = 64;
constexpr int NSLOT = 3, KSLOT = 12288, VSLOT = 8192;
constexpr int LDS_K = 0, LDS_V = NSLOT * KSLOT, LDS_WS = LDS_V + NSLOT * VSLOT, LDS_OST = LDS_WS + NW * 64 * 4, LDS_BYTES = LDS_OST + NW * 4096;
constexpr float NEGBIG = -1.0e30f;
constexpr float THR = 8.0f;

__device__ __forceinline__ int crow(int r, int hi) { return (r & 3) + 8 * (r >> 2) + 4 * hi; }
__device__ __forceinline__ void glds16(const void* gsrc, unsigned lds_dst) { unsigned keep;
    asm volatile("s_mov_b32 %0, m0\n\ts_mov_b32 m0, %2\n\ts_nop 0\n\tglobal_load_lds_dwordx4 %1, off\n\ts_mov_b32 m0, %0" : "=&s"(keep) : "v"(gsrc), "s"(lds_dst) : "memory"); }
__device__ __forceinline__ unsigned cvtpk(float lo, float hi) { f32x2_t v = {lo, hi}; bf16x2_t b = __builtin_convertvector(v, bf16x2_t); return __builtin_bit_cast(unsigned, b); }
__device__ __forceinline__ s16x4 vtr(lds_cptr p) { return __builtin_bit_cast(s16x4, __builtin_amdgcn_ds_read_tr16_b64_v4i16((__attribute__((address_space(3))) v4i16_t*)p)); }
__device__ __forceinline__ float swapmax(float m) { auto rr = __builtin_amdgcn_permlane32_swap(__float_as_uint(m), __float_as_uint(m), false, false); return __builtin_fmaxf(__uint_as_float(rr[0]), __uint_as_float(rr[1])); }
__device__ __forceinline__ float swapadd(float m) { auto rr = __builtin_amdgcn_permlane32_swap(__float_as_uint(m), __float_as_uint(m), false, false); return __uint_as_float(rr[0]) + __uint_as_float(rr[1]); }
__device__ __forceinline__ float fadd_s(float a, float b) { float r; asm("v_add_f32_e32 %0, %1, %2" : "=v"(r) : "v"(a), "v"(b)); return r; }
__device__ __forceinline__ int lane_now() { int l; asm volatile("v_mbcnt_lo_u32_b32 %0, -1, 0\n\tv_mbcnt_hi_u32_b32 %0, -1, %0" : "=v"(l)); return l; }
#ifndef ATT_PAIR
#define ATT_PAIR 1
#endif
#ifndef ATT_SHV
#define ATT_SHV 1
#endif
#ifndef ATT_DEEP
#define ATT_DEEP 1
#endif
#ifndef ATT_SMAX
#define ATT_SMAX 1
#endif
#define XPB(n) (XP == (n) || (XP >= 100 && (((XP - 100) >> ((n) - 1)) & 1)))
#define ATT_WAIT_BAR(N) asm volatile("s_waitcnt vmcnt(" #N ") lgkmcnt(0)\n\ts_barrier" ::: "memory")

struct Job {
    const bf16_t* Q; int qs;
    const bf16_t* K0; int ks0;
    const bf16_t* K1; int ks1;
    const bf16_t* V; int vs;
    bf16_t* O; int os; long omap;
    float* LSE; int ls; long lmap;
    int q0, t_lo, t_hi, max_dist;
    float slope2, sink2;
    const f32x2_t* rope;
    float kmax2[2];
};

template <int NCH, int NMAP, bool ALIBI, int EPI, bool QROPE = false, bool TRUNC = false, int XP = 0, bool STAG = false>
__device__ __forceinline__ void attn_unit(const Job& J, char* shm, unsigned* qhead, volatile __attribute__((address_space(3))) unsigned* qslot, const int wave_id) {
    constexpr int NPK = 2 * NCH * NMAP;
    static_assert(!STAG || NMAP == 1, "STAG: single map");
    constexpr bool DEEP = (ATT_DEEP != 0) && !STAG;
    constexpr int AHEAD = DEEP ? 3 : 2;
    constexpr bool PAIR = DEEP && (ATT_PAIR != 0);
    constexpr int NS = (STAG || DEEP) ? 4 : 3, LDS_K = 0, LDS_V = NS * KSLOT, LDS_WS = LDS_V + NS * VSLOT, LDS_OST = LDS_WS + NW * 64 * 4;
    int lane_; asm volatile("v_mbcnt_lo_u32_b32 %0, -1, 0\n\tv_mbcnt_hi_u32_b32 %0, -1, %0" : "=v"(lane_));
    const int wid = wave_id, lane = lane_, tid = wid * 64 + lane, r32 = lane & 31, hi = lane >> 5;
    unsigned q_next = 0; if (tid == 0) q_next = __hip_atomic_fetch_add(qhead, 1u, __ATOMIC_RELAXED, __HIP_MEMORY_SCOPE_AGENT);
    const unsigned lds0 = (unsigned)(uintptr_t)shm;
    float* wsf = (float*)(shm + LDS_WS) + wid * 64;
    const unsigned koffA = (unsigned)(lane * J.ks0 + wid * 8) * 2u, koffB = (NPK > 8) ? (unsigned)(lane * J.ks1 + wid * 8) * 2u : 0u;
    const unsigned voff = (unsigned)((16 * (wid & 3) + (lane >> 2)) * J.vs + (wid >> 2) * 32 + (lane & 3) * 8) * 2u;
    const long kstepA = (long)KVBLK * J.ks0 * 2, kstepB = (NPK > 8) ? (long)KVBLK * J.ks1 * 2 : 0, vstep = (long)KVBLK * J.vs * 2;
    const unsigned kdst = lds0 + LDS_K + wid * 1024, vdst = lds0 + LDS_V + wid * 1024;
    const bool extraK = (NPK > 8) && (wid < NPK - 8);
#define ATT_DMA(t, slot) do { if (XPB(4)) break; pg8::glds_s(koffA, (const char*)J.K0 + (long)(t) * kstepA, kdst + (slot) * KSLOT); \
        if (extraK) pg8::glds_s(koffB, (const char*)J.K1 + (long)(t) * kstepB, kdst + (slot) * KSLOT + 8192); \
        pg8::glds_s(voff, (const char*)J.V + (long)(t) * vstep, vdst + (slot) * VSLOT); } while (0)
    const int qw = J.q0 + wid * QBLK;
    const int nq = qw + r32;
    if constexpr (!ALIBI) { if (J.t_lo < J.t_hi) ATT_DMA(J.t_lo, 0); if (J.t_lo + 1 < J.t_hi) ATT_DMA(J.t_lo + 1, 1); if (DEEP && !PAIR && J.t_lo + 2 < J.t_hi) ATT_DMA(J.t_lo + 2, 2); }
    bf16x8 qr[NMAP][NCH];
    { const bf16_t* qp = J.Q + (long)nq * J.qs + hi * 8;
#pragma unroll
      for (int m = 0; m < NMAP; ++m)
#pragma unroll
        for (int c = 0; c < NCH; ++c) qr[m][c] = *reinterpret_cast<const bf16x8*>(qp + (m * NCH + c) * 16); }
    if constexpr (QROPE) {
        const f32x2_t* rt = J.rope + (size_t)nq * 16 + hi * 4;
#pragma unroll
        for (int c = 0; c < 2; ++c) { bf16x8 q = qr[0][NCH - 2 + c]; bf16x8 r;
#pragma unroll
            for (int i = 0; i < 4; ++i) { const f32x2_t cs = rt[c * 8 + i]; const float a = __uint_as_float((unsigned)(unsigned short)q[2 * i] << 16), b = __uint_as_float((unsigned)(unsigned short)q[2 * i + 1] << 16);
                const unsigned w = cvtpk(a * cs.x - b * cs.y, b * cs.x + a * cs.y); r[2 * i] = (short)(w & 0xffffu); r[2 * i + 1] = (short)(w >> 16); }
            qr[0][NCH - 2 + c] = r; }
    }
    int t_lo = J.t_lo; const int t_hi = J.t_hi; int soft_dist = 1 << 28; float qk2row[NMAP]; bool stat = false;
    if constexpr (TRUNC) {
        float b2 = 0.f;
#pragma unroll
        for (int m = 0; m < NMAP; ++m) { float q2 = 0.f;
#pragma unroll
            for (int c = 0; c < NCH; ++c)
#pragma unroll
                for (int e = 0; e < 8; ++e) { const float x = __uint_as_float((unsigned)(unsigned short)qr[m][c][e] << 16); q2 += x * x; }
            q2 = swapadd(q2); qk2row[m] = q2 * J.kmax2[m];
#pragma unroll
            for (int o_ = 1; o_ < 32; o_ <<= 1) q2 = fmaxf(q2, __int_as_float(__builtin_amdgcn_ds_bpermute((lane ^ o_) << 2, __float_as_int(q2))));
            b2 = fmaxf(b2, q2 * J.kmax2[m]); }
        float* xq = (float*)(shm + LDS_OST);
        if (lane == 0) xq[wid] = b2;
        asm volatile("s_waitcnt lgkmcnt(0)\n\ts_barrier" ::: "memory");
        float bm = xq[0];
#pragma unroll
        for (int w_ = 1; w_ < NW; ++w_) bm = fmaxf(bm, xq[w_]);
        if constexpr (ALIBI) {
        const float bound = 2.02f * __builtin_sqrtf(bm) + 80.f;
        const float dmin = bound / J.slope2;
        soft_dist = __builtin_amdgcn_readfirstlane(dmin < 1.0e8f ? (int)dmin + 1 : (1 << 28));
        const int tl = (J.q0 - soft_dist) >> 6; t_lo = tl > t_lo ? tl : t_lo;
        }
        stat = ATT_SMAX && (1.01f * __builtin_sqrtf(bm) <= 50.f);
    }
    if constexpr (ALIBI) { if (t_lo < t_hi) ATT_DMA(t_lo, 0); if (t_lo + 1 < t_hi) ATT_DMA(t_lo + 1, 1); if (DEEP && !PAIR && t_lo + 2 < t_hi) ATT_DMA(t_lo + 2, 2); }
    if (!(t_lo < t_hi)) { __builtin_amdgcn_s_barrier(); if (tid == 0) *qslot = q_next; }
#ifndef ATT_SB
#define ATT_SB 1
#endif
#ifndef ATT_ONES
#define ATT_ONES 0
#endif
#ifndef ATT_HALF
#define ATT_HALF 0
#endif
    constexpr bool ONES = (NMAP == 1) && ATT_ONES;
    float mhat[NMAP], lsum[NMAP]; f32x16 o[NMAP][2]; f32x16 osum, negm;
    float zero_ = 0.f; asm volatile("" : "+v"(zero_));
#pragma unroll
    for (int m = 0; m < NMAP; ++m) { mhat[m] = -1000.f; lsum[m] = 0.f;
#pragma unroll
        for (int r = 0; r < 16; ++r) { o[m][0][r] = zero_; o[m][1][r] = zero_; } }
#pragma unroll
    for (int r = 0; r < 16; ++r) { osum[r] = zero_; negm[r] = 1000.f + zero_; }
    if constexpr (TRUNC) { if (stat) {
#pragma unroll
        for (int m = 0; m < NMAP; ++m) mhat[m] = 1.01f * __builtin_sqrtf(qk2row[m]);
        if (!ALIBI) {
#pragma unroll
            for (int r = 0; r < 16; ++r) negm[r] = -mhat[0]; } } }
    const bf16x8 ones = (bf16x8){0x3f80, 0x3f80, 0x3f80, 0x3f80, 0x3f80, 0x3f80, 0x3f80, 0x3f80};
    const lds_cptr shm3 = (lds_cptr)shm;
    const lds_cptr kp0 = shm3 + LDS_K + hi * 1024 + r32 * 16;
    const lds_cptr vp0 = shm3 + LDS_V + ((lane >> 4) & 1) * 32 + (lane & 3) * 8 + (4 * hi + ((lane & 15) >> 2)) * 64;
    int slot = 0; u32x4 ppw[4]; bool pend = false; const bool late = STAG && ((wid & 1) != 0);
    for (int t = t_lo; t < t_hi; ++t) {
        if constexpr (PAIR) {
            if (((t - t_lo) & 1) == 0) {
                ATT_WAIT_BAR(0);
                if (t == t_lo && tid == 0) *qslot = q_next;
                if (t + 2 < t_hi) ATT_DMA(t + 2, (slot + 2) & 3);
                if (t + 3 < t_hi) ATT_DMA(t + 3, (slot + 3) & 3); }
        } else {
        if (XPB(5)) { asm volatile("s_waitcnt vmcnt(3) lgkmcnt(0)" ::: "memory"); } else
        if (DEEP && t + 2 < t_hi) { if (extraK) ATT_WAIT_BAR(6); else ATT_WAIT_BAR(4); } else
        if (t + 1 < t_hi) { if (extraK) ATT_WAIT_BAR(3); else ATT_WAIT_BAR(2); } else ATT_WAIT_BAR(0);
        if (t == t_lo && tid == 0) *qslot = q_next;
        if (t + AHEAD < t_hi) { const int s2 = (slot + AHEAD >= NS) ? slot + AHEAD - NS : slot + AHEAD; ATT_DMA(t + AHEAD, s2); }
        }
        if constexpr (STAG) { if (pend) { const lds_cptr vq = vp0 + ((slot == 0) ? NS - 1 : slot - 1) * VSLOT;
#pragma unroll
            for (int d0 = 0; d0 < 2; ++d0) {
#pragma unroll
                for (int ks = 0; ks < 4; ++ks) { const s16x4 vl = vtr(vq + d0 * 4096 + ks * 1024), vh = vtr(vq + d0 * 4096 + ks * 1024 + 512);
                    const bf16x8 vf = (bf16x8){vl[0], vl[1], vl[2], vl[3], vh[0], vh[1], vh[2], vh[3]};
                    o[0][d0] = __builtin_amdgcn_mfma_f32_32x32x16_bf16(__builtin_bit_cast(bf16x8, ppw[ks]), vf, o[0][d0], 0, 0, 0); }
                __builtin_amdgcn_sched_barrier(0); }
            pend = false; } }
        const int k_lo = t * KVBLK;
        const int e0 = qw - (k_lo + 31), e1 = qw - (k_lo + 63);
        bool act0 = (k_lo <= qw + QBLK - 1) && (e0 <= J.max_dist) && (!TRUNC || e0 <= soft_dist);
        bool act1 = (k_lo + 32 <= qw + QBLK - 1) && (e1 <= J.max_dist) && (!TRUNC || e1 <= soft_dist);
        if (!XPB(8) && (act0 || act1)) {
            bool clean0 = (e0 >= 0) && (qw + QBLK - 1 - k_lo <= J.max_dist), clean1 = (e1 >= 0) && (qw + QBLK - 1 - (k_lo + 32) <= J.max_dist);
            if (!ATT_HALF) { clean0 = clean0 && act0; clean1 = clean1 && act1; act0 = true; act1 = true; }
            const int dq = nq - k_lo;
            const lds_cptr kp = kp0 + slot * KSLOT; const lds_cptr vp = vp0 + slot * VSLOT;
            u32x4 pwk[4];
#pragma unroll
            for (int m = 0; m < NMAP; ++m) {
                if (ATT_SB) __builtin_amdgcn_sched_barrier(0);
                u32x4 pw[4]; f32x16 p0, p1;
                if (ALIBI) { const float L = -mhat[m] - J.slope2 * (float)(dq - 4 * hi), L1 = L + 32.f * J.slope2;
#pragma unroll
                    for (int r = 0; r < 16; ++r) { float a_ = __builtin_fmaf(J.slope2, (float)crow(r, 0), L), b_ = __builtin_fmaf(J.slope2, (float)crow(r, 0), L1); asm("" : "+v"(a_)); asm("" : "+v"(b_)); p0[r] = a_; p1[r] = b_; } }
                else if (!(act0 && act1)) { p0 = negm; p1 = negm; }
                if (XPB(3)) { } else if (act0 && act1) {
#pragma unroll
                    for (int c = 0; c < NCH; ++c) {
                        const bf16x8 b0 = XPB(6) ? qr[m][(c + 1) % NCH] : *(const __attribute__((address_space(3))) bf16x8*)(kp + (m * NCH + c) * 2048);
                        const bf16x8 b1 = XPB(6) ? qr[m][(c + 2) % NCH] : *(const __attribute__((address_space(3))) bf16x8*)(kp + (m * NCH + c) * 2048 + 512);
                        if (!ALIBI && c == 0) { p0 = __builtin_amdgcn_mfma_f32_32x32x16_bf16(b0, qr[m][c], negm, 0, 0, 0); p1 = __builtin_amdgcn_mfma_f32_32x32x16_bf16(b1, qr[m][c], negm, 0, 0, 0); }
                        else { p0 = __builtin_amdgcn_mfma_f32_32x32x16_bf16(b0, qr[m][c], p0, 0, 0, 0);
                               p1 = __builtin_amdgcn_mfma_f32_32x32x16_bf16(b1, qr[m][c], p1, 0, 0, 0); } }
                } else if (act0) {
#pragma unroll
                    for (int c = 0; c < NCH; ++c) p0 = __builtin_amdgcn_mfma_f32_32x32x16_bf16(*(const __attribute__((address_space(3))) bf16x8*)(kp + (m * NCH + c) * 2048), qr[m][c], p0, 0, 0, 0);
                } else {
#pragma unroll
                    for (int c = 0; c < NCH; ++c) p1 = __builtin_amdgcn_mfma_f32_32x32x16_bf16(*(const __attribute__((address_space(3))) bf16x8*)(kp + (m * NCH + c) * 2048 + 512), qr[m][c], p1, 0, 0, 0);
                }
                const int lo = dq - J.max_dist;
                if (!act0) {
#pragma unroll
                    for (int r = 0; r < 16; ++r) p0[r] = NEGBIG;
                } else if (!clean0) {
#pragma unroll
                    for (int r = 0; r < 16; ++r) { const int kl = crow(r, hi); if (kl > dq || kl < lo) p0[r] = NEGBIG; }
                }
                if (!act1) {
#pragma unroll
                    for (int r = 0; r < 16; ++r) p1[r] = NEGBIG;
                } else if (!clean1) {
#pragma unroll
                    for (int r = 0; r < 16; ++r) { const int kl = crow(r, hi) + 32; if (kl > dq || kl < lo) p1[r] = NEGBIG; }
                }
                float rm = 0.f;
                if (!XPB(1) && !stat) { float a = __builtin_fmaxf(__builtin_fmaxf(p0[0], p0[1]), p1[0]), b = __builtin_fmaxf(__builtin_fmaxf(p0[2], p0[3]), p1[1]); a = __builtin_fmaxf(__builtin_fmaxf(a, p1[2]), p1[3]);
#pragma unroll
                  for (int r = 4; r < 16; r += 4) { a = __builtin_fmaxf(__builtin_fmaxf(a, p0[r]), p0[r + 1]); b = __builtin_fmaxf(__builtin_fmaxf(b, p0[r + 2]), p0[r + 3]);
                      a = __builtin_fmaxf(__builtin_fmaxf(a, p1[r]), p1[r + 1]); b = __builtin_fmaxf(__builtin_fmaxf(b, p1[r + 2]), p1[r + 3]); }
                  rm = swapmax(__builtin_fmaxf(a, b)); }
                if (__any(rm > THR)) {
                    const float dl = __builtin_fmaxf(rm, 0.f); mhat[m] += dl;
#pragma unroll
                    for (int r = 0; r < 16; ++r) { p0[r] -= dl; p1[r] -= dl; }
                    if (!ALIBI) {
#pragma unroll
                        for (int r = 0; r < 16; ++r) negm[r] = -mhat[m];
                    }
                    const float f = __builtin_amdgcn_exp2f(-dl); lsum[m] *= f;
                    if (hi == 0) wsf[m * 32 + r32] = f;
                    asm volatile("s_waitcnt lgkmcnt(0)" ::: "memory");
#pragma unroll
                    for (int r = 0; r < 16; ++r) { const float fr_ = wsf[m * 32 + crow(r, hi)]; o[m][0][r] *= fr_; o[m][1][r] *= fr_; if (ONES) osum[r] *= fr_; }
                }
                if (act0) { float sacc = 0.f;
#pragma unroll
                    for (int r = 0; r < 16; ++r) { if (!XPB(1)) { float x_ = __builtin_amdgcn_exp2f(p0[r]); asm("" : "+v"(x_)); p0[r] = x_; if (!ONES) sacc += x_; } }
                    if (!ONES) lsum[m] += sacc;
                    pw[0] = (u32x4){cvtpk(p0[0], p0[1]), cvtpk(p0[2], p0[3]), cvtpk(p0[4], p0[5]), cvtpk(p0[6], p0[7])};
                    pw[1] = (u32x4){cvtpk(p0[8], p0[9]), cvtpk(p0[10], p0[11]), cvtpk(p0[12], p0[13]), cvtpk(p0[14], p0[15])}; }
                if (act1) { float sacc = 0.f;
#pragma unroll
                    for (int r = 0; r < 16; ++r) { if (!XPB(1)) { float x_ = __builtin_amdgcn_exp2f(p1[r]); asm("" : "+v"(x_)); p1[r] = x_; if (!ONES) sacc += x_; } }
                    if (!ONES) lsum[m] += sacc;
                    pw[2] = (u32x4){cvtpk(p1[0], p1[1]), cvtpk(p1[2], p1[3]), cvtpk(p1[4], p1[5]), cvtpk(p1[6], p1[7])};
                    pw[3] = (u32x4){cvtpk(p1[8], p1[9]), cvtpk(p1[10], p1[11]), cvtpk(p1[12], p1[13]), cvtpk(p1[14], p1[15])}; }
                if (ATT_SB) __builtin_amdgcn_sched_barrier(0);
#define ATT_PV(KS0, KS1) do { _Pragma("unroll") for (int d0 = 0; d0 < 2; ++d0) { _Pragma("unroll") for (int ks = (KS0); ks < (KS1); ++ks) { \
                        bf16x8 vf; if (XPB(7)) vf = qr[m][(d0 * 4 + ks) % NCH]; else { const s16x4 vl = vtr(vp + d0 * 4096 + ks * 1024), vh = vtr(vp + d0 * 4096 + ks * 1024 + 512); \
                        vf = (bf16x8){vl[0], vl[1], vl[2], vl[3], vh[0], vh[1], vh[2], vh[3]}; } \
                        o[m][d0] = __builtin_amdgcn_mfma_f32_32x32x16_bf16(__builtin_bit_cast(bf16x8, pw[ks]), vf, o[m][d0], 0, 0, 0); \
                        if (ONES && d0 == 0) osum = __builtin_amdgcn_mfma_f32_32x32x16_bf16(__builtin_bit_cast(bf16x8, pw[ks]), ones, osum, 0, 0, 0); } \
                    if (ATT_SB) __builtin_amdgcn_sched_barrier(0); } } while (0)
#define ATT_PV2(KS0, KS1) do { _Pragma("unroll") for (int d0 = 0; d0 < 2; ++d0) { _Pragma("unroll") for (int ks = (KS0); ks < (KS1); ++ks) { \
                        const s16x4 vl = vtr(vp + d0 * 4096 + ks * 1024), vh = vtr(vp + d0 * 4096 + ks * 1024 + 512); const bf16x8 vf = (bf16x8){vl[0], vl[1], vl[2], vl[3], vh[0], vh[1], vh[2], vh[3]}; \
                        o[0][d0] = __builtin_amdgcn_mfma_f32_32x32x16_bf16(__builtin_bit_cast(bf16x8, pwk[ks]), vf, o[0][d0], 0, 0, 0); \
                        o[NMAP - 1][d0] = __builtin_amdgcn_mfma_f32_32x32x16_bf16(__builtin_bit_cast(bf16x8, pw[ks]), vf, o[NMAP - 1][d0], 0, 0, 0); } \
                    if (ATT_SB) __builtin_amdgcn_sched_barrier(0); } } while (0)
                constexpr bool SHV = (NMAP == 2) && (ATT_SHV != 0) && (XP == 0) && !STAG;
                if (SHV && m == 0) { pwk[0] = pw[0]; pwk[1] = pw[1]; pwk[2] = pw[2]; pwk[3] = pw[3]; }
                else if (SHV) { if (act0 && act1) ATT_PV2(0, 4); else if (act0) ATT_PV2(0, 2); else ATT_PV2(2, 4); }
                else if (XPB(2)) { o[m][0][0] += __uint_as_float(pw[0][0] ^ pw[1][1] ^ pw[2][2] ^ pw[3][3]); }
                else if (STAG && late) { ppw[0] = pw[0]; ppw[1] = pw[1]; ppw[2] = pw[2]; ppw[3] = pw[3]; pend = true; }
                else if (act0 && act1) ATT_PV(0, 4); else if (act0) ATT_PV(0, 2); else ATT_PV(2, 4);
#undef ATT_PV
#undef ATT_PV2
            }
        }
        slot = (slot == NS - 1) ? 0 : slot + 1;
    }
    if constexpr (STAG) { if (pend) { const lds_cptr vq = vp0 + ((slot == 0) ? NS - 1 : slot - 1) * VSLOT;
#pragma unroll
        for (int d0 = 0; d0 < 2; ++d0)
#pragma unroll
            for (int ks = 0; ks < 4; ++ks) { const s16x4 vl = vtr(vq + d0 * 4096 + ks * 1024), vh = vtr(vq + d0 * 4096 + ks * 1024 + 512);
                const bf16x8 vf = (bf16x8){vl[0], vl[1], vl[2], vl[3], vh[0], vh[1], vh[2], vh[3]};
                o[0][d0] = __builtin_amdgcn_mfma_f32_32x32x16_bf16(__builtin_bit_cast(bf16x8, ppw[ks]), vf, o[0][d0], 0, 0, 0); } } }
#pragma unroll
    for (int m = 0; m < NMAP; ++m) {
        float l;
        if (ONES) {
            if (r32 == 0) {
#pragma unroll
                for (int r = 0; r < 16; ++r) wsf[crow(r, hi)] = osum[r]; }
            asm volatile("s_waitcnt lgkmcnt(0)" ::: "memory");
            l = wsf[r32];
            asm volatile("s_waitcnt lgkmcnt(0)" ::: "memory");
        } else l = swapadd(lsum[m]);
        if (EPI == 3) l += __builtin_amdgcn_exp2f(J.sink2 - mhat[m]);
        if (EPI == 1) { if (hi == 0) J.LSE[m * J.lmap + (long)nq * J.ls] = mhat[m] + __builtin_amdgcn_logf(l); }
        if (hi == 0) wsf[m * 32 + r32] = l > 0.f ? __builtin_amdgcn_rcpf(l) : 0.f;
    }
    asm volatile("s_waitcnt lgkmcnt(0)" ::: "memory");
#pragma unroll
    for (int m = 0; m < NMAP; ++m) {
        __hip_bfloat16* stg = (__hip_bfloat16*)(shm + LDS_OST) + wid * 2048;
#pragma unroll
        for (int r = 0; r < 16; ++r) { const int orow = crow(r, hi); const float rl = wsf[m * 32 + orow];
#pragma unroll
            for (int d0 = 0; d0 < 2; ++d0) stg[orow * 64 + d0 * 32 + r32] = __float2bfloat16(o[m][d0][r] * rl); }
        asm volatile("s_waitcnt lgkmcnt(0)" ::: "memory");
        bf16_t* Ow = J.O + m * J.omap + (long)qw * J.os;
#pragma unroll
        for (int i = 0; i < 4; ++i) { const int row = i * 8 + (lane >> 3), ch = lane & 7; const u32x4 v = *(const u32x4*)((const bf16_t*)stg + row * 64 + ch * 8);
            *(u32x4*)(Ow + (long)row * J.os + ch * 8) = v; }
        asm volatile("s_waitcnt lgkmcnt(0)" ::: "memory");
    }
    asm volatile("s_waitcnt lgkmcnt(0)\n\ts_barrier" ::: "memory");
#undef ATT_DMA
}
}

namespace att {
constexpr int P_NSLOT = 4, P_LDS_K = 0, P_LDS_V = P_NSLOT * KSLOT, P_LDS_WS = P_LDS_V + P_NSLOT * VSLOT, P_LDS_OST = P_LDS_WS + NW * 64 * 4, P_LDS_BYTES = P_LDS_OST + NW * 4096;
template <int NCH, bool ALIBI, int EPI, bool QROPE = false>
__device__ __forceinline__ void attn_unit2(const Job& J, char* shm, unsigned* qhead, volatile __attribute__((address_space(3))) unsigned* qslot, const int wave_id) {
    constexpr int NQK = 2 * NCH;
    int lane_; asm volatile("v_mbcnt_lo_u32_b32 %0, -1, 0\n\tv_mbcnt_hi_u32_b32 %0, -1, %0" : "=v"(lane_));
    const int wid = wave_id, lane = lane_, tid = wid * 64 + lane, r32 = lane & 31, hi = lane >> 5;
    unsigned q_next = 0; if (tid == 0) q_next = __hip_atomic_fetch_add(qhead, 1u, __ATOMIC_RELAXED, __HIP_MEMORY_SCOPE_AGENT);
    const unsigned lds0 = (unsigned)(uintptr_t)shm;
    float* wsf = (float*)(shm + P_LDS_WS) + wid * 64;
    const unsigned koffA = (unsigned)(lane * J.ks0 + wid * 8) * 2u, koffB = (NQK > 8) ? (unsigned)(lane * J.ks1 + wid * 8) * 2u : 0u;
    const unsigned voff = (unsigned)((16 * (wid & 3) + (lane >> 2)) * J.vs + (wid >> 2) * 32 + (lane & 3) * 8) * 2u;
    const long kstepA = (long)KVBLK * J.ks0 * 2, kstepB = (NQK > 8) ? (long)KVBLK * J.ks1 * 2 : 0, vstep = (long)KVBLK * J.vs * 2;
    const unsigned kdst = lds0 + P_LDS_K + wid * 1024, vdst = lds0 + P_LDS_V + wid * 1024;
    const bool extraK = (NQK > 8) && (wid < NQK - 8);
#define ATT2_DMA(t, slot) do { pg8::glds_s(koffA, (const char*)J.K0 + (long)(t) * kstepA, kdst + (slot) * KSLOT); \
        if (extraK) pg8::glds_s(koffB, (const char*)J.K1 + (long)(t) * kstepB, kdst + (slot) * KSLOT + 8192); \
        pg8::glds_s(voff, (const char*)J.V + (long)(t) * vstep, vdst + (slot) * VSLOT); } while (0)
    const int qw = J.q0 + wid * QBLK, nq = qw + r32;
    bf16x8 qr[NCH];
    { const bf16_t* qp = J.Q + (long)nq * J.qs + hi * 8;
#pragma unroll
      for (int c = 0; c < NCH; ++c) qr[c] = *reinterpret_cast<const bf16x8*>(qp + c * 16); }
    if constexpr (QROPE) {
        const f32x2_t* rt = J.rope + (size_t)nq * 16 + hi * 4;
#pragma unroll
        for (int c = 0; c < 2; ++c) { bf16x8 q = qr[NCH - 2 + c]; bf16x8 r;
#pragma unroll
            for (int i = 0; i < 4; ++i) { const f32x2_t cs = rt[c * 8 + i]; const float a = __uint_as_float((unsigned)(unsigned short)q[2 * i] << 16), b = __uint_as_float((unsigned)(unsigned short)q[2 * i + 1] << 16);
                const unsigned w = cvtpk(a * cs.x - b * cs.y, b * cs.x + a * cs.y); r[2 * i] = (short)(w & 0xffffu); r[2 * i + 1] = (short)(w >> 16); }
            qr[NCH - 2 + c] = r; __builtin_amdgcn_sched_barrier(0); }
    }
    __builtin_amdgcn_sched_barrier(0);
    const int t_lo = J.t_lo, t_hi = J.t_hi;
    int tw_lo = t_lo; if (J.max_dist < (1 << 27)) { const int a = (qw - J.max_dist) >> 6; tw_lo = a > tw_lo ? a : tw_lo; }
    int tw_hi = ((qw + QBLK - 1) >> 6) + 1; tw_hi = tw_hi < t_hi ? tw_hi : t_hi;
    ATT2_DMA(t_lo, 0); if (t_lo + 1 < t_hi) ATT2_DMA(t_lo + 1, 1);
    float mhat = -1000.f, lsum = 0.f; f32x16 o[2], negm, pc0, pc1, pn0, pn1;
    float zero_ = 0.f; asm volatile("" : "+v"(zero_));
#pragma unroll
    for (int r = 0; r < 16; ++r) { o[0][r] = zero_; o[1][r] = zero_; negm[r] = 1000.f + zero_; pc0[r] = zero_; pc1[r] = zero_; }
    const lds_cptr shm3 = (lds_cptr)shm;
    const lds_cptr kp0 = shm3 + P_LDS_K + hi * 1024 + r32 * 16;
    const lds_cptr vp0 = shm3 + P_LDS_V + ((lane >> 4) & 1) * 32 + (lane & 3) * 8 + (4 * hi + ((lane & 15) >> 2)) * 64;
    bool have_cur = false;
#define ATT2_PC(e) ((e) < 16 ? pc0[(e) & 15] : pc1[(e) & 15])
    for (int i = t_lo - 1; i < t_hi; ++i) {
        if (i + 2 < t_hi) { if (extraK) ATT_WAIT_BAR(3); else ATT_WAIT_BAR(2); } else ATT_WAIT_BAR(0);
        if (i == t_lo - 1 && tid == 0) *qslot = q_next;
        if (i + 3 < t_hi) ATT2_DMA(i + 3, (i + 3 - t_lo) & 3);
        const bool do_next = (i + 1 >= tw_lo) && (i + 1 < tw_hi), do_cur = have_cur;
        const lds_cptr kp = kp0 + ((i + 1 - t_lo) & 3) * KSLOT; const lds_cptr vp = vp0 + ((i - t_lo) & 3) * VSLOT;
        const int k_lo = (i + 1) * KVBLK, dq = nq - k_lo;
        u32x4 pw[4]; float sacc = 0.f;
#define ATT2_INIT() do { if (ALIBI) { const float L = -mhat - J.slope2 * (float)(dq - 4 * hi), L1 = L + 32.f * J.slope2; \
                _Pragma("unroll") for (int r = 0; r < 16; ++r) { pn0[r] = __builtin_fmaf(J.slope2, (float)crow(r, 0), L); pn1[r] = __builtin_fmaf(J.slope2, (float)crow(r, 0), L1); } } \
            else { const float L = -mhat; _Pragma("unroll") for (int r = 0; r < 16; ++r) { pn0[r] = L; pn1[r] = L; } } } while (0)
#define ATT2_KLD(j) (*(const __attribute__((address_space(3))) bf16x8*)(kp + ((j) >> 1) * 2048 + ((j) & 1) * 512))
        if (do_next && do_cur) {
            ATT2_INIT();
            bf16x8 kf[NQK]; kf[0] = ATT2_KLD(0); kf[1] = ATT2_KLD(1);
            __builtin_amdgcn_sched_barrier(0);
#pragma unroll
            for (int j = 0; j < NQK; ++j) {
                if (j + 2 < NQK) kf[j + 2] = ATT2_KLD(j + 2);
                if ((j & 1) == 0) pn0 = __builtin_amdgcn_mfma_f32_32x32x16_bf16(kf[j], qr[j >> 1], pn0, 0, 0, 0);
                else pn1 = __builtin_amdgcn_mfma_f32_32x32x16_bf16(kf[j], qr[j >> 1], pn1, 0, 0, 0);
                const int e0 = j * 32 / NQK, e1 = (j + 1) * 32 / NQK;
#pragma unroll
                for (int e = e0; e < e1; ++e) { const float x = __builtin_amdgcn_exp2f(ATT2_PC(e)); if (e < 16) pc0[e & 15] = x; else pc1[e & 15] = x; sacc += x; }
#pragma unroll
                for (int k = e0 / 2; k < e1 / 2; ++k) pw[k >> 2][k & 3] = cvtpk(ATT2_PC(2 * k), ATT2_PC(2 * k + 1));
                asm volatile("" : "+v"(sacc));
                __builtin_amdgcn_sched_barrier(0);
            }
        } else if (do_next) {
            ATT2_INIT();
#pragma unroll
            for (int j = 0; j < NQK; ++j) { const bf16x8 kfj = ATT2_KLD(j);
                if ((j & 1) == 0) pn0 = __builtin_amdgcn_mfma_f32_32x32x16_bf16(kfj, qr[j >> 1], pn0, 0, 0, 0);
                else pn1 = __builtin_amdgcn_mfma_f32_32x32x16_bf16(kfj, qr[j >> 1], pn1, 0, 0, 0); }
        } else if (do_cur) {
#pragma unroll
            for (int e = 0; e < 32; ++e) { const float x = __builtin_amdgcn_exp2f(ATT2_PC(e)); if (e < 16) pc0[e & 15] = x; else pc1[e & 15] = x; sacc += x; }
#pragma unroll
            for (int k = 0; k < 16; ++k) pw[k >> 2][k & 3] = cvtpk(ATT2_PC(2 * k), ATT2_PC(2 * k + 1));
        }
#undef ATT2_INIT
#undef ATT2_KLD
        lsum += sacc;
        if (do_next) { const bool clean = (k_lo + KVBLK - 1 <= qw) && (qw + QBLK - 1 - k_lo <= J.max_dist);
            if (!clean) { const int lo = dq - J.max_dist;
#pragma unroll
                for (int r = 0; r < 16; ++r) { const int kl = crow(r, hi); if (kl > dq || kl < lo) pn0[r] = NEGBIG; if (kl + 32 > dq || kl + 32 < lo) pn1[r] = NEGBIG; } } }
        __builtin_amdgcn_sched_barrier(0);
        float ma = NEGBIG, mb = NEGBIG;
#define ATT2_VLD(g, VL, VH) do { VL = vtr(vp + ((g) >> 2) * 4096 + ((g) & 3) * 1024); VH = vtr(vp + ((g) >> 2) * 4096 + ((g) & 3) * 1024 + 512); } while (0)
        if (do_cur && do_next) {
            s16x4 vl[8], vh[8]; ATT2_VLD(0, vl[0], vh[0]);
            __builtin_amdgcn_sched_barrier(0);
#pragma unroll
            for (int g = 0; g < 8; ++g) {
                if (g + 1 < 8) ATT2_VLD(g + 1, vl[g + 1], vh[g + 1]);
                const bf16x8 vf = (bf16x8){vl[g][0], vl[g][1], vl[g][2], vl[g][3], vh[g][0], vh[g][1], vh[g][2], vh[g][3]};
                o[g >> 2] = __builtin_amdgcn_mfma_f32_32x32x16_bf16(__builtin_bit_cast(bf16x8, pw[g & 3]), vf, o[g >> 2], 0, 0, 0);
                if (g < 4) { ma = __builtin_fmaxf(__builtin_fmaxf(ma, pn0[4 * g]), pn0[4 * g + 1]); mb = __builtin_fmaxf(__builtin_fmaxf(mb, pn0[4 * g + 2]), pn0[4 * g + 3]); }
                else { ma = __builtin_fmaxf(__builtin_fmaxf(ma, pn1[4 * g - 16]), pn1[4 * g - 15]); mb = __builtin_fmaxf(__builtin_fmaxf(mb, pn1[4 * g - 14]), pn1[4 * g - 13]); }
                asm volatile("" : "+v"(ma), "+v"(mb));
                __builtin_amdgcn_sched_barrier(0);
            }
        } else if (do_cur) {
#pragma unroll
            for (int g = 0; g < 8; ++g) { s16x4 vl_, vh_; ATT2_VLD(g, vl_, vh_);
                const bf16x8 vf = (bf16x8){vl_[0], vl_[1], vl_[2], vl_[3], vh_[0], vh_[1], vh_[2], vh_[3]};
                o[g >> 2] = __builtin_amdgcn_mfma_f32_32x32x16_bf16(__builtin_bit_cast(bf16x8, pw[g & 3]), vf, o[g >> 2], 0, 0, 0); }
        } else if (do_next) {
#pragma unroll
            for (int r = 0; r < 16; r += 2) { ma = __builtin_fmaxf(__builtin_fmaxf(ma, pn0[r]), pn0[r + 1]); mb = __builtin_fmaxf(__builtin_fmaxf(mb, pn1[r]), pn1[r + 1]); }
        }
#undef ATT2_VLD
        if (do_next) {
            const float rm = swapmax(__builtin_fmaxf(ma, mb));
            if (__any(rm > THR)) {
                const float dl = __builtin_fmaxf(rm, 0.f); mhat += dl;
#pragma unroll
                for (int r = 0; r < 16; ++r) { pn0[r] -= dl; pn1[r] -= dl; }
                if (!ALIBI) {
#pragma unroll
                    for (int r = 0; r < 16; ++r) negm[r] = -mhat;
                }
                const float f = __builtin_amdgcn_exp2f(-dl); lsum *= f;
                { const int l_ = lane_now(); if (l_ < 32) wsf[l_] = f; }
                asm volatile("s_waitcnt lgkmcnt(0)" ::: "memory");
#pragma unroll
                for (int r = 0; r < 16; ++r) { const float fr_ = wsf[crow(r, hi)]; o[0][r] *= fr_; o[1][r] *= fr_; }
            }
            pc0 = pn0; pc1 = pn1;
        }
        have_cur = do_next;
    }
#undef ATT2_PC
    { float l = swapadd(lsum);
      if (EPI == 3) l += __builtin_amdgcn_exp2f(J.sink2 - mhat);
      if (EPI == 1) { if (hi == 0) J.LSE[(long)nq * J.ls] = mhat + __builtin_amdgcn_logf(l); }
      { const int l_ = lane_now(); if (l_ < 32) wsf[l_] = l > 0.f ? __builtin_amdgcn_rcpf(l) : 0.f; } }
    asm volatile("s_waitcnt lgkmcnt(0)" ::: "memory");
    { __hip_bfloat16* stg = (__hip_bfloat16*)(shm + P_LDS_OST) + wid * 2048;
#pragma unroll
      for (int r = 0; r < 16; ++r) { const int orow = crow(r, hi); const float rl = wsf[orow];
#pragma unroll
          for (int d0 = 0; d0 < 2; ++d0) stg[orow * 64 + d0 * 32 + r32] = __float2bfloat16(o[d0][r] * rl); }
      asm volatile("s_waitcnt lgkmcnt(0)" ::: "memory");
      bf16_t* Ow = J.O + (long)qw * J.os;
#pragma unroll
      for (int i = 0; i < 4; ++i) { const int row = i * 8 + (lane >> 3), ch = lane & 7; const u32x4 v = *(const u32x4*)((const bf16_t*)stg + row * 64 + ch * 8);
          *(u32x4*)(Ow + (long)row * J.os + ch * 8) = v; } }
    asm volatile("s_waitcnt lgkmcnt(0)\n\ts_barrier" ::: "memory");
#undef ATT2_DMA
}
}

namespace att {
constexpr int BW_LDS = 16384;
template <int EPI>
__device__ __forceinline__ void band_wave(const Job& J, char* wl, float* wsf, const int wid, const unsigned q_next, volatile __attribute__((address_space(3))) unsigned* qslot) {
    int lane_; asm volatile("v_mbcnt_lo_u32_b32 %0, -1, 0\n\tv_mbcnt_hi_u32_b32 %0, -1, %0" : "=v"(lane_));
    const int lane = lane_, r32 = lane & 31, hi = lane >> 5;
    const unsigned wl0 = (unsigned)(uintptr_t)wl;
    const int qw = J.q0 + wid * QBLK, nq = qw + r32;
    bf16x8 qr[4];
    { const bf16_t* qp = J.Q + (long)nq * J.qs + hi * 8;
#pragma unroll
      for (int c = 0; c < 4; ++c) qr[c] = *reinterpret_cast<const bf16x8*>(qp + c * 16); }
    const unsigned vlo = (unsigned)((lane >> 2) * J.vs * 2 + (lane & 3) * 16);
    const long klo = (long)r32 * J.ks0 + hi * 8;
    float mhat = -1000.f, lsum = 0.f; f32x16 o[2];
    float zero_ = 0.f; asm volatile("" : "+v"(zero_));
#pragma unroll
    for (int r = 0; r < 16; ++r) { o[0][r] = zero_; o[1][r] = zero_; }
    const lds_cptr wl3 = (lds_cptr)wl;
    const lds_cptr vp0 = wl3 + ((lane >> 4) & 1) * 32 + (lane & 3) * 8 + (4 * hi + ((lane & 15) >> 2)) * 64;
    bf16x8 kA[2][4], kB[2][4], kC[1][4];
#define BW_KB(s, jb) (qw - 128 + 64 * (s) + 32 * (jb))
#define BW_LOADK(dst, s, jb) do { const int kb_ = BW_KB(s, jb) > 0 ? BW_KB(s, jb) : 0; const bf16_t* kp_ = J.K0 + (long)kb_ * J.ks0 + klo; \
        _Pragma("unroll") for (int c = 0; c < 4; ++c) dst[jb][c] = *reinterpret_cast<const bf16x8*>(kp_ + c * 16); } while (0)
#define BW_DMAV(s, jb) do { const int kb_ = BW_KB(s, jb) > 0 ? BW_KB(s, jb) : 0; \
        _Pragma("unroll") for (int i = 0; i < 4; ++i) pg8::glds_s(vlo, (const char*)(J.V + (long)(kb_ + (i & 1) * 16) * J.vs + (i >> 1) * 32), wl0 + ((s) & 1) * 8192 + (jb) * 4096 + (i >> 1) * 2048 + (i & 1) * 1024); } while (0)
    BW_DMAV(0, 0); BW_DMAV(0, 1); BW_DMAV(1, 0); BW_DMAV(1, 1);
    BW_LOADK(kA, 0, 0); BW_LOADK(kA, 0, 1); BW_LOADK(kB, 1, 0); BW_LOADK(kB, 1, 1); BW_LOADK(kC, 2, 0);
#define BW_STEP(s, KF, NB) do { \
        if ((s) != 1) asm volatile("s_waitcnt vmcnt(0)" ::: "memory"); \
        if ((s) == 0 && wid == 0 && lane == 0) *qslot = q_next;       \
        const int kb0 = BW_KB(s, 0), dq = nq - kb0; \
        f32x16 p0, p1; \
        { const float L = -mhat - J.slope2 * (float)(dq - 4 * hi), L1 = L + 32.f * J.slope2; \
          _Pragma("unroll") for (int r = 0; r < 16; ++r) { float a_ = __builtin_fmaf(J.slope2, (float)crow(r, 0), L), b_ = __builtin_fmaf(J.slope2, (float)crow(r, 0), L1); asm("" : "+v"(a_)); asm("" : "+v"(b_)); p0[r] = a_; p1[r] = b_; } } \
        _Pragma("unroll") for (int c = 0; c < 4; ++c) { p0 = __builtin_amdgcn_mfma_f32_32x32x16_bf16(KF[0][c], qr[c], p0, 0, 0, 0); \
            if ((NB) == 2) p1 = __builtin_amdgcn_mfma_f32_32x32x16_bf16(KF[1][c], qr[c], p1, 0, 0, 0); } \
          \
        { const int lo = dq - J.max_dist; const bool v0 = kb0 >= 0, v1 = kb0 + 32 >= 0; \
          if ((s) == 0) { _Pragma("unroll") for (int r = 0; r < 16; ++r) { const int kl = crow(r, hi); if (kl < lo) p0[r] = NEGBIG; } \
              if ((NB) == 2 && J.max_dist < 97) { _Pragma("unroll") for (int r = 0; r < 16; ++r) { const int kl = crow(r, hi) + 32; if (kl < lo) p1[r] = NEGBIG; } } } \
          if ((s) == 2) { _Pragma("unroll") for (int r = 0; r < 16; ++r) { const int kl = crow(r, hi); if (kl > dq) p0[r] = NEGBIG; } } \
          if (!v0) { _Pragma("unroll") for (int r = 0; r < 16; ++r) p0[r] = NEGBIG; } \
          if ((NB) == 2 && !v1) { _Pragma("unroll") for (int r = 0; r < 16; ++r) p1[r] = NEGBIG; } } \
        float rm; \
        { float a = NEGBIG, b = NEGBIG; \
          _Pragma("unroll") for (int r = 0; r < 16; r += 2) { a = __builtin_fmaxf(__builtin_fmaxf(a, p0[r]), p0[r + 1]); if ((NB) == 2) b = __builtin_fmaxf(__builtin_fmaxf(b, p1[r]), p1[r + 1]); } \
          rm = swapmax(__builtin_fmaxf(a, b)); } \
        if (__any(rm > THR)) { const float dl = __builtin_fmaxf(rm, 0.f); mhat += dl; \
            _Pragma("unroll") for (int r = 0; r < 16; ++r) { p0[r] -= dl; p1[r] -= dl; } \
            const float f = __builtin_amdgcn_exp2f(-dl); lsum *= f; \
            if (hi == 0) wsf[r32] = f; \
            asm volatile("s_waitcnt lgkmcnt(0)" ::: "memory"); \
            _Pragma("unroll") for (int r = 0; r < 16; ++r) { const float fr_ = wsf[crow(r, hi)]; o[0][r] *= fr_; o[1][r] *= fr_; } } \
        u32x4 pw[4]; float sacc = 0.f; \
        _Pragma("unroll") for (int r = 0; r < 16; ++r) { float x_ = __builtin_amdgcn_exp2f(p0[r]); asm("" : "+v"(x_)); p0[r] = x_; sacc += x_; if ((NB) == 2) { float y_ = __builtin_amdgcn_exp2f(p1[r]); asm("" : "+v"(y_)); p1[r] = y_; sacc += y_; } } \
        lsum += sacc; \
        pw[0] = (u32x4){cvtpk(p0[0], p0[1]), cvtpk(p0[2], p0[3]), cvtpk(p0[4], p0[5]), cvtpk(p0[6], p0[7])}; \
        pw[1] = (u32x4){cvtpk(p0[8], p0[9]), cvtpk(p0[10], p0[11]), cvtpk(p0[12], p0[13]), cvtpk(p0[14], p0[15])}; \
        if ((NB) == 2) { pw[2] = (u32x4){cvtpk(p1[0], p1[1]), cvtpk(p1[2], p1[3]), cvtpk(p1[4], p1[5]), cvtpk(p1[6], p1[7])}; \
            pw[3] = (u32x4){cvtpk(p1[8], p1[9]), cvtpk(p1[10], p1[11]), cvtpk(p1[12], p1[13]), cvtpk(p1[14], p1[15])}; } \
        const lds_cptr vp = vp0 + ((s) & 1) * 8192; \
        _Pragma("unroll") for (int d0 = 0; d0 < 2; ++d0) _Pragma("unroll") for (int g = 0; g < 2 * (NB); ++g) { \
            const s16x4 vl = vtr(vp + (g >> 1) * 4096 + d0 * 2048 + (g & 1) * 1024), vh = vtr(vp + (g >> 1) * 4096 + d0 * 2048 + (g & 1) * 1024 + 512); \
            const bf16x8 vf = (bf16x8){vl[0], vl[1], vl[2], vl[3], vh[0], vh[1], vh[2], vh[3]}; \
            o[d0] = __builtin_amdgcn_mfma_f32_32x32x16_bf16(__builtin_bit_cast(bf16x8, pw[g]), vf, o[d0], 0, 0, 0); } \
        if ((s) == 0) { asm volatile("s_waitcnt lgkmcnt(0)" ::: "memory"); BW_DMAV(2, 0); } \
    } while (0)
    BW_STEP(0, kA, 2);
    BW_STEP(1, kB, 2);
    BW_STEP(2, kC, 1);
#undef BW_STEP
#undef BW_LOADK
#undef BW_DMAV
#undef BW_KB
    { float l = swapadd(lsum);
      if (EPI == 3) l += __builtin_amdgcn_exp2f(J.sink2 - mhat);
      if (EPI == 1) { if (hi == 0) J.LSE[(long)nq * J.ls] = mhat + __builtin_amdgcn_logf(l); }
      if (hi == 0) wsf[r32] = l > 0.f ? __builtin_amdgcn_rcpf(l) : 0.f; }
    asm volatile("s_waitcnt lgkmcnt(0)" ::: "memory");
    { __hip_bfloat16* stg = (__hip_bfloat16*)(wl + 8192);
#pragma unroll
      for (int r = 0; r < 16; ++r) { const int orow = crow(r, hi); const float rl = wsf[orow];
#pragma unroll
          for (int d0 = 0; d0 < 2; ++d0) stg[orow * 64 + d0 * 32 + r32] = __float2bfloat16(o[d0][r] * rl); }
      asm volatile("s_waitcnt lgkmcnt(0)" ::: "memory");
      bf16_t* Ow = J.O + (long)qw * J.os;
#pragma unroll
      for (int i = 0; i < 4; ++i) { const int row = i * 8 + (lane >> 3), ch = lane & 7; const u32x4 v = *(const u32x4*)((const bf16_t*)stg + row * 64 + ch * 8);
          *(u32x4*)(Ow + (long)row * J.os + ch * 8) = v; } }
    asm volatile("s_waitcnt lgkmcnt(0)" ::: "memory");
}
}
#ifndef MK_PER_PHASE
#define MK_PER_PHASE 0
#endif
constexpr int NWAVES = 8;
constexpr int NB = 4, S = 8192, T = NB * S, D = 1024;
constexpr int NQKV = 2592, NQKVP = 2816;
constexpr int FF = 2816, FE = 3584, NEXP = 8;
constexpr float RMS_EPS = 1e-6f;
#ifndef FFN8
#define FFN8 3
#endif
constexpr float LOG2E = 1.4426950408889634f;
constexpr float MOE_WSCALE = 64.0f;
constexpr int C_QA = 0, C_KA = 256, C_VA = 512, C_QB = 768, C_KB = 1024, C_VB = 1280, C_QD = 1536, C_KD = 1792, C_VD = 1920, C_CQ = 2048, C_CKV = 2432, C_KPE = 2560;

constexpr size_t MiB = 1u << 20;
constexpr size_t WS_CTL = 0, CTL_ZERO_BYTES = 1 * MiB;
constexpr size_t WS_ROPE = 1 * MiB;
constexpr size_t WS_WIN = 2 * MiB, WIN_L = (size_t)NQKVP * D * 2;
constexpr size_t WS_WOUT = 13 * MiB, WOUT_L = (size_t)D * D * 2;
constexpr size_t WS_WUQ = 17 * MiB, WUQ_L = (size_t)512 * 384 * 2;
constexpr size_t WS_WUKV = 17 * MiB + 768 * 1024, WUKV_L = (size_t)512 * 128 * 2;
constexpr size_t WS_W13 = 18 * MiB, WS_W2 = 29 * MiB;
constexpr size_t WS_R1 = 35 * MiB;
constexpr size_t WS_QKV = 99 * MiB, WS_QM = 261 * MiB, WS_KVM = 285 * MiB, WS_OB = 317 * MiB, OB_L = (size_t)T * 256 * 2, WS_LSE = 365 * MiB, LSE_L = (size_t)T * 4 * 4;
constexpr size_t WS_PA = 367 * MiB, WS_PC = 431 * MiB, WS_LA = 463 * MiB, WS_LC = 465 * MiB;
constexpr size_t WS_XB = 440 * MiB, WS_SSQ = 505 * MiB;
constexpr size_t WS_G = 99 * MiB;
constexpr size_t WS_MW13 = 99 * MiB, WS_MW2 = 211 * MiB, WS_GM = 267 * MiB, GM_L = (size_t)64 * 256 * FE  , WS_Y = 379 * MiB;
constexpr size_t WS_RT = 511 * MiB, RT_SEL = 0, RT_GATE = 256 * 1024, RT_POS = 512 * 1024, RT_TOK = 768 * 1024, RT_BLK = 1280 * 1024;
constexpr size_t WS_SSQ2 = 513 * MiB;
constexpr size_t WS_END = 515 * MiB;
static_assert(WS_WIN + 2 * WIN_L <= WS_WOUT && WS_WOUT + 2 * WOUT_L <= WS_WUQ && WS_WUQ + 2 * WUQ_L <= WS_WUKV && WS_WUKV + 2 * WUKV_L <= WS_W13, "ws map 1");
static_assert(WS_W13 + (size_t)2 * FF * D * 2 <= WS_W2 && WS_W2 + (size_t)D * FF * 2 <= WS_R1 && WS_R1 + (size_t)T * D * 2 <= WS_QKV, "ws map 2");
static_assert(WS_QKV + (size_t)T * NQKV * 2 <= WS_QM && WS_QM + (size_t)T * 384 * 2 <= WS_KVM && WS_KVM + (size_t)T * 512 * 2 <= WS_OB && WS_OB + 3 * OB_L <= WS_LSE && WS_LSE + 3 * LSE_L <= WS_RT, "ws map 3");
static_assert(WS_G + (size_t)T * FF * 2 <= WS_XB && WS_XB + (size_t)T * D * 2 <= WS_SSQ && WS_SSQ + (size_t)T * 16 * 4 <= WS_RT, "ws map 4");
static_assert(WS_LSE + 3 * LSE_L <= WS_PA && WS_PA + 4 * OB_L <= WS_PC && WS_PC + 2 * OB_L <= WS_LA && WS_LA + 4 * LSE_L <= WS_LC && WS_LC + 2 * LSE_L <= WS_RT, "ws map 6");
static_assert(WS_MW13 + (size_t)NEXP * 2 * FE * D <= WS_MW2 && WS_MW2 + (size_t)NEXP * D * FE <= WS_GM && WS_GM + 2 * GM_L <= WS_Y && WS_Y + (size_t)264 * 256 * D * 2 <= WS_RT, "ws map 5");
constexpr int CW_TMO = 0, CW_CODE = 1;
constexpr int CW_BAR = 4096;
constexpr int CW_Q = 120000;
constexpr int CW_HIST = 122000;
constexpr int CW_KMAX = 124160;
constexpr int CW_KMAXC = CW_KMAX + 64;
constexpr int CW_RDY = CW_KMAX + 140;
constexpr int CW_KPE = CW_KMAX + 128;
static_assert(CW_HIST + 256 * 8 <= CW_KMAX && (CW_KMAX + 144) * 4 <= (int)CTL_ZERO_BYTES, "CTL words inside the memset region");

constexpr int RING_OFF = 0, RING_BYTES = 131072;
constexpr int LDSCTL_OFF = RING_BYTES, MISC_OFF = LDSCTL_OFF + 320;
constexpr int LDS_BYTES = 147456;

#define GAS __attribute__((address_space(1)))
#define LAS __attribute__((address_space(3)))
typedef unsigned short bf16;
typedef unsigned v4u __attribute__((ext_vector_type(4)));
typedef unsigned v2u __attribute__((ext_vector_type(2)));
typedef float f32x4 __attribute__((ext_vector_type(4)));
typedef float f32x2 __attribute__((ext_vector_type(2)));
typedef GAS unsigned gu32;
#define RLX_AGENT __ATOMIC_RELAXED, __HIP_MEMORY_SCOPE_AGENT
#define LDS_WAIT() asm volatile("s_waitcnt lgkmcnt(0)" ::: "memory")
#define VM_WAIT() asm volatile("s_waitcnt vmcnt(0)" ::: "memory")
__device__ __forceinline__ unsigned f2bf(float f) { unsigned u = __builtin_bit_cast(unsigned, f); return (u + 0x7fffu + ((u >> 16) & 1u)) >> 16; }
__device__ __forceinline__ unsigned pk2(float lo, float hi) { return f2bf(lo) | (f2bf(hi) << 16); }
__device__ __forceinline__ float bflo(unsigned w) { return __uint_as_float(w << 16); }
__device__ __forceinline__ float bfhi(unsigned w) { return __uint_as_float(w & 0xffff0000u); }

#define XB_TMO      128
#define XB_XCNT(j)  (256  + 64 * (j))
#define XB_XSUB(j)  (1280 + 64 * (j))
#define XB_XGEN(j)  (2304 + 64 * (j))
#define XB_TOP      3328
#define XB_TOPGEN   3392
#define XCD_BAR_WORDS 3456
#define XB_SPIN_CAP (1u << 18)
__device__ __forceinline__ unsigned xb_ld(unsigned* p)              { return __hip_atomic_load(p, __ATOMIC_RELAXED, __HIP_MEMORY_SCOPE_AGENT); }
__device__ __forceinline__ unsigned xb_add(unsigned* p, unsigned v) { return __hip_atomic_fetch_add(p, v, __ATOMIC_RELAXED, __HIP_MEMORY_SCOPE_AGENT); }
__device__ __forceinline__ unsigned xb_xcc_id() { return (unsigned)__builtin_amdgcn_s_getreg((3 << 11) | 20) & 0xFu; }
#define XB_SPIN(cond, bar) do { unsigned _sp = 0; while (cond) { __builtin_amdgcn_s_sleep(1); \
    if ((++_sp & 255u) == 0u) { if (xb_ld(&(bar)[XB_TMO])) break; if (_sp > XB_SPIN_CAP) { atomicAdd(&(bar)[XB_TMO], 1u); break; } } } } while (0)
struct XcdBarrier { unsigned* bar; unsigned x; volatile LAS unsigned* st; };
__device__ __forceinline__ XcdBarrier xcd_barrier_post(unsigned* bar, volatile LAS unsigned* st) {
    XcdBarrier b; b.bar = bar; b.x = xb_xcc_id(); b.st = st;
    if (threadIdx.x == 0) (void)xb_add(&bar[XB_XCNT(b.x)], 1u);
    return b;
}
__device__ __forceinline__ void xcd_barrier_complete(unsigned* bar, unsigned x, unsigned& nloc, unsigned& nx) {
    const unsigned G = gridDim.x * gridDim.y * gridDim.z;
    unsigned sum, cnt, mine, sp = 0u;
    for (;;) {
        sum = 0u; cnt = 0u; mine = 0u;
#pragma unroll
        for (unsigned j = 0; j < 16; ++j) { const unsigned c = xb_ld(&bar[XB_XCNT(j)]); sum += c; cnt += (c > 0u) ? 1u : 0u; mine = (j == x) ? c : mine; }
        if (sum == G) break;
        __builtin_amdgcn_s_sleep(1);
        if ((++sp & 255u) == 0u) { if (xb_ld(&bar[XB_TMO])) break; if (sp > XB_SPIN_CAP) { atomicAdd(&bar[XB_TMO], 1u); break; } }
    }
    nloc = mine > 0u ? mine : 1u; nx = cnt > 0u ? cnt : 1u;
}
__device__ __forceinline__ void xcd_barrier(const XcdBarrier& b) {
    asm volatile("s_waitcnt vmcnt(0)" ::: "memory");
    __syncthreads();
    if (threadIdx.x == 0) {
        unsigned* bar = b.bar;
        __builtin_amdgcn_s_waitcnt(0);
        unsigned nloc = b.st[0], nx = b.st[1];
        if (nloc == 0u) { xcd_barrier_complete(bar, b.x, nloc, nx); b.st[0] = nloc; b.st[1] = nx; }
        const unsigned old = xb_add(&bar[XB_XSUB(b.x)], 1u);
        const unsigned gen = old / nloc;
        if (old + 1u == (gen + 1u) * nloc) {
            __builtin_amdgcn_fence(__ATOMIC_RELEASE, "agent");
            asm volatile("s_waitcnt vmcnt(0)" ::: "memory");
            const unsigned og = xb_add(&bar[XB_TOP], 1u);
            const unsigned tg = og / nx;
            if (og + 1u == (tg + 1u) * nx) xb_add(&bar[XB_TOPGEN], 1u);
            else XB_SPIN(xb_ld(&bar[XB_TOPGEN]) == tg, bar);
            __builtin_amdgcn_fence(__ATOMIC_ACQUIRE, "agent");
            xb_add(&bar[XB_XGEN(b.x)], 1u);
            asm volatile("s_waitcnt vmcnt(0)" ::: "memory");
        } else {
            XB_SPIN(xb_ld(&bar[XB_XGEN(b.x)]) == gen, bar);
            __builtin_amdgcn_fence(__ATOMIC_ACQUIRE, "agent");
            asm volatile("s_waitcnt vmcnt(0)" ::: "memory");
        }
    }
    __syncthreads();
}

struct Frame {
    LAS unsigned char* lds;
    volatile LAS unsigned* MISC;
    int tid, lane, wave, vcu, G, bx;
};
#define CAS __attribute__((address_space(4)))
__device__ __forceinline__ const CAS char* kargs() { const CAS char* p = (const CAS char*)__builtin_amdgcn_kernarg_segment_ptr(); asm volatile("" : "+s"(p)); return p; }
__device__ __forceinline__ const float* gin(int k) { return *(const float* const CAS*)(kargs() + 8 * k); }
__device__ __forceinline__ float* gout() { return *(float* const CAS*)(kargs() + 160); }
__device__ __forceinline__ unsigned char* gws() { return *(unsigned char* const CAS*)(kargs() + 168); }
__device__ __forceinline__ gu32* gctl() { return (gu32*)gws(); }
__device__ __forceinline__ float wave_sum(float v, int lane) {
#pragma unroll
    for (int o = 1; o < 64; o <<= 1) v += __int_as_float(__builtin_amdgcn_ds_bpermute((lane ^ o) << 2, __float_as_int(v)));
    return v;
}

__device__ __forceinline__ void wmap(int kind, int aux, int n, int& drow, float& sc) {
    sc = 1.f; drow = n + aux;
    if (kind == 1) {
        if (n < 1536) { drow = n; if (n < 256) sc = 0.17677669529663687f * LOG2E; else if (n >= 768 && n < 1024) sc = 0.125f * LOG2E; }
        else if (n < 2048) drow = n + 512;
        else if (n < 2080) { const int j = n - 2048; drow = C_KPE + (j < 16 ? 2 * j : 2 * (j - 16) + 1); }
        else { drow = n - 544; if (n < 2336) sc = 0.125f * LOG2E; }
    } else if (kind == 2) {
        const int h = n / 96, dd = n % 96; sc = 0.10206207261596575f * LOG2E;
        drow = (dd < 64) ? n : h * 96 + 64 + ((dd - 64) < 16 ? 2 * (dd - 64) : 2 * (dd - 80) + 1);
    } else if (kind == 3) {
        drow = (n >> 7) * 256 + aux * 128 + (n & 127);
    }
}
__device__ __forceinline__ void tr_item(const float* W, int K, int N, bf16* WT, LAS float* scr, int item, int lane, int kind, int aux, const float* kscale = nullptr) {
    const int nblk = N / 32, kb = item / nblk, nb = item % nblk, k0 = 64 * kb, n0 = 32 * nb;
    float wv[32];
#pragma unroll
    for (int i = 0; i < 32; ++i) { const int kk = 2 * i + (lane >> 5); wv[i] = __builtin_nontemporal_load(W + (size_t)(k0 + kk) * N + n0 + (lane & 31)); }
#pragma unroll
    for (int i = 0; i < 32; ++i) { const int kk = 2 * i + (lane >> 5); scr[kk * 33 + (lane & 31)] = wv[i]; }
    LDS_WAIT(); asm volatile("" ::: "memory");
    const int c = lane & 7;
    float kg[8];
#pragma unroll
    for (int e = 0; e < 8; ++e) kg[e] = kscale ? kscale[k0 + 8 * c + e] : 1.0f;
#pragma unroll
    for (int j = 0; j < 4; ++j) { const int n = (lane >> 3) + 8 * j; const LAS float* s = scr + (8 * c) * 33 + n; int drow; float sc; wmap(kind, aux, n0 + n, drow, sc);
        float ks[8];
#pragma unroll
        for (int e = 0; e < 8; ++e) ks[e] = sc * kg[e];
        v4u o; o.x = pk2(s[0 * 33] * ks[0], s[1 * 33] * ks[1]); o.y = pk2(s[2 * 33] * ks[2], s[3 * 33] * ks[3]); o.z = pk2(s[4 * 33] * ks[4], s[5 * 33] * ks[5]); o.w = pk2(s[6 * 33] * ks[6], s[7 * 33] * ks[7]);
        *(GAS v4u*)(WT + (size_t)drow * K + k0 + 8 * c) = o; }
    LDS_WAIT(); asm volatile("" ::: "memory");
}
__device__ __forceinline__ void tr_item8(const float* W, int K, int N, unsigned char* WT, LAS float* scr, int item, int lane, int kind, int aux, float scale, const float* kscale = nullptr) {
    const int nblk = N / 32, kb = item / nblk, nb = item % nblk, k0 = 64 * kb, n0 = 32 * nb;
    float wv[32];
#pragma unroll
    for (int i = 0; i < 32; ++i) { const int kk = 2 * i + (lane >> 5); wv[i] = __builtin_nontemporal_load(W + (size_t)(k0 + kk) * N + n0 + (lane & 31)); }
#pragma unroll
    for (int i = 0; i < 32; ++i) { const int kk = 2 * i + (lane >> 5); scr[kk * 33 + (lane & 31)] = wv[i]; }
    LDS_WAIT(); asm volatile("" ::: "memory");
    const int c = lane & 7;
#pragma unroll
    for (int j = 0; j < 4; ++j) { const int n = (lane >> 3) + 8 * j; const LAS float* s = scr + (8 * c) * 33 + n; int drow; float sc; wmap(kind, aux, n0 + n, drow, sc); sc *= scale;
        float ks[8];
#pragma unroll
        for (int e = 0; e < 8; ++e) ks[e] = kscale ? sc * kscale[k0 + 8 * c + e] : sc;
        int w0 = __builtin_amdgcn_cvt_pk_fp8_f32(s[0 * 33] * ks[0], s[1 * 33] * ks[1], 0, false); w0 = __builtin_amdgcn_cvt_pk_fp8_f32(s[2 * 33] * ks[2], s[3 * 33] * ks[3], w0, true);
        int w1 = __builtin_amdgcn_cvt_pk_fp8_f32(s[4 * 33] * ks[4], s[5 * 33] * ks[5], 0, false); w1 = __builtin_amdgcn_cvt_pk_fp8_f32(s[6 * 33] * ks[6], s[7 * 33] * ks[7], w1, true);
        *(GAS v2u*)(WT + (size_t)drow * K + k0 + 8 * c) = (v2u){(unsigned)w0, (unsigned)w1}; }
    LDS_WAIT(); asm volatile("" ::: "memory");
}
__device__ __forceinline__ void row_load(const float* xrow, int lane, f32x4 (&v)[4]) {
    const GAS f32x4* xr = (const GAS f32x4*)xrow + lane;
#pragma unroll
    for (int j = 0; j < 4; ++j) v[j] = xr[64 * j];
}
__device__ __forceinline__ void rms_fin(const f32x4 (&gn)[4], bf16* orow, int lane, f32x4 (&v)[4]) {
    float s = 0.f;
#pragma unroll
    for (int j = 0; j < 4; ++j) s += (v[j].x * v[j].x + v[j].y * v[j].y) + (v[j].z * v[j].z + v[j].w * v[j].w);
    const float r = 1.0f / sqrtf(wave_sum(s, lane) * (1.f / D) + RMS_EPS);
    GAS unsigned long long* o8 = (GAS unsigned long long*)orow + lane;
#pragma unroll
    for (int j = 0; j < 4; ++j) { v[j] = v[j] * r * gn[j]; o8[64 * j] = (unsigned long long)pk2(v[j].x, v[j].y) | ((unsigned long long)pk2(v[j].z, v[j].w) << 32); }
}
__device__ __forceinline__ void rms_fin8(const f32x4 (&gn)[4], unsigned char* orow, int lane, f32x4 (&v)[4]) {
    float s = 0.f;
#pragma unroll
    for (int j = 0; j < 4; ++j) s += (v[j].x * v[j].x + v[j].y * v[j].y) + (v[j].z * v[j].z + v[j].w * v[j].w);
    const float r = 1.0f / sqrtf(wave_sum(s, lane) * (1.f / D) + RMS_EPS);
    GAS int* o4 = (GAS int*)orow + lane;
#pragma unroll
    for (int j = 0; j < 4; ++j) { v[j] = v[j] * r * gn[j]; int w = __builtin_amdgcn_cvt_pk_fp8_f32(v[j].x, v[j].y, 0, false); w = __builtin_amdgcn_cvt_pk_fp8_f32(v[j].z, v[j].w, w, true); o4[64 * j] = w; }
}
__device__ __forceinline__ void load_gain(const float* g, int lane, f32x4 (&gn)[4]) {
#pragma unroll
    for (int j = 0; j < 4; ++j) gn[j] = *((const GAS f32x4*)g + lane + 64 * j);
}
__device__ __forceinline__ void norm_rows(Frame& F, const float* x, const float* gain, bf16* out) {
    f32x4 gn[4]; load_gain(gain, F.lane, gn);
    const int r0 = F.bx * (T / 256) + F.wave * 16;
    f32x4 cur[4], nxt[4], nx2[4]; row_load(x + (size_t)r0 * D, F.lane, cur); row_load(x + (size_t)(r0 + 1) * D, F.lane, nxt);
    for (int i = 0; i < 16; ++i) { if (i + 2 < 16) row_load(x + (size_t)(r0 + i + 2) * D, F.lane, nx2);
        rms_fin(gn, out + (size_t)(r0 + i) * D, F.lane, cur);
#pragma unroll
        for (int j = 0; j < 4; ++j) { cur[j] = nxt[j]; nxt[j] = nx2[j]; } }
}

__device__ __forceinline__ void p0_prologue(Frame& F) {
    LAS float* scr = (LAS float*)(F.lds + RING_OFF + F.wave * 16384);
    const int gw = F.vcu * NWAVES + F.wave, NGW = F.G * NWAVES;
    constexpr int I_IN = 16 * 81, I_OUT = 16 * 32, I_UQ = 6 * 12, I_UKV = 2 * 16, I_L = I_IN + I_OUT + I_UQ + I_UKV, I_F = 16 * 88, I_F2 = 44 * 32;
    constexpr int NITEMS = 2 * I_L + 2 * I_F + I_F2;
    unsigned char* ws = gws();
    for (int it = gw; it < NITEMS; it += NGW) {
        int r = it;
        if (r < 2 * I_L) { const int l = r / I_L; r -= l * I_L;
            if (r < I_IN) { tr_item(gin(2) + (size_t)l * D * NQKV, D, NQKV, (bf16*)(ws + WS_WIN + l * WIN_L), scr, r, F.lane, 1, 0, l == 1 ? gin(1) + D : nullptr); continue; } r -= I_IN;
            if (r < I_OUT) { tr_item(gin(3) + (size_t)l * D * D, D, D, (bf16*)(ws + WS_WOUT + l * WOUT_L), scr, r, F.lane, 0, 0); continue; } r -= I_OUT;
            if (r < I_UQ) { tr_item(gin(7) + (size_t)l * 384 * 384, 384, 384, (bf16*)(ws + WS_WUQ + l * WUQ_L), scr, r, F.lane, 2, 0, gin(6) + l * 384); continue; } r -= I_UQ;
            tr_item(gin(9) + (size_t)l * 128 * 512, 128, 512, (bf16*)(ws + WS_WUKV + l * WUKV_L), scr, r, F.lane, 0, 0, gin(8) + l * 128); continue; }
        r -= 2 * I_L;
#if FFN8 == 1 || FFN8 == 2
        if (r < I_F) { tr_item8(gin(12), D, FF, ws + WS_W13, scr, r, F.lane, 3, 0, MOE_WSCALE, gin(11)); continue; } r -= I_F;
        if (r < I_F) { tr_item8(gin(13), D, FF, ws + WS_W13, scr, r, F.lane, 3, 1, MOE_WSCALE, gin(11)); continue; } r -= I_F;
#else
        if (r < I_F) { tr_item(gin(12), D, FF, (bf16*)(ws + WS_W13), scr, r, F.lane, 3, 0, gin(11)); continue; } r -= I_F;
        if (r < I_F) { tr_item(gin(13), D, FF, (bf16*)(ws + WS_W13), scr, r, F.lane, 3, 1, gin(11)); continue; } r -= I_F;
#endif
#if FFN8 == 1 || FFN8 == 3
        tr_item8(gin(14), FF, D, ws + WS_W2, scr, r, F.lane, 0, 0, MOE_WSCALE);
#else
        tr_item(gin(14), FF, D, (bf16*)(ws + WS_W2), scr, r, F.lane, 0, 0);
#endif
    }
    { const int gt = (F.vcu * NWAVES + F.wave) * 64 + F.lane, NGT = NGW * 64; const v4u z = {0u, 0u, 0u, 0u};
      for (int l = 0; l < 2; ++l) {
        GAS v4u* p = (GAS v4u*)(ws + WS_WIN + l * WIN_L + (size_t)NQKV * D * 2); const int n1 = (NQKVP - NQKV) * D * 2 / 16;
        for (int i = gt; i < n1; i += NGT) p[i] = z;
        GAS v4u* q = (GAS v4u*)(ws + WS_WUQ + l * WUQ_L + (size_t)384 * 384 * 2); const int n2 = 128 * 384 * 2 / 16;
        for (int i = gt; i < n2; i += NGT) q[i] = z; }
      const double invf[16] = {0.15915494309189535, 0.08949940160889101, 0.050329212104487035, 0.0283021958306234, 0.015915494309189534, 0.008949940160889102, 0.005032921210448704, 0.00283021958306234,
                               0.0015915494309189536, 0.0008949940160889102, 0.0005032921210448703, 0.00028302195830623395, 0.00015915494309189535, 8.949940160889102e-05, 5.0329212104487035e-05, 2.8302195830623396e-05};
      GAS f32x2* rt = (GAS f32x2*)(ws + WS_ROPE);
      for (int i = gt; i < S * 16; i += NGT) { const int pos = i >> 4, j = i & 15; double f = invf[0];
#pragma unroll
          for (int q = 1; q < 16; ++q) f = (j == q) ? invf[q] : f;
          const double rev = (double)pos * f; const float fr = (float)(rev - __builtin_floor(rev));
          rt[i] = (f32x2){__builtin_amdgcn_cosf(fr), __builtin_amdgcn_sinf(fr)}; } }
    norm_rows(F, gin(0), gin(1), (bf16*)(ws + WS_R1));
}
__device__ __forceinline__ void moe_weights(Frame& F) {
    LAS float* scr = (LAS float*)(F.lds + RING_OFF + F.wave * 16384);
    const int gw = F.vcu * NWAVES + F.wave, NGW = F.G * NWAVES;
    constexpr int I_U = 16 * 112, I_D = 56 * 32, I_E = 2 * I_U + I_D, NITEMS = NEXP * I_E;
    for (int it = gw; it < NITEMS; it += NGW) { const int e = it / I_E; int r = it - e * I_E;
        unsigned char* w13 = gws() + WS_MW13 + (size_t)e * 2 * FE * D; unsigned char* w2 = gws() + WS_MW2 + (size_t)e * D * FE;
        if (r < I_U) { tr_item8(gin(16) + (size_t)e * D * FE, D, FE, w13, scr, r, F.lane, 3, 0, MOE_WSCALE); continue; } r -= I_U;
        if (r < I_U) { tr_item8(gin(17) + (size_t)e * D * FE, D, FE, w13, scr, r, F.lane, 3, 1, MOE_WSCALE); continue; } r -= I_U;
        tr_item8(gin(18) + (size_t)e * FE * D, FE, D, w2, scr, r, F.lane, 0, 0, MOE_WSCALE); }
}

__device__ __forceinline__ void mla_prep(Frame& F, int layer) {
    bf16* qkv = (bf16*)(gws() + WS_QKV); const GAS f32x2* rope = (const GAS f32x2*)(gws() + WS_ROPE);
    const int lane = F.lane;
    const int r0 = F.bx * (T / 256) + F.wave * 16;
    float kpm = 0.f;
    float kmx = 0.f;
    for (int i0 = 0; i0 < 16; i0 += 4) { v2u kw4[4]; v4u kp4[4]; f32x2 cs4[4][4];
#pragma unroll
        for (int k = 0; k < 4; ++k) { const int row = r0 + i0 + k; kw4[k] = *((const GAS v2u*)(qkv + (size_t)row * NQKV + C_KA) + lane);
            if (lane < 4) { kp4[k] = *((const GAS v4u*)(qkv + (size_t)row * NQKV + C_KPE) + lane); const GAS f32x2* rt = rope + (size_t)(row & (S - 1)) * 16 + lane * 4; cs4[k][0] = rt[0]; cs4[k][1] = rt[1]; cs4[k][2] = rt[2]; cs4[k][3] = rt[3]; } }
#pragma unroll
        for (int k = 0; k < 4; ++k) { const int row = r0 + i0 + k;
            { const v2u kw = kw4[k]; const float k0 = bflo(kw.x), k1 = bfhi(kw.x), k2 = bflo(kw.y), k3 = bfhi(kw.y);
              float s2 = (k0 * k0 + k1 * k1) + (k2 * k2 + k3 * k3);
#pragma unroll
              for (int o_ = 1; o_ < 8; o_ <<= 1) s2 += __int_as_float(__builtin_amdgcn_ds_bpermute((lane ^ o_) << 2, __float_as_int(s2)));
              kmx = fmaxf(kmx, s2); }
            if (lane < 4) { GAS v4u* kp = (GAS v4u*)(qkv + (size_t)row * NQKV + C_KPE) + lane; const v4u k_ = kp4[k];
                const f32x2 c0 = cs4[k][0], c1 = cs4[k][1], c2 = cs4[k][2], c3 = cs4[k][3]; v4u ko;
                { const float a = bflo(k_.x), b = bfhi(k_.x); ko.x = pk2(a * c0.x - b * c0.y, b * c0.x + a * c0.y); }
                { const float a = bflo(k_.y), b = bfhi(k_.y); ko.y = pk2(a * c1.x - b * c1.y, b * c1.x + a * c1.y); }
                { const float a = bflo(k_.z), b = bfhi(k_.z); ko.z = pk2(a * c2.x - b * c2.y, b * c2.x + a * c2.y); }
                { const float a = bflo(k_.w), b = bfhi(k_.w); ko.w = pk2(a * c3.x - b * c3.y, b * c3.x + a * c3.y); }
                *kp = ko;
                float s2 = ((bflo(ko.x) * bflo(ko.x) + bfhi(ko.x) * bfhi(ko.x)) + (bflo(ko.y) * bflo(ko.y) + bfhi(ko.y) * bfhi(ko.y))) + ((bflo(ko.z) * bflo(ko.z) + bfhi(ko.z) * bfhi(ko.z)) + (bflo(ko.w) * bflo(ko.w) + bfhi(ko.w) * bfhi(ko.w)));
                s2 += __int_as_float(__builtin_amdgcn_ds_bpermute((lane ^ 1) << 2, __float_as_int(s2))); s2 += __int_as_float(__builtin_amdgcn_ds_bpermute((lane ^ 2) << 2, __float_as_int(s2)));
                kpm = fmaxf(kpm, s2); } } }
    if (lane == 0) __hip_atomic_fetch_max((unsigned*)gctl() + CW_KPE + layer * 4 + (r0 >> 13), __float_as_uint(kpm), __ATOMIC_RELAXED, __HIP_MEMORY_SCOPE_AGENT);
    if ((lane & 7) == 0) __hip_atomic_fetch_max((unsigned*)gctl() + CW_KMAX + layer * 32 + (r0 >> 13) * 8 + (lane >> 3), __float_as_uint(kmx), __ATOMIC_RELAXED, __HIP_MEMORY_SCOPE_AGENT);
}

__device__ __forceinline__ float xsum16(float v, int lane) {
#pragma unroll
    for (int o_ = 1; o_ < 16; o_ <<= 1) v += __int_as_float(__builtin_amdgcn_ds_bpermute((lane ^ o_) << 2, __float_as_int(v)));
    return v;
}
__device__ __forceinline__ void merge2(const bf16* pa, const bf16* pb, float la, float lb, bool two, int lane, float (&o)[4]) {
    const v2u a = *((const GAS v2u*)pa + lane); float w0 = 1.f, w1 = 0.f; v2u b = {0u, 0u};
    if (two) { b = *((const GAS v2u*)pb + lane); const float mx = fmaxf(la, lb); w0 = __builtin_amdgcn_exp2f(la - mx); w1 = __builtin_amdgcn_exp2f(lb - mx); const float inv = 1.0f / (w0 + w1); w0 *= inv; w1 *= inv; }
    o[0] = w0 * bflo(a.x) + w1 * bflo(b.x); o[1] = w0 * bfhi(a.x) + w1 * bfhi(b.x); o[2] = w0 * bflo(a.y) + w1 * bflo(b.y); o[3] = w0 * bfhi(a.y) + w1 * bfhi(b.y);
}
__device__ __forceinline__ void merge2r(const v2u a, const v2u b, float la, float lb, bool two, float (&o)[4]) {
    float w0 = 1.f, w1 = 0.f;
    if (two) { const float mx = fmaxf(la, lb); w0 = __builtin_amdgcn_exp2f(la - mx); w1 = __builtin_amdgcn_exp2f(lb - mx); const float inv = 1.0f / (w0 + w1); w0 *= inv; w1 *= inv; }
    o[0] = w0 * bflo(a.x) + w1 * bflo(b.x); o[1] = w0 * bfhi(a.x) + w1 * bfhi(b.x); o[2] = w0 * bflo(a.y) + w1 * bflo(b.y); o[3] = w0 * bfhi(a.y) + w1 * bfhi(b.y);
}
__device__ __forceinline__ void attn_combine(Frame& F, int layer) {
    const bf16* ob = (const bf16*)(gws() + WS_OB); const float* lse = (const float*)(gws() + WS_LSE); bf16* o = (bf16*)(gws() + WS_R1);
    const bf16* pa = (const bf16*)(gws() + WS_PA); const bf16* pc = (const bf16*)(gws() + WS_PC); const float* la = (const float*)(gws() + WS_LA); const float* lc = (const float*)(gws() + WS_LC);
    const int lane = F.lane, h = lane >> 4; const int r0 = F.bx * (T / 256) + F.wave * 16;
    float lam, osc;
    { const float* lp = gin(4) + layer * 128; float a = 0.f, b = 0.f;
      if (lane < 32) { a = lp[lane] * lp[32 + lane]; b = lp[64 + lane] * lp[96 + lane]; }
      a = wave_sum(a, lane); b = wave_sum(b, lane);
      const float lam_init = 0.8f - 0.6f * __expf(-0.3f * (float)layer); lam = __expf(a) - __expf(b) + lam_init; osc = 1.0f - lam_init; }
    const f32x4 sg = *((const GAS f32x4*)(gin(5) + layer * 64) + (lane & 15));
    const size_t TL = (size_t)T * 4, TO = (size_t)T * 256;
    const bool two = (r0 & (S - 1)) >= 4096;
    struct RowIn { float l[3]; v2u b[3]; float lcv[2]; v2u c[2]; float lav[4]; v2u a[4]; };
    for (int i0 = 0; i0 < 16; i0 += 4) { RowIn in[4];
#pragma unroll
        for (int k = 0; k < 4; ++k) { const int row = r0 + i0 + k; const size_t ro = (size_t)row * 256, rl = (size_t)row * 4 + h; RowIn& R = in[k];
            R.l[0] = lse[rl]; R.l[1] = lse[TL + rl]; R.l[2] = lse[2 * TL + rl];
            R.b[0] = *((const GAS v2u*)(ob + ro) + lane); R.b[1] = *((const GAS v2u*)(ob + TO + ro) + lane); R.b[2] = *((const GAS v2u*)(ob + 2 * TO + ro) + lane);
            R.lcv[0] = lc[rl]; R.c[0] = *((const GAS v2u*)(pc + ro) + lane); R.lav[0] = la[rl]; R.lav[2] = la[2 * TL + rl]; R.a[0] = *((const GAS v2u*)(pa + ro) + lane); R.a[2] = *((const GAS v2u*)(pa + 2 * TO + ro) + lane);
            R.lcv[1] = 0.f; R.lav[1] = 0.f; R.lav[3] = 0.f; R.c[1] = (v2u){0u, 0u}; R.a[1] = (v2u){0u, 0u}; R.a[3] = (v2u){0u, 0u};
            if (two) { R.lcv[1] = lc[TL + rl]; R.c[1] = *((const GAS v2u*)(pc + TO + ro) + lane); R.lav[1] = la[TL + rl]; R.lav[3] = la[3 * TL + rl]; R.a[1] = *((const GAS v2u*)(pa + TO + ro) + lane); R.a[3] = *((const GAS v2u*)(pa + 3 * TO + ro) + lane); } }
#pragma unroll
        for (int k = 0; k < 4; ++k) { const int row = r0 + i0 + k; const RowIn& R = in[k];
            { const float l0 = R.l[0], l1 = R.l[1], l2 = R.l[2];
              const float mx = fmaxf(l0, fmaxf(l1, l2)); float w0 = __builtin_amdgcn_exp2f(l0 - mx), w1 = __builtin_amdgcn_exp2f(l1 - mx), w2 = __builtin_amdgcn_exp2f(l2 - mx);
              const float inv = 1.0f / (w0 + w1 + w2); w0 *= inv; w1 *= inv; w2 *= inv;
              const v2u a = R.b[0], b = R.b[1], c = R.b[2];
              v2u r; r.x = pk2(w0 * bflo(a.x) + w1 * bflo(b.x) + w2 * bflo(c.x), w0 * bfhi(a.x) + w1 * bfhi(b.x) + w2 * bfhi(c.x));
              r.y = pk2(w0 * bflo(a.y) + w1 * bflo(b.y) + w2 * bflo(c.y), w0 * bfhi(a.y) + w1 * bfhi(b.y) + w2 * bfhi(c.y));
              *((GAS v2u*)(o + (size_t)row * D + 256) + lane) = r; }
            { float v[4]; merge2r(R.c[0], R.c[1], R.lcv[0], R.lcv[1], two, v);
              v2u r; r.x = pk2(v[0], v[1]); r.y = pk2(v[2], v[3]); *((GAS v2u*)(o + (size_t)row * D + 512) + lane) = r; }
            { float v0[4], v1[4]; merge2r(R.a[0], R.a[1], R.lav[0], R.lav[1], two, v0); merge2r(R.a[2], R.a[3], R.lav[2], R.lav[3], two, v1);
              float d[4], ss = 0.f;
#pragma unroll
              for (int e = 0; e < 4; ++e) { d[e] = v0[e] - lam * v1[e]; ss += d[e] * d[e]; }
              ss = xsum16(ss, lane); const float rs = (1.0f / sqrtf(ss * (1.0f / 64.0f) + RMS_EPS)) * osc;
              v2u r; r.x = pk2(d[0] * rs * sg.x, d[1] * rs * sg.y); r.y = pk2(d[2] * rs * sg.z, d[3] * rs * sg.w); *((GAS v2u*)(o + (size_t)row * D) + lane) = r; } } }
}

__device__ __forceinline__ void norm2_router(Frame& F, int layer, bool moe) {
    const float* x1 = gout(); bf16* h2 = (bf16*)(gws() + WS_R1); const int lane = F.lane;
    f32x4 gn[4]; load_gain(gin(11) + layer * D, lane, gn);
    const int r0 = F.bx * (T / 256) + F.wave * 16;
    f32x4 cur[4], nxt[4]; row_load(x1 + (size_t)r0 * D, lane, cur);
    if (!moe) {
        for (int i = 0; i < 16; ++i) { if (i + 1 < 16) row_load(x1 + (size_t)(r0 + i + 1) * D, lane, nxt);
            rms_fin(gn, h2 + (size_t)(r0 + i) * D, lane, cur);
#pragma unroll
            for (int j = 0; j < 4; ++j) cur[j] = nxt[j]; }
        return; }
    int* sel = (int*)(gws() + WS_RT + RT_SEL); float* gate = (float*)(gws() + WS_RT + RT_GATE);
    const float* rw = gin(15);
    volatile LAS unsigned* lh = F.MISC + 16;
    f32x4 wr[16][2];
#pragma unroll
    for (int j = 0; j < 4; ++j)
#pragma unroll
        for (int c = 0; c < 4; ++c) { const GAS f32x4* wp = (const GAS f32x4*)(rw + (size_t)(4 * lane + 256 * j + c) * 8); wr[j * 4 + c][0] = wp[0]; wr[j * 4 + c][1] = wp[1]; }
    f32x4 nx2[4]; row_load(x1 + (size_t)(r0 + 1) * D, lane, nxt);
    for (int i = 0; i < 16; ++i) { const int row = r0 + i; f32x4 v[4];
        if (i + 2 < 16) row_load(x1 + (size_t)(row + 2) * D, lane, nx2);
#pragma unroll
        for (int j = 0; j < 4; ++j) v[j] = cur[j];
        rms_fin8(gn, (unsigned char*)h2 + (size_t)row * D, lane, v);
#pragma unroll
        for (int j = 0; j < 4; ++j) { cur[j] = nxt[j]; nxt[j] = nx2[j]; }
        float lg[8];
#pragma unroll
        for (int e = 0; e < 8; ++e) lg[e] = 0.f;
#pragma unroll
        for (int j = 0; j < 4; ++j)
#pragma unroll
            for (int c = 0; c < 4; ++c) { const f32x4 wa = wr[j * 4 + c][0], wb = wr[j * 4 + c][1]; const float xv = v[j][c];
                lg[0] += xv * wa.x; lg[1] += xv * wa.y; lg[2] += xv * wa.z; lg[3] += xv * wa.w; lg[4] += xv * wb.x; lg[5] += xv * wb.y; lg[6] += xv * wb.z; lg[7] += xv * wb.w; }
#pragma unroll
        for (int e = 0; e < 8; ++e) lg[e] = wave_sum(lg[e], lane);
        int i1 = 0; float v1 = lg[0];
#pragma unroll
        for (int e = 1; e < 8; ++e) if (lg[e] > v1) { v1 = lg[e]; i1 = e; }
        int i2 = -1; float v2 = -3.0e38f;
#pragma unroll
        for (int e = 0; e < 8; ++e) if (e != i1 && lg[e] > v2) { v2 = lg[e]; i2 = e; }
        const float g1 = 1.0f / (1.0f + __expf(v2 - v1));
        if (lane == 0) { sel[row * 2] = i1; sel[row * 2 + 1] = i2; gate[row * 2] = g1; gate[row * 2 + 1] = 1.0f - g1;
            __hip_atomic_fetch_add((LAS unsigned*)lh + i1, 1u, __ATOMIC_RELAXED, __HIP_MEMORY_SCOPE_WORKGROUP); __hip_atomic_fetch_add((LAS unsigned*)lh + i2, 1u, __ATOMIC_RELAXED, __HIP_MEMORY_SCOPE_WORKGROUP); } }
    __syncthreads();
    if (F.tid < 8) __hip_atomic_store((unsigned*)gctl() + CW_HIST + F.bx * 8 + F.tid, (unsigned)lh[F.tid], RLX_AGENT);
    asm volatile("s_waitcnt vmcnt(0)" ::: "memory"); __syncthreads();
    if (F.tid == 0) { __builtin_amdgcn_fence(__ATOMIC_RELEASE, "agent"); (void)__hip_atomic_fetch_add((unsigned*)gctl() + CW_RDY, 1u, RLX_AGENT); }
}
__device__ __forceinline__ void hist_wait(Frame& F) {
    if (F.tid == 0) { unsigned sp_ = 0; while (__hip_atomic_load((unsigned*)gctl() + CW_RDY, RLX_AGENT) < (unsigned)F.G) { __builtin_amdgcn_s_sleep(2); if (++sp_ > (1u << 22)) break; }
        __builtin_amdgcn_fence(__ATOMIC_ACQUIRE, "agent"); }
    __syncthreads();
}

__device__ __forceinline__ void route_assign(Frame& F) {
    LAS int* L = (LAS int*)(F.lds + RING_OFF);
    const unsigned* hist = (const unsigned*)gctl() + CW_HIST;
    for (int i = F.tid; i < 2048; i += NWAVES * 64) L[i] = (int)__hip_atomic_load(hist + i, RLX_AGENT);
    __syncthreads();
    if (F.tid < 8) { int tot = 0, before = 0;
#pragma unroll 16
        for (int w = 0; w < 256; ++w) { const int c = L[w * 8 + F.tid]; tot += c; before += (w < F.bx) ? c : 0; } L[2048 + F.tid] = tot; L[2048 + 16 + F.tid] = before; }
    __syncthreads();
    if (F.tid == 0) { int ps = 0; for (int e = 0; e < 8; ++e) { const int c = L[2048 + e], pd = (c + 255) / 256 * 256; L[2048 + 8 + e] = ps; L[2048 + 16 + e] += ps; L[2048 + 24 + e] = pd; ps += pd; } L[2048 + 32] = ps / 256; }
    __syncthreads();
    const int* sel = (const int*)(gws() + WS_RT + RT_SEL); int* pos = (int*)(gws() + WS_RT + RT_POS); int* tokv = (int*)(gws() + WS_RT + RT_TOK); int* blk = (int*)(gws() + WS_RT + RT_BLK);
    if (F.wave == 0) {
        const int lane = F.lane; const unsigned long long lt = (1ull << lane) - 1ull;
        int run[8];
#pragma unroll
        for (int e = 0; e < 8; ++e) run[e] = L[2048 + 16 + e];
        int sl[2][2];
#pragma unroll
        for (int half = 0; half < 2; ++half) { const int row = F.bx * 128 + half * 64 + lane; sl[half][0] = sel[row * 2]; sl[half][1] = sel[row * 2 + 1]; }
#pragma unroll
        for (int half = 0; half < 2; ++half) { const int row = F.bx * 128 + half * 64 + lane; const int s0 = sl[half][0], s1 = sl[half][1]; int d0 = 0, d1 = 0;
#pragma unroll
            for (int e = 0; e < 8; ++e) { const unsigned long long m0 = __ballot(s0 == e), m1 = __ballot(s1 == e); const int rk = run[e] + __popcll(m0 & lt) + __popcll(m1 & lt);
                if (s0 == e) d0 = rk; if (s1 == e) d1 = rk; run[e] += __popcll(m0) + __popcll(m1); }
            pos[row * 2] = d0; pos[row * 2 + 1] = d1; tokv[d0] = row; tokv[d1] = row; }
    }
    if (F.bx == 0) {
        const int nblk = L[2048 + 32];
        for (int rb = F.tid; rb < 272; rb += NWAVES * 64) { int e = 0;
#pragma unroll
            for (int q = 0; q < 8; ++q) if (rb * 256 >= L[2048 + 8 + q] + L[2048 + 24 + q]) e = q + 1;
            blk[rb] = e > 7 ? 7 : e; }
        if (F.tid == 0) blk[272] = nblk;
        for (int e = 0; e < 8; ++e) { const int a = L[2048 + 8 + e] + L[2048 + e], b = L[2048 + 8 + e] + L[2048 + 24 + e]; for (int s = a + F.tid; s < b; s += NWAVES * 64) tokv[s] = 0; }
    }
}

__device__ __forceinline__ void final_combine(Frame& F, int mode, int w0) {
    const int lane = F.lane; f32x4 gn[4]; load_gain(gin(19), lane, gn);
    const int* pos = (const int*)(gws() + WS_RT + RT_POS); const float* gate = (const float*)(gws() + WS_RT + RT_GATE); const bf16* Y = (const bf16*)(gws() + WS_Y);
    const int gw = (F.bx - w0) * NWAVES + F.wave, NGW = (F.G - w0) * NWAVES; constexpr int MAINROWS = 256 * 256;
    if (gw < 0) return;
    f32x4 xc[4], xn[4]; v2u ac[4], bc[4], an[4], bn[4]; float g0c = 0.f, g1c = 0.f, g0n = 0.f, g1n = 0.f; int pmc = 0, pmn = 0;
#define FC_LOAD(row, X, A, B, G0, G1, PM) do { const int p0_ = pos[(row) * 2], p1_ = pos[(row) * 2 + 1]; PM = p0_ > p1_ ? p0_ : p1_; G0 = gate[(row) * 2]; G1 = gate[(row) * 2 + 1]; \
        const GAS f32x4* xr_ = (const GAS f32x4*)(gout() + (size_t)(row) * D) + lane; const GAS v2u* y0_ = (const GAS v2u*)(Y + (size_t)p0_ * D) + lane; const GAS v2u* y1_ = (const GAS v2u*)(Y + (size_t)p1_ * D) + lane; \
        _Pragma("unroll") for (int j = 0; j < 4; ++j) { X[j] = xr_[64 * j]; A[j] = y0_[64 * j]; B[j] = y1_[64 * j]; } } while (0)
#define FC_FINISH(row) do { f32x4 v[4]; float s = 0.f; \
        _Pragma("unroll") for (int j = 0; j < 4; ++j) { const v2u a = ac[j], b = bc[j]; f32x4 x = xc[j]; \
            x.x += g0c * bflo(a.x) + g1c * bflo(b.x); x.y += g0c * bfhi(a.x) + g1c * bfhi(b.x); x.z += g0c * bflo(a.y) + g1c * bflo(b.y); x.w += g0c * bfhi(a.y) + g1c * bfhi(b.y); \
            v[j] = x; s += (x.x * x.x + x.y * x.y) + (x.z * x.z + x.w * x.w); } \
        const float r = 1.0f / sqrtf(wave_sum(s, lane) * (1.f / D) + RMS_EPS); \
        GAS f32x4* xw = (GAS f32x4*)(gout() + (size_t)(row) * D) + lane; \
        _Pragma("unroll") for (int j = 0; j < 4; ++j) xw[64 * j] = v[j] * r * gn[j]; } while (0)
    if (mode == 0) {
        if (gw < T) FC_LOAD(gw, xc, ac, bc, g0c, g1c, pmc);
        for (int row = gw; row < T; row += NGW) {
            if (row + NGW < T) FC_LOAD(row + NGW, xn, an, bn, g0n, g1n, pmn);
            if (pmc < MAINROWS) FC_FINISH(row);
#pragma unroll
            for (int j = 0; j < 4; ++j) { xc[j] = xn[j]; ac[j] = an[j]; bc[j] = bn[j]; }
            g0c = g0n; g1c = g1n; pmc = pmn; }
    } else {
        int pm16[16];
#pragma unroll
        for (int k = 0; k < 16; ++k) { const int row = gw + k * NGW; int p0_ = 0, p1_ = 0; if (row < T) { p0_ = pos[row * 2]; p1_ = pos[row * 2 + 1]; } pm16[k] = p0_ > p1_ ? p0_ : p1_; }
#pragma unroll
        for (int k = 0; k < 16; ++k) { const int row = gw + k * NGW;
            if (pm16[k] >= MAINROWS) { FC_LOAD(row, xc, ac, bc, g0c, g1c, pmc); FC_FINISH(row); } }
        for (int row = gw + 16 * NGW; row < T; row += NGW) { const int p0_ = pos[row * 2], p1_ = pos[row * 2 + 1];
            if ((p0_ > p1_ ? p0_ : p1_) < MAINROWS) continue;
            FC_LOAD(row, xc, ac, bc, g0c, g1c, pmc); FC_FINISH(row); }
    }
#undef FC_LOAD
#undef FC_FINISH
}
__device__ __forceinline__ int q_first(Frame& F, gu32* head) {
    __syncthreads();
    if (F.tid == 0) F.MISC[24] = __hip_atomic_fetch_add(head, 1u, RLX_AGENT);
    __syncthreads(); const int u = __builtin_amdgcn_readfirstlane((int)F.MISC[24]); __syncthreads(); return u;
}
#define ATT_QARGS (unsigned*)qh_, (volatile LAS unsigned*)(F.MISC + 24), F.wave
#define ATT_LOOP(head, NUNITS, ...) do { gu32* qh_ = (head); int u_ = q_first(F, qh_); while (u_ < (NUNITS)) { bool ran_ = false; \
        { const int u = u_; __VA_ARGS__ } if (ran_) u_ = __builtin_amdgcn_readfirstlane((int)F.MISC[24]); else u_ = q_first(F, qh_); } } while (0)

#ifndef ATT_PIPE_C
#define ATT_PIPE_C 0
#endif
#ifndef ATT_PIPE_D
#define ATT_PIPE_D 0
#endif
#ifndef ATT_PIPE_B
#define ATT_PIPE_B 0
#endif
__device__ __forceinline__ void attn_phase(Frame& F, int layer, int rep = 0) {
    char* shm = (char*)F.lds + RING_OFF;
    const att::bf16_t* qkv = (const att::bf16_t*)(gws() + WS_QKV); const att::bf16_t* qm = (const att::bf16_t*)(gws() + WS_QM); const att::bf16_t* kvm = (const att::bf16_t*)(gws() + WS_KVM);
    att::bf16_t* o = (att::bf16_t*)(gws() + WS_R1); att::bf16_t* ob = (att::bf16_t*)(gws() + WS_OB); float* lse = (float*)(gws() + WS_LSE);
    att::bf16_t* pa = (att::bf16_t*)(gws() + WS_PA); att::bf16_t* pc = (att::bf16_t*)(gws() + WS_PC); float* la = (float*)(gws() + WS_LA); float* lc = (float*)(gws() + WS_LC);
    gu32* heads = gctl() + CW_Q + layer * 4 * 64 + rep * 512;
    const int BIG = 1 << 28;
    __syncthreads();
    if (F.tid < 68) { const unsigned* src = (const unsigned*)gctl() + (F.tid < 32 ? CW_KMAX + layer * 32 + F.tid : F.tid < 64 ? CW_KMAXC + layer * 32 + (F.tid - 32) : CW_KPE + layer * 4 + (F.tid - 64));
        F.MISC[32 + F.tid] = __hip_atomic_load(src, RLX_AGENT); }
#ifndef DBG_SKIP_C
#define DBG_SKIP_C 0
#endif
#ifndef PROBE_AC
#define PROBE_AC 0
#endif
  for (int pass = 0; pass < (PROBE_AC ? 2 : 1); ++pass)
    ATT_LOOP(heads + pass * 64, 1568, {
        const bool isC = (u >= 196 && u < 980);
        if (pass == 1 && (isC ? PROBE_AC != 2 : PROBE_AC != 1)) { }
        else if (isC) {
            const int i = u - 196; int qb, bh, ck;
            if (i < 272) { ck = 0; bh = i / 17; qb = 31 - (i % 17); }   else { const int j = i - 272, g = j >> 5, r = j & 31; if (r < 16) { ck = 1; qb = 31 - g; bh = r; } else { ck = 0; qb = 14 - g; bh = r - 16; } }
            if (qb >= 0 && !DBG_SKIP_C) {
                const int b_ = bh >> 2, h = bh & 3, nt = 4 * qb + 4; const long rb = (long)b_ * S;
                att::Job J; J.Q = qm + rb * 384 + h * 96; J.qs = 384; J.K0 = kvm + rb * 512 + h * 128; J.ks0 = 512; J.K1 = qkv + rb * NQKV + C_KPE; J.ks1 = NQKV;
                J.V = kvm + rb * 512 + h * 128 + 64; J.vs = 512; J.O = pc + (size_t)ck * T * 256 + rb * 256 + h * 64; J.os = 256; J.omap = 0; J.LSE = lc + (size_t)ck * T * 4 + rb * 4 + h; J.ls = 4; J.lmap = 0;
                J.q0 = qb * 256; J.t_lo = ck ? 0 : (nt > 64 ? nt - 64 : 0); J.t_hi = ck ? nt - 64 : nt; J.max_dist = BIG; J.slope2 = 0.f; J.sink2 = 0.f; J.rope = (const att::f32x2_t*)(gws() + WS_ROPE); J.kmax2[1] = 0.f;
                J.kmax2[0] = (__uint_as_float(__builtin_amdgcn_readfirstlane(F.MISC[64 + bh * 2])) + __uint_as_float(__builtin_amdgcn_readfirstlane(F.MISC[64 + bh * 2 + 1]))) + __uint_as_float(__builtin_amdgcn_readfirstlane(F.MISC[96 + b_]));
#ifndef PROBE_XP
#define PROBE_XP 0
#endif
#ifndef PROBE_STAG
#define PROBE_STAG 0
#endif
#ifndef ATT_SMAX_C
#define ATT_SMAX_C 1
#endif
#ifndef ATT_STAG_C
#define ATT_STAG_C 0
#endif
                if (pass == 1) { J.O = (att::bf16_t*)(gws() + (size_t)470 * MiB) + (size_t)ck * T * 256 + rb * 256 + h * 64; J.LSE = (float*)(gws() + (size_t)504 * MiB) + (size_t)ck * T * 4 + rb * 4 + h;
                    att::attn_unit<6, 1, false, 1, true, true, PROBE_XP, (PROBE_STAG != 0)>(J, shm, ATT_QARGS); }
                else if constexpr (ATT_PIPE_C) att::attn_unit2<6, false, 1, true>(J, shm, ATT_QARGS); else att::attn_unit<6, 1, false, 1, true, (ATT_SMAX_C != 0), 0, (ATT_STAG_C != 0)>(J, shm, ATT_QARGS);
                ran_ = true;
            }
        } else {
            const int i = u < 196 ? u : u - 784; const int h = 3 - i / 196, ii = i % 196; int qb, b_, ck;
            if (ii < 68) { ck = 0; qb = 31 - (ii >> 2); b_ = ii & 3; } else { const int j = ii - 68, g = j >> 3, r = j & 7; if (r < 4) { ck = 1; qb = 31 - g; b_ = r; } else { ck = 0; qb = 14 - g; b_ = r - 4; } }
            if (qb >= 0) {
                const int nt = 4 * qb + 4; const long rb = (long)b_ * S;
                att::Job J; J.Q = qkv + rb * NQKV + C_QA + h * 64; J.qs = NQKV; J.K0 = qkv + rb * NQKV + C_KA + h * 64; J.ks0 = NQKV; J.K1 = nullptr; J.ks1 = 0;
                J.V = qkv + rb * NQKV + C_VA + h * 64; J.vs = NQKV; J.O = pa + (size_t)ck * T * 256 + rb * 256 + h * 64; J.os = 256; J.omap = (long)2 * T * 256;
                J.LSE = la + (size_t)ck * T * 4 + rb * 4 + h; J.ls = 4; J.lmap = (long)2 * T * 4;
                J.q0 = qb * 256; J.t_lo = ck ? 0 : (nt > 64 ? nt - 64 : 0); J.t_hi = ck ? nt - 64 : nt; J.max_dist = BIG; J.slope2 = exp2f(-(2.f / 3.f) * (float)(3 * h + 1)) * LOG2E; J.sink2 = 0.f; J.rope = nullptr;
                J.kmax2[0] = __uint_as_float(__builtin_amdgcn_readfirstlane(F.MISC[32 + b_ * 8 + h * 2])); J.kmax2[1] = __uint_as_float(__builtin_amdgcn_readfirstlane(F.MISC[32 + b_ * 8 + h * 2 + 1]));
                att::attn_unit<2, 2, true, 1, false, true>(J, shm, ATT_QARGS); ran_ = true;
            }
        }
    });
    __syncthreads();
    {
        char* wl = shm + F.wave * att::BW_LDS; float* wsfb = (float*)((char*)F.lds + MISC_OFF + 1024) + F.wave * 64;
#ifndef PROBE_BAND
#define PROBE_BAND 1
#endif
      for (int pass = 0; pass < PROBE_BAND; ++pass) {
        gu32* bq = heads + (2 + pass) * 64;
        int u = q_first(F, bq); int par_ = 0;
        while (u < 2048) {
            unsigned un_ = 0; if (F.tid == 0) un_ = __hip_atomic_fetch_add(bq, 1u, RLX_AGENT);
            const int ws_ = F.wave;
            att::Job J; J.K1 = nullptr; J.ks1 = 0; J.omap = 0; J.lmap = 0; J.rope = nullptr; J.kmax2[0] = 0.f; J.kmax2[1] = 0.f; J.t_lo = 0; J.t_hi = 0;
            if (u < 512) {
                const int qb = u >> 4, bh = u & 15, b_ = bh >> 2, h = bh & 3, g = h >> 1; const long rb = (long)b_ * S;
                J.Q = qkv + rb * NQKV + C_QD + h * 64; J.qs = NQKV; J.K0 = qkv + rb * NQKV + C_KD + g * 64; J.ks0 = NQKV; J.V = qkv + rb * NQKV + C_VD + g * 64; J.vs = NQKV;
                J.O = o + rb * D + 768 + h * 64; J.os = D; J.LSE = nullptr; J.ls = 0; J.q0 = qb * 256; J.max_dist = 127; J.slope2 = exp2f(-2.f * (float)(h + 1)) * LOG2E;
                J.sink2 = __builtin_bit_cast(float, __builtin_amdgcn_readfirstlane(__builtin_bit_cast(int, gin(10)[layer * 4 + h]))) * LOG2E;
                att::band_wave<3>(J, wl, wsfb, ws_, un_, F.MISC + 26 + par_);
            } else {
                const int v = u - 512, pat = v >> 9, w2 = v & 511, bh = w2 & 15, b_ = bh >> 2, h = bh & 3, w = w2 >> 4;
                const int dsh = 2 * pat, d = 1 << dsh; const int nblk = 32 >> dsh, cls = w / nblk, qb = w % nblk; const long rb = (long)b_ * S + cls;
                J.Q = qkv + rb * NQKV + C_QB + h * 64; J.qs = NQKV * d; J.K0 = qkv + rb * NQKV + C_KB + h * 64; J.ks0 = NQKV * d; J.V = qkv + rb * NQKV + C_VB + h * 64; J.vs = NQKV * d;
                J.O = ob + (size_t)pat * T * 256 + rb * 256 + h * 64; J.os = 256 * d; J.LSE = lse + (size_t)pat * T * 4 + rb * 4 + h; J.ls = 4 * d;
                J.q0 = qb * 256; J.max_dist = 128; J.slope2 = exp2f(-(2.f / 3.f) * (float)(3 * h + 2)) * (float)d * LOG2E; J.sink2 = 0.f;
                att::band_wave<1>(J, wl, wsfb, ws_, un_, F.MISC + 26 + par_);
            }
            asm volatile("s_waitcnt lgkmcnt(0)\n\ts_barrier" ::: "memory"); u = __builtin_amdgcn_readfirstlane((int)F.MISC[26 + par_]); par_ ^= 1;
        }
      }
    }
}

constexpr int G1_DEFER = 5;
struct SkipColOrder { pg8::StaticOrder s;
    __device__ __forceinline__ bool next(int i, pg8::Unit& u) const { if (!s.next(i, u)) return false; if (u.pn >= G1_DEFER) ++u.pn; return true; } };
struct OneTileOrder { int pm, pn;
    __device__ __forceinline__ bool next(int i, pg8::Unit& u) const { if (pm < 0 || i >= 1) return false; u.pm = pm; u.pa = pm; u.pn = pn; return true; } };

struct MoeUpOrder { int rbl, e, pn0, cnt;
    __device__ __forceinline__ bool next(int i, pg8::Unit& u) const { if (rbl < 0 || i >= cnt) return false; u.pm = rbl; u.pa = 0; u.pn = e * 28 + pn0 + i; return true; } };
struct MoeDownOrder { int rbl, e, pn0;
    __device__ __forceinline__ bool next(int i, pg8::Unit& u) const { if (rbl < 0 || i >= 1) return false; u.pm = rbl; u.pa = rbl; u.pn = e * 4 + pn0; return true; } };

__device__ __forceinline__ Frame fresh(const Frame& F) { Frame P = F; int lane_; asm volatile("v_mbcnt_lo_u32_b32 %0, -1, 0\n\tv_mbcnt_hi_u32_b32 %0, -1, %0" : "=v"(lane_) :: "memory"); asm volatile("" : "+s"(P.wave), "+s"(P.bx), "+s"(P.G));
    P.lane = lane_; P.tid = P.wave * 64 + lane_; P.vcu = (P.bx % 8) * (P.G / 8) + P.bx / 8; return P; }
#ifndef WGM_G4
#define WGM_G4 6
#endif
#ifndef WGM_G1
#define WGM_G1 8
#endif
#ifndef REP_P0
#define REP_P0 1
#endif
#ifndef REP_G1
#define REP_G1 1
#endif
#ifndef REP_G2
#define REP_G2 1
#endif
#ifndef REP_AT
#define REP_AT 1
#endif
#ifndef REP_CB
#define REP_CB 1
#endif
#ifndef REP_G4
#define REP_G4 1
#endif
#ifndef REP_N1
#define REP_N1 1
#endif
#ifndef REP_MW
#define REP_MW 1
#endif
#ifndef REP_G6
#define REP_G6 1
#endif
#ifndef REP_G7
#define REP_G7 1
#endif
#ifndef REP_R2
#define REP_R2 1
#endif
struct Args { const float* in[20]; float* out; unsigned char* ws; int ph_lo, ph_hi, li, pad; };
__global__ void __launch_bounds__(NWAVES * 64, 2) fwd(Args args) {
    extern __shared__ __attribute__((aligned(16))) unsigned char lds[];
    Frame F0;
    F0.lds = (LAS unsigned char*)lds;
    F0.MISC = (volatile LAS unsigned*)(F0.lds + MISC_OFF);
    F0.tid = 0; F0.lane = 0; F0.wave = __builtin_amdgcn_readfirstlane((int)threadIdx.x >> 6);
    F0.G = gridDim.x; F0.bx = blockIdx.x; F0.vcu = 0;
    for (int u = threadIdx.x; u < (LDS_BYTES - LDSCTL_OFF) / 4; u += NWAVES * 64) ((LAS unsigned*)(F0.lds + LDSCTL_OFF))[u] = 0u;
    __syncthreads();
#define KA_LO (*(const int CAS*)(kargs() + 176))
#define KA_HI (*(const int CAS*)(kargs() + 180))
#define KA_LI (*(const int CAS*)(kargs() + 184))
#define MK_BAR() XcdBarrier bar; bar.bar = (unsigned*)(gctl() + CW_BAR) + KA_LI * XCD_BAR_WORDS; bar.x = xb_xcc_id(); bar.st = (volatile LAS unsigned*)((LAS unsigned char*)lds + MISC_OFF) + 8
    if (!MK_PER_PHASE) { MK_BAR(); (void)xcd_barrier_post(bar.bar, bar.st); }
    int ph = 0;
#define PH_ON() (ph >= KA_LO && ph < KA_HI)
#define PH_END() do { if (PH_ON() && ph + 1 < KA_HI) { if (MK_PER_PHASE) { if (threadIdx.x == 0) __hip_atomic_store(gctl() + CW_TMO, 0xBADBA0u, RLX_AGENT); } else { MK_BAR(); xcd_barrier(bar); } } ++ph; } while (0)
#define ws gws()
#define R1 ((bf16*)(gws() + WS_R1))
#define QKV ((bf16*)(gws() + WS_QKV))

    if (PH_ON()) for (int rep = 0; rep < REP_P0; ++rep) { Frame F = fresh(F0); p0_prologue(F); }
    PH_END();
#ifndef PROBE_NBAR
#define PROBE_NBAR 0
#endif
    for (int xb_ = 0; xb_ < PROBE_NBAR; ++xb_) { MK_BAR(); xcd_barrier(bar); }
    for (int l = 0; l < 2; ++l) {
        if (PH_ON()) for (int rep = 0; rep < REP_G1; ++rep) { Frame F = fresh(F0); pg8::Gemm g{R1, (const bf16*)(ws + WS_WIN + l * WIN_L), D, D, nullptr}; SkipColOrder So; So.s.init(T, NQKVP - 256, F.G, F.bx, WGM_G1);
            pg8::EpiBf16Q E{QKV, NQKV, NQKV, l == 1 ? (const float*)(ws + WS_SSQ) : nullptr, (float*)(ws + WS_SSQ2)}; pg8::gemm_phase<pg8::EpiBf16Q, SkipColOrder>(F.lds + RING_OFF, g, So, E, F.wave); }
        PH_END();
        if (PH_ON()) for (int rep = 0; rep < REP_G2; ++rep) { Frame F = fresh(F0); const int half = F.G / 2;
            if (rep == 0) mla_prep(F, l);
            { pg8::Gemm g{QKV + C_CKV, (const bf16*)(ws + WS_WUKV + l * WUKV_L), 128, NQKV, nullptr}; pg8::StaticOrder So; So.init(T, 512, F.G, F.bx);
              pg8::EpiBf16K E{(bf16*)(ws + WS_KVM), (unsigned*)gctl() + CW_KMAXC + l * 32, (const float*)(ws + WS_SSQ2)}; pg8::gemm_phase<pg8::EpiBf16K, pg8::StaticOrder>(F.lds + RING_OFF, g, So, E, F.wave); }
            if (F.bx < half) {
              pg8::Gemm g{QKV + C_CQ, (const bf16*)(ws + WS_WUQ + l * WUQ_L), 384, NQKV, nullptr}; pg8::StaticOrder So; So.init(T, 512, half, F.bx);
              pg8::EpiBf16R E{(bf16*)(ws + WS_QM), (const float*)(ws + WS_SSQ2)}; pg8::gemm_phase<pg8::EpiBf16R, pg8::StaticOrder>(F.lds + RING_OFF, g, So, E, F.wave);
            } else {
              pg8::Gemm g{R1, (const bf16*)(ws + WS_WIN + l * WIN_L), D, D, nullptr}; OneTileOrder So; So.pm = F.bx - half < T / 256 ? F.bx - half : -1; So.pn = G1_DEFER;
              pg8::EpiBf16 E{QKV, NQKV, NQKV, 0, 1.0f, l == 1 ? (const float*)(ws + WS_SSQ) : nullptr}; pg8::gemm_phase<pg8::EpiBf16, OneTileOrder>(F.lds + RING_OFF, g, So, E, F.wave); }
        }
        PH_END();
        if (PH_ON()) for (int rep = 0; rep < REP_AT; ++rep) { Frame F = fresh(F0); attn_phase(F, l, rep); }
        PH_END();
        if (PH_ON()) for (int rep = 0; rep < REP_CB; ++rep) { Frame F = fresh(F0); attn_combine(F, l); }
        PH_END();
        if (PH_ON()) { Frame F = fresh(F0); pg8::Gemm g{R1, (const bf16*)(ws + WS_WOUT + l * WOUT_L), D, D, nullptr}; pg8::StaticOrder So; So.init(T, D, F.G, F.bx);
            pg8::EpiResid E{l == 0 ? gin(0) : (const float*)gout(), gout(), D, l == 0 ? (bf16*)(ws + WS_XB) : nullptr, l == 0 ? (float*)(ws + WS_SSQ) : nullptr, 1.0f, (FFN8 == 1 || FFN8 == 2)}; pg8::gemm_phase<pg8::EpiResid, pg8::StaticOrder>(F.lds + RING_OFF, g, So, E, F.wave); }
        PH_END();
        if (l == 1) {
        if (PH_ON()) { Frame F = fresh(F0); norm2_router(F, l, true); for (int rep = 0; rep < REP_MW; ++rep) moe_weights(F);
            __syncthreads(); hist_wait(F); route_assign(F); }
        PH_END();
        }
        if (l == 0) {
            if (PH_ON()) for (int rep = 0; rep < REP_G4; ++rep) { Frame F = fresh(F0); pg8::StaticOrder So; So.init(T, 2 * FF, F.G, F.bx, WGM_G4);
#if FFN8 == 1 || FFN8 == 2
                pg8::Gemm g{(const bf16*)(ws + WS_XB), (const bf16*)(ws + WS_W13), D / 2, D / 2, nullptr};
#if FFN8 == 1
                pg8::EpiSwiglu8 E{(void*)(ws + WS_G), FF, 22, 1.0f / MOE_WSCALE, (const float*)(ws + WS_SSQ)}; pg8::gemm_phase<pg8::EpiSwiglu8, pg8::StaticOrder, false, true>(F.lds + RING_OFF, g, So, E, F.wave); }
#else
                pg8::EpiSwiglu E{(void*)(ws + WS_G), FF, 22, 1.0f / MOE_WSCALE, (const float*)(ws + WS_SSQ)}; pg8::gemm_phase<pg8::EpiSwiglu, pg8::StaticOrder, false, true>(F.lds + RING_OFF, g, So, E, F.wave); }
#endif
#else
                pg8::Gemm g{(const bf16*)(ws + WS_XB), (const bf16*)(ws + WS_W13), D, D, nullptr};
#if FFN8 == 3
                pg8::EpiSwiglu8 E{(void*)(ws + WS_G), FF, 22, 1.0f, (const float*)(ws + WS_SSQ)}; pg8::gemm_phase<pg8::EpiSwiglu8, pg8::StaticOrder>(F.lds + RING_OFF, g, So, E, F.wave); }
#else
                pg8::EpiSwiglu E{(void*)(ws + WS_G), FF, 22, 1.0f, (const float*)(ws + WS_SSQ)}; pg8::gemm_phase<pg8::EpiSwiglu, pg8::StaticOrder>(F.lds + RING_OFF, g, So, E, F.wave); }
#endif
#endif
            PH_END();
            if (PH_ON()) { Frame F = fresh(F0); pg8::StaticOrder So; So.init(T, D, F.G, F.bx);
#if FFN8 == 1 || FFN8 == 3
                pg8::Gemm g{(const bf16*)(ws + WS_G), (const bf16*)(ws + WS_W2), FF / 2, FF / 2, nullptr};
                pg8::EpiResid E{(const float*)gout(), gout(), D, R1, (float*)(ws + WS_SSQ), 1.0f / MOE_WSCALE, false}; pg8::gemm_phase<pg8::EpiResid, pg8::StaticOrder, false, true>(F.lds + RING_OFF, g, So, E, F.wave); }
#else
                pg8::Gemm g{(const bf16*)(ws + WS_G), (const bf16*)(ws + WS_W2), FF, FF, nullptr};
                pg8::EpiResid E{(const float*)gout(), gout(), D, R1, (float*)(ws + WS_SSQ)}; pg8::gemm_phase<pg8::EpiResid, pg8::StaticOrder>(F.lds + RING_OFF, g, So, E, F.wave); }
#endif
            PH_END();
        } else {
            const int* blk = (const int*)(ws + WS_RT + RT_BLK); const int* tokv = (const int*)(ws + WS_RT + RT_TOK);
            for (int p = 0; p < 6; ++p) {
                if (PH_ON()) {
                    if (p >= 1) for (int rep = 0; rep < REP_G7; ++rep) { Frame F = fresh(F0); const int q = p - 1; const int nblk = __builtin_amdgcn_readfirstlane(blk[272]); const int nrem4 = nblk > 256 ? (nblk - 256) * 4 : 0;
                        const bool rem = (q == 4);
                        const int rb = rem ? 256 + (F.bx >> 2) : q * 64 + (F.vcu >> 2); MoeDownOrder So; So.rbl = rb < nblk ? (rem ? (F.bx >> 2) : (F.vcu >> 2)) : -1; So.e = rb < nblk ? __builtin_amdgcn_readfirstlane(blk[rb]) : 0; So.pn0 = rem ? (F.bx & 3) : (F.vcu & 3);
                        if (!rem || F.bx < nrem4) {
                            pg8::Gemm g{(const bf16*)(ws + WS_GM + (size_t)(q & 1) * GM_L), (const bf16*)(ws + WS_MW2), FE / 2, FE / 2, nullptr};
                            pg8::EpiBf16 E{(bf16*)(ws + WS_Y) + (size_t)q * 64 * 256 * D, D, D, 4, 1.0f / MOE_WSCALE}; pg8::gemm_phase<pg8::EpiBf16, MoeDownOrder, false, true>(F.lds + RING_OFF, g, So, E, F.wave); }
                        else final_combine(F, 0, nrem4); }
                    if (p <= 4) for (int rep = 0; rep < REP_G6; ++rep) { Frame F = fresh(F0); const int nblk = __builtin_amdgcn_readfirstlane(blk[272]);
                        const bool rem6 = (p == 4); const int lb = rem6 ? F.vcu / 28 : (F.vcu >> 2);
                        const int rb = p * 64 + lb; MoeUpOrder So; So.rbl = rb < nblk ? lb : -1; So.e = rb < nblk ? __builtin_amdgcn_readfirstlane(blk[rb]) : 0; So.pn0 = rem6 ? F.vcu % 28 : (F.vcu & 3) * 7; So.cnt = rem6 ? 1 : 7;
                        pg8::Gemm g{R1, (const bf16*)(ws + WS_MW13), D / 2, D / 2, tokv + (rb < nblk ? rb : 0) * 256};
                        pg8::EpiSwiglu8 E{(void*)(ws + WS_GM + (size_t)(p & 1) * GM_L), FE, 28, 1.0f / MOE_WSCALE}; pg8::gemm_phase<pg8::EpiSwiglu8, MoeUpOrder, true, true>(F.lds + RING_OFF, g, So, E, F.wave); }
                }
                PH_END();
            }
            if (PH_ON()) { Frame F = fresh(F0); final_combine(F, 1, 0); }
            PH_END();
        }
    }
#undef PH_ON
#undef PH_END
#undef ws
#undef R1
#undef QKV
}
static_assert(sizeof(Args) == 192 && offsetof(Args, out) == 160 && offsetof(Args, ws) == 168 && offsetof(Args, ph_lo) == 176 && offsetof(Args, ph_hi) == 180 && offsetof(Args, li) == 184, "kernarg offsets");
constexpr int N_PHASES = 1 + (5 + 2) + (5 + 1 + 6 + 1);

extern "C" void kernel_launch(void* const* d_in, const int* in_sizes, int n_in, void* d_out, int out_size, void* d_ws, size_t ws_size, hipStream_t stream) {
    static int grid = 0;
    if (grid == 0) {
        if (n_in != 20 || in_sizes[0] != T * D || out_size != T * D || ws_size < WS_END) { fprintf(stderr, "kernel_launch: unexpected shapes (n_in %d, in0 %d, out %d, ws %zu < %zu); nothing launched\n", n_in, n_in > 0 ? in_sizes[0] : -1, out_size, ws_size, (size_t)WS_END); grid = -1; return; }
        int dev = 0, cus = 0, per_cu = 0;
        if (hipGetDevice(&dev) != hipSuccess || hipDeviceGetAttribute(&cus, hipDeviceAttributeMultiprocessorCount, dev) != hipSuccess) { grid = -1; return; }
        if (hipFuncSetAttribute((const void*)fwd, hipFuncAttributeMaxDynamicSharedMemorySize, LDS_BYTES) != hipSuccess) { fprintf(stderr, "kernel_launch: hipFuncSetAttribute failed\n"); grid = -1; return; }
        if (hipOccupancyMaxActiveBlocksPerMultiprocessor(&per_cu, (const void*)fwd, NWAVES * 64, LDS_BYTES) != hipSuccess || per_cu < 1) { fprintf(stderr, "kernel_launch: occupancy query reports %d workgroups per CU\n", per_cu); }
        (void)hipGetLastError();
        if (cus < 256) { fprintf(stderr, "kernel_launch: %d CUs < 256: the 256-workgroup grid would not be resident; nothing launched\n", cus); grid = -1; return; }
        grid = 256;
    }
    if (grid < 0) return;
    if (hipMemsetAsync((char*)d_ws + WS_CTL, 0, CTL_ZERO_BYTES, stream) != hipSuccess) return;
    Args a{};
    for (int i = 0; i < 20; ++i) a.in[i] = (const float*)d_in[i];
    a.out = (float*)d_out; a.ws = (unsigned char*)d_ws; a.pad = 0;
#if MK_PER_PHASE
    for (int li = 0; li < N_PHASES; ++li) { a.ph_lo = li; a.ph_hi = li + 1; a.li = 0; hipLaunchKernelGGL(fwd, dim3(grid), dim3(NWAVES * 64), LDS_BYTES, stream, a); }
#else
#ifndef DBG_PH_HI
#define DBG_PH_HI N_PHASES
#endif
    a.ph_lo = 0; a.ph_hi = DBG_PH_HI; a.li = 0;
    hipLaunchKernelGGL(fwd, dim3(grid), dim3(NWAVES * 64), LDS_BYTES, stream, a);
#endif
    const hipError_t le = hipPeekAtLastError();
    if (le != hipSuccess) fprintf(stderr, "kernel_launch: launch failed: %s\n", hipGetErrorName(le));
}
```

```cpp
#include <hip/hip_runtime.h>
#include <hip/hip_bf16.h>
#include <cstdio>
#include <cstdint>
#include <cstddef>
#include <cmath>

namespace pg8 {
#define PG8_LAS __attribute__((address_space(3)))
typedef unsigned short bf16_t;
typedef short bf16x8 __attribute__((ext_vector_type(8)));
typedef float f32x4 __attribute__((ext_vector_type(4)));
typedef float f32x2 __attribute__((ext_vector_type(2)));
typedef unsigned u32x4 __attribute__((ext_vector_type(4)));
constexpr int BM = 256, BK = 64, HALF = 128, HTB = HALF * BK * 2  , STAGE_BYTES = 8 * HTB, NXCD = 8, WGM = 8;

__host__ __device__ __forceinline__ int lds_byte(int r, int c) { const int st = (r >> 4) * 2 + (c >> 5), rr = r & 15, cc = c & 31, ob = rr * 64 + cc * 2; return st * 1024 + (ob ^ (((ob >> 9) & 1) << 5)); }
__host__ __device__ __forceinline__ void stage_rc(int b, int& R, int& C) { const int st = b / 1024, sb = b % 1024, swz = sb ^ (((sb >> 9) & 1) << 5); R = (st >> 1) * 16 + swz / 64; C = (st & 1) * 32 + (swz % 64) / 2; }
__host__ __device__ __forceinline__ int perm32(int rho) { const int n = rho >> 4, i = rho & 15; return 8 * (i >> 2) + 4 * n + (i & 3); }

struct Unit { int pm, pn, pa; };
struct Gemm { const bf16_t* A; const bf16_t* Bt; int K, lda; const int* gidx; };

struct StaticOrder {
    int nM, nN, nwg, G, c, wgm;
    __host__ __device__ void init(int M, int N, int G_, int c_, int wgm_ = WGM) { nM = M / BM; nN = N / BM; nwg = nM * nN; G = G_; c = c_; wgm = wgm_; }
    __host__ __device__ bool next(int i, Unit& u) const {
        const long L = (long)i * G + c; if (L >= nwg) return false;
        int wgid = (int)L; { const int q = nwg / NXCD, r = nwg % NXCD, xcd = wgid % NXCD, off = wgid / NXCD; wgid = (xcd < r ? xcd * (q + 1) : r * (q + 1) + (xcd - r) * q) + off; }
        const int nig = wgm * nN, gid = wgid / nig, fm = gid * wgm, gsz = (nM - fm) < wgm ? (nM - fm) : wgm;
        u.pm = fm + ((wgid % nig) % gsz); u.pn = (wgid % nig) / gsz; u.pa = u.pm; return true;
    }
};

__device__ __forceinline__ unsigned cvt_pk_bf16(float lo, float hi) { unsigned r; asm volatile("v_cvt_pk_bf16_f32 %0, %1, %2" : "=v"(r) : "v"(lo), "v"(hi)); return r; }

__device__ __forceinline__ float rms_scale16(const float* ssq, int row) { const f32x4* p = (const f32x4*)(ssq + (size_t)row * 16); const f32x4 a = p[0], b = p[1], c = p[2], d = p[3];
    const float s = ((a[0] + a[1]) + (a[2] + a[3])) + ((b[0] + b[1]) + (b[2] + b[3])) + ((c[0] + c[1]) + (c[2] + c[3])) + ((d[0] + d[1]) + (d[2] + d[3])); return 1.0f / sqrtf(s * (1.0f / 1024.0f) + 1e-6f); }
struct RowScale { float r0, r1;
    __device__ __forceinline__ void init(const float* ssq, int unit_row0, int wr, int lane) { r0 = rms_scale16(ssq, unit_row0 + wr * 64 + lane); r1 = rms_scale16(ssq, unit_row0 + HALF + wr * 64 + lane); }
    __device__ __forceinline__ float get(int ai, int m, int fr) const { return __int_as_float(__builtin_amdgcn_ds_bpermute((m * 16 + fr) << 2, __float_as_int(ai ? r1 : r0))); } };
template <int OFF, int CNT> __device__ __forceinline__ float rms_part(const float* ssq, int row) { const float* p = ssq + (size_t)row * 16 + OFF; float s = 0.f;
#pragma unroll
    for (int i = 0; i < CNT; i += 4) { const f32x4 a = *(const f32x4*)(p + i); s += (a[0] + a[1]) + (a[2] + a[3]); }
    return 1.0f / sqrtf(s * (1.0f / (32.0f * CNT)) + 1e-6f); }
template <int OFF, int CNT> struct RowScaleP { float r0, r1;
    __device__ __forceinline__ void init(const float* ssq, int unit_row0, int wr, int lane) { r0 = rms_part<OFF, CNT>(ssq, unit_row0 + wr * 64 + lane); r1 = rms_part<OFF, CNT>(ssq, unit_row0 + HALF + wr * 64 + lane); }
    __device__ __forceinline__ float get(int ai, int m, int fr) const { return __int_as_float(__builtin_amdgcn_ds_bpermute((m * 16 + fr) << 2, __float_as_int(ai ? r1 : r0))); } };
struct EpiBf16Q {
    static constexpr bool PERM = true;
    bf16_t* O; int ldc; int ncols; const float* ssq; float* ssq2;
    __device__ __forceinline__ void operator()(const f32x4 (&acc)[2][2][4][2], const Unit& u, int wr, int wc, int fr, int fq) const {
        const int row0 = u.pm * BM + wr * 64 + fr; const int col0 = u.pn * BM + wc * 32 + 8 * fq; const int ln = fq * 16 + fr;
        const bool lat = (u.pn == 8 || u.pn == 9);
        RowScale R; if (ssq) R.init(ssq, u.pm * BM, wr, fq * 16 + fr);
#pragma unroll
        for (int ai = 0; ai < 2; ++ai)
#pragma unroll
            for (int m = 0; m < 4; ++m) { const int row = row0 + ai * HALF + m * 16; bf16_t* rowp = O + (size_t)row * ldc + col0; const float rs = ssq ? R.get(ai, m, fr) : 1.0f;
#pragma unroll
                for (int bj = 0; bj < 2; ++bj) { const f32x4 v0 = acc[ai][bj][m][0] * rs, v1 = acc[ai][bj][m][1] * rs;
                    u32x4 w; w.x = cvt_pk_bf16(v0[0], v0[1]); w.y = cvt_pk_bf16(v0[2], v0[3]); w.z = cvt_pk_bf16(v1[0], v1[1]); w.w = cvt_pk_bf16(v1[2], v1[3]);
                    if (col0 + bj * HALF < ncols) *(u32x4*)(rowp + bj * HALF) = w;
                    if (lat) { float ss = ((v0[0] * v0[0] + v0[1] * v0[1]) + (v0[2] * v0[2] + v0[3] * v0[3])) + ((v1[0] * v1[0] + v1[1] * v1[1]) + (v1[2] * v1[2] + v1[3] * v1[3]));
                        ss += __int_as_float(__builtin_amdgcn_ds_bpermute((ln ^ 16) << 2, __float_as_int(ss))); ss += __int_as_float(__builtin_amdgcn_ds_bpermute((ln ^ 32) << 2, __float_as_int(ss)));
                        if (fq == 0) ssq2[(size_t)row * 16 + (u.pn - 8) * 8 + bj * 4 + wc] = ss; } } }
    }
};
struct EpiBf16R {
    static constexpr bool PERM = true;
    bf16_t* O; const float* ssq2;
    __device__ __forceinline__ void operator()(const f32x4 (&acc)[2][2][4][2], const Unit& u, int wr, int wc, int fr, int fq) const {
        const int row0 = u.pm * BM + wr * 64 + fr; const int col0 = u.pn * BM + wc * 32 + 8 * fq;
        RowScaleP<0, 12> R; R.init(ssq2, u.pm * BM, wr, fq * 16 + fr);
#pragma unroll
        for (int ai = 0; ai < 2; ++ai)
#pragma unroll
            for (int m = 0; m < 4; ++m) { const int row = row0 + ai * HALF + m * 16; bf16_t* rowp = O + (size_t)row * 384 + col0; const float rs = R.get(ai, m, fr);
#pragma unroll
                for (int bj = 0; bj < 2; ++bj) { const f32x4 v0 = acc[ai][bj][m][0] * rs, v1 = acc[ai][bj][m][1] * rs;
                    u32x4 w; w.x = cvt_pk_bf16(v0[0], v0[1]); w.y = cvt_pk_bf16(v0[2], v0[3]); w.z = cvt_pk_bf16(v1[0], v1[1]); w.w = cvt_pk_bf16(v1[2], v1[3]);
                    if (col0 + bj * HALF < 384) *(u32x4*)(rowp + bj * HALF) = w; } }
    }
};
struct EpiBf16 {
    static constexpr bool PERM = true;
    bf16_t* O; int ldc; int ncols; int nt; float sc = 1.0f; const float* ssq = nullptr;
    __device__ __forceinline__ void operator()(const f32x4 (&acc)[2][2][4][2], const Unit& u, int wr, int wc, int fr, int fq) const {
        const int row0 = u.pm * BM + wr * 64 + fr; const int col0 = (nt ? u.pn % nt : u.pn) * BM + wc * 32 + 8 * fq;
        RowScale R; if (ssq) R.init(ssq, u.pm * BM, wr, fq * 16 + fr);
#pragma unroll
        for (int ai = 0; ai < 2; ++ai)
#pragma unroll
            for (int m = 0; m < 4; ++m) { const int row = row0 + ai * HALF + m * 16; bf16_t* rowp = O + (size_t)row * ldc + col0; const float rs = ssq ? sc * R.get(ai, m, fr) : sc;
#pragma unroll
                for (int bj = 0; bj < 2; ++bj) { const f32x4 v0 = acc[ai][bj][m][0] * rs, v1 = acc[ai][bj][m][1] * rs;
                    u32x4 w; w.x = cvt_pk_bf16(v0[0], v0[1]); w.y = cvt_pk_bf16(v0[2], v0[3]); w.z = cvt_pk_bf16(v1[0], v1[1]); w.w = cvt_pk_bf16(v1[2], v1[3]);
                    if (col0 + bj * HALF < ncols) *(u32x4*)(rowp + bj * HALF) = w; } }
    }
};
struct EpiBf16K {
    static constexpr bool PERM = true;
    bf16_t* O; unsigned* kmax; const float* ssq2;
    __device__ __forceinline__ void operator()(const f32x4 (&acc)[2][2][4][2], const Unit& u, int wr, int wc, int fr, int fq) const {
        const int row0 = u.pm * BM + wr * 64 + fr; const int col0 = u.pn * BM + wc * 32 + 8 * fq; const int ln = fq * 16 + fr;
        float mx0 = 0.f, mx1 = 0.f;
        RowScaleP<12, 4> R; R.init(ssq2, u.pm * BM, wr, ln);
#pragma unroll
        for (int ai = 0; ai < 2; ++ai)
#pragma unroll
            for (int m = 0; m < 4; ++m) { const int row = row0 + ai * HALF + m * 16; bf16_t* rowp = O + (size_t)row * 512 + col0; const float rs = R.get(ai, m, fr);
#pragma unroll
                for (int bj = 0; bj < 2; ++bj) { const f32x4 v0 = acc[ai][bj][m][0] * rs, v1 = acc[ai][bj][m][1] * rs;
                    u32x4 w; w.x = cvt_pk_bf16(v0[0], v0[1]); w.y = cvt_pk_bf16(v0[2], v0[3]); w.z = cvt_pk_bf16(v1[0], v1[1]); w.w = cvt_pk_bf16(v1[2], v1[3]);
                    *(u32x4*)(rowp + bj * HALF) = w;
                    if (wc < 2) { float ss = ((v0[0] * v0[0] + v0[1] * v0[1]) + (v0[2] * v0[2] + v0[3] * v0[3])) + ((v1[0] * v1[0] + v1[1] * v1[1]) + (v1[2] * v1[2] + v1[3] * v1[3]));
                        ss += __int_as_float(__builtin_amdgcn_ds_bpermute((ln ^ 16) << 2, __float_as_int(ss))); ss += __int_as_float(__builtin_amdgcn_ds_bpermute((ln ^ 32) << 2, __float_as_int(ss)));
                        if (bj == 0) mx0 = __builtin_fmaxf(mx0, ss); else mx1 = __builtin_fmaxf(mx1, ss); } } }
        if (wc < 2) {
#pragma unroll
            for (int o_ = 1; o_ < 16; o_ <<= 1) { mx0 = __builtin_fmaxf(mx0, __int_as_float(__builtin_amdgcn_ds_bpermute((ln ^ o_) << 2, __float_as_int(mx0)))); mx1 = __builtin_fmaxf(mx1, __int_as_float(__builtin_amdgcn_ds_bpermute((ln ^ o_) << 2, __float_as_int(mx1)))); }
            if (ln == 0) { unsigned* kp = kmax + (((u.pm * BM) >> 13) * 4 + 2 * u.pn) * 2 + wc;
                __hip_atomic_fetch_max(kp, __float_as_uint(mx0), __ATOMIC_RELAXED, __HIP_MEMORY_SCOPE_AGENT); __hip_atomic_fetch_max(kp + 2, __float_as_uint(mx1), __ATOMIC_RELAXED, __HIP_MEMORY_SCOPE_AGENT); } }
    }
};
struct EpiRope {
    static constexpr bool PERM = true;
    bf16_t* O; const f32x2* rope;
    __device__ __forceinline__ void operator()(const f32x4 (&acc)[2][2][4][2], const Unit& u, int wr, int wc, int fr, int fq) const {
        const int row0 = u.pm * BM + wr * 64 + fr; const int col0 = u.pn * BM + wc * 32 + 8 * fq;
#pragma unroll
        for (int bj = 0; bj < 2; ++bj) { const int col = col0 + bj * HALF; if (col >= 384) continue;
            const int dd = col % 96; const bool rp = dd >= 64; const int j0 = rp ? ((dd - 64) >> 1) : 0;
            const f32x2* rt0 = rope + (size_t)(row0 & 8191) * 16 + j0; bf16_t* op0 = O + (size_t)row0 * 384 + col;
#pragma unroll
            for (int ai = 0; ai < 2; ++ai)
#pragma unroll
                for (int m = 0; m < 4; ++m) { const int dr = ai * HALF + m * 16; f32x4 v0 = acc[ai][bj][m][0], v1 = acc[ai][bj][m][1];
                    { const f32x2* rt = rt0 + dr * 16; f32x2 c0 = rt[0], c1 = rt[1], c2 = rt[2], c3 = rt[3];
                        if (!rp) { c0 = (f32x2){1.f, 0.f}; c1 = c0; c2 = c0; c3 = c0; }
                        f32x4 a, b; a[0] = v0[0] * c0.x - v0[1] * c0.y; a[1] = v0[1] * c0.x + v0[0] * c0.y; a[2] = v0[2] * c1.x - v0[3] * c1.y; a[3] = v0[3] * c1.x + v0[2] * c1.y;
                        b[0] = v1[0] * c2.x - v1[1] * c2.y; b[1] = v1[1] * c2.x + v1[0] * c2.y; b[2] = v1[2] * c3.x - v1[3] * c3.y; b[3] = v1[3] * c3.x + v1[2] * c3.y; v0 = a; v1 = b; }
                    u32x4 w; w.x = cvt_pk_bf16(v0[0], v0[1]); w.y = cvt_pk_bf16(v0[2], v0[3]); w.z = cvt_pk_bf16(v1[0], v1[1]); w.w = cvt_pk_bf16(v1[2], v1[3]);
                    *(u32x4*)(op0 + (size_t)dr * 384) = w; asm volatile("" ::: "memory"); } }
    }
};
struct EpiResid {
    static constexpr bool PERM = true;
    const float* base; float* out; int ldc; bf16_t* xb = nullptr; float* ssq = nullptr; float sc = 1.0f; bool xb8 = false;
    __device__ __forceinline__ void operator()(const f32x4 (&acc)[2][2][4][2], const Unit& u, int wr, int wc, int fr, int fq) const {
        const int row0 = u.pm * BM + wr * 64 + fr; const int col0 = u.pn * BM + wc * 32 + 8 * fq;
#pragma unroll
        for (int ai = 0; ai < 2; ++ai)
#pragma unroll
            for (int mp = 0; mp < 4; mp += 2) {
                f32x4 bb[2][2][2];
#pragma unroll
                for (int mi = 0; mi < 2; ++mi) { const size_t off = (size_t)(row0 + ai * HALF + (mp + mi) * 16) * ldc + col0;
                    bb[mi][0][0] = *(const f32x4*)(base + off); bb[mi][0][1] = *(const f32x4*)(base + off + 4); bb[mi][1][0] = *(const f32x4*)(base + off + HALF); bb[mi][1][1] = *(const f32x4*)(base + off + HALF + 4); }
#pragma unroll
                for (int mi = 0; mi < 2; ++mi) { const int m = mp + mi; const int row = row0 + ai * HALF + m * 16; const size_t off = (size_t)row * ldc + col0; float ss = 0.f;
#pragma unroll
                    for (int bj = 0; bj < 2; ++bj) { const f32x4 b0 = bb[mi][bj][0], b1 = bb[mi][bj][1];
                        const f32x4 x0 = b0 + acc[ai][bj][m][0] * sc, x1 = b1 + acc[ai][bj][m][1] * sc;
                        *(f32x4*)(out + off + bj * HALF) = x0; *(f32x4*)(out + off + bj * HALF + 4) = x1;
                        if (xb) { if (xb8) { int w0 = __builtin_amdgcn_cvt_pk_fp8_f32(x0[0], x0[1], 0, false); w0 = __builtin_amdgcn_cvt_pk_fp8_f32(x0[2], x0[3], w0, true);
                                int w1 = __builtin_amdgcn_cvt_pk_fp8_f32(x1[0], x1[1], 0, false); w1 = __builtin_amdgcn_cvt_pk_fp8_f32(x1[2], x1[3], w1, true);
                                typedef int i32x2 __attribute__((ext_vector_type(2))); *(i32x2*)((char*)xb + off + bj * HALF) = (i32x2){w0, w1}; }
                            else { u32x4 w; w.x = cvt_pk_bf16(x0[0], x0[1]); w.y = cvt_pk_bf16(x0[2], x0[3]); w.z = cvt_pk_bf16(x1[0], x1[1]); w.w = cvt_pk_bf16(x1[2], x1[3]); *(u32x4*)(xb + off + bj * HALF) = w; }
                            ss += ((x0[0] * x0[0] + x0[1] * x0[1]) + (x0[2] * x0[2] + x0[3] * x0[3])) + ((x1[0] * x1[0] + x1[1] * x1[1]) + (x1[2] * x1[2] + x1[3] * x1[3])); } }
                    if (xb) { const int ln = fq * 16 + fr;
                        ss += __int_as_float(__builtin_amdgcn_ds_bpermute((ln ^ 16) << 2, __float_as_int(ss))); ss += __int_as_float(__builtin_amdgcn_ds_bpermute((ln ^ 32) << 2, __float_as_int(ss)));
                        if (fq == 0) ssq[(size_t)row * 16 + u.pn * 4 + wc] = ss; } }
                asm volatile("" ::: "memory"); }
    }
};
template <bool F8OUT> struct EpiSwigluT {
    static constexpr bool PERM = true;
    void* G; int ldc; int ntile; float sc; const float* ssq = nullptr;
    __device__ __forceinline__ void operator()(const f32x4 (&acc)[2][2][4][2], const Unit& u, int wr, int wc, int fr, int fq) const {
        const int row0 = u.pm * BM + wr * 64 + fr; const int col0 = (u.pn % ntile) * HALF + wc * 32 + 8 * fq;
        RowScale R; if (ssq) R.init(ssq, u.pm * BM, wr, fq * 16 + fr);
#pragma unroll
        for (int ai = 0; ai < 2; ++ai)
#pragma unroll
            for (int m = 0; m < 4; ++m) { float g[8]; const float rs = ssq ? sc * R.get(ai, m, fr) : sc;
#pragma unroll
                for (int n = 0; n < 2; ++n)
#pragma unroll
                    for (int e = 0; e < 4; ++e) { const float a = acc[ai][0][m][n][e] * rs, b = acc[ai][1][m][n][e] * rs;
                        const float s = __builtin_amdgcn_rcpf(1.0f + __builtin_amdgcn_exp2f(-1.4426950408889634f * a)); g[n * 4 + e] = a * s * b; }
                if constexpr (F8OUT) { int w0 = __builtin_amdgcn_cvt_pk_fp8_f32(g[0], g[1], 0, false); w0 = __builtin_amdgcn_cvt_pk_fp8_f32(g[2], g[3], w0, true);
                    int w1 = __builtin_amdgcn_cvt_pk_fp8_f32(g[4], g[5], 0, false); w1 = __builtin_amdgcn_cvt_pk_fp8_f32(g[6], g[7], w1, true);
                    typedef int i32x2 __attribute__((ext_vector_type(2)));
                    *(i32x2*)((char*)G + (size_t)(row0 + ai * HALF + m * 16) * ldc + col0) = (i32x2){w0, w1}; }
                else { u32x4 w; w.x = cvt_pk_bf16(g[0], g[1]); w.y = cvt_pk_bf16(g[2], g[3]); w.z = cvt_pk_bf16(g[4], g[5]); w.w = cvt_pk_bf16(g[6], g[7]);
                    *(u32x4*)((bf16_t*)G + (size_t)(row0 + ai * HALF + m * 16) * ldc + col0) = w; } }
    }
};
typedef EpiSwigluT<false> EpiSwiglu;
typedef EpiSwigluT<true> EpiSwiglu8;

__device__ __forceinline__ void glds_s(unsigned voff, const char* sbase, unsigned lds_dst) { unsigned keep;
    asm volatile("s_mov_b32 %0, m0\n\ts_mov_b32 m0, %3\n\ts_nop 0\n\tglobal_load_lds_dwordx4 %1, %2\n\ts_mov_b32 m0, %0" : "=&s"(keep) : "v"(voff), "s"(sbase), "s"(lds_dst) : "memory"); }
template <class Epi, class Sched, bool GATHER = false, bool FP8 = false>
__device__ __forceinline__ void gemm_phase(PG8_LAS unsigned char* lds, const Gemm g, const Sched& S, const Epi& E, const int wave_id) {
    int lane_; asm volatile("v_mbcnt_lo_u32_b32 %0, -1, 0\n\tv_mbcnt_hi_u32_b32 %0, -1, %0" : "=v"(lane_));
    const int wid = wave_id, lane = lane_, tid = wid * 64 + lane, wr = wid >> 2, wc = wid & 3, fr = lane & 15, fq = lane >> 4;
    const int K = g.K, nt = K / BK;
    Unit cur, nxt; int ui = 0;
    if (!S.next(0, cur)) return;
    unsigned offA[2][2], voffB[2];
#pragma unroll
    for (int i = 0; i < 2; ++i) { int R, C; stage_rc(tid * 16 + i * 8192, R, C); const int Rb = Epi::PERM ? ((R & ~31) + perm32(R & 31)) : R;
        voffB[i] = (unsigned)(Rb * K + C) * 2u;
#pragma unroll
        for (int h = 0; h < 2; ++h) {
            if constexpr (GATHER) { const int tok = g.gidx[h * HALF + R]; offA[h][i] = (unsigned)tok * (unsigned)(g.lda * 2) + (unsigned)C * 2u; }
            else offA[h][i] = (unsigned)((h * HALF + R) * g.lda + C) * 2u; } }
    if constexpr (GATHER) asm volatile("s_waitcnt vmcnt(0)" ::: "memory");
    const size_t kstep = (size_t)(BK * 2);
    const size_t hstep = (size_t)HALF * K * 2;
    const size_t tstepB = 2 * hstep, tstepA = (size_t)BM * g.lda * 2;
    const unsigned ldsw = (unsigned)wid * 1024u; const unsigned lds0 = (unsigned)(uintptr_t)lds;
    int scl1 = 0x7f7f7f7f; asm volatile("" : "+v"(scl1));
    const int aoff = lds_byte(wr * 64 + fr, fq * 8), boff = lds_byte(wc * 32 + fr, fq * 8);
#define PG8_SA(b, h) (((b) * 2 + (h)) * HTB)
#define PG8_SB(b, h) ((4 + (b) * 2 + (h)) * HTB)
#define PG8_STAGE(bufoff, gbase, voff) do { _Pragma("unroll") for (int _i = 0; _i < 2; ++_i) \
        glds_s((voff)[_i], (const char*)(gbase), lds0 + (unsigned)(bufoff) + ldsw + _i * 8192u); } while (0)
#define PG8_LDA(dst, b, h) do { if constexpr (FP8) { _Pragma("unroll") for (int m = 0; m < 4; ++m) { const i32x4 lo_ = *(const PG8_LAS i32x4*)(lds + PG8_SA(b, h) + aoff + m * 2048), hi_ = *(const PG8_LAS i32x4*)(lds + PG8_SA(b, h) + aoff + m * 2048 + 1024); \
        dst##8[m] = (i32x8){lo_[0], lo_[1], lo_[2], lo_[3], hi_[0], hi_[1], hi_[2], hi_[3]}; } } \
    else { _Pragma("unroll") for (int m = 0; m < 4; ++m) _Pragma("unroll") for (int k = 0; k < 2; ++k) dst[m][k] = *(const PG8_LAS bf16x8*)(lds + PG8_SA(b, h) + aoff + m * 2048 + k * 1024); } } while (0)
#define PG8_LDB(dst, b, h) do { if constexpr (FP8) { _Pragma("unroll") for (int n = 0; n < 2; ++n) { const i32x4 lo_ = *(const PG8_LAS i32x4*)(lds + PG8_SB(b, h) + boff + n * 2048), hi_ = *(const PG8_LAS i32x4*)(lds + PG8_SB(b, h) + boff + n * 2048 + 1024); \
        dst##8[n] = (i32x8){lo_[0], lo_[1], lo_[2], lo_[3], hi_[0], hi_[1], hi_[2], hi_[3]}; } } \
    else { _Pragma("unroll") for (int n = 0; n < 2; ++n) _Pragma("unroll") for (int k = 0; k < 2; ++k) dst[n][k] = *(const PG8_LAS bf16x8*)(lds + PG8_SB(b, h) + boff + n * 2048 + k * 1024); } } while (0)
#define PG8_MMA(ai, bj, At, Bt) do { __builtin_amdgcn_s_setprio(1); _Pragma("unroll") for (int m = 0; m < 4; ++m) _Pragma("unroll") for (int n = 0; n < 2; ++n) { \
        if constexpr (FP8) asm volatile("v_mfma_scale_f32_16x16x128_f8f6f4 %0, %1, %2, %0, %3, %3 op_sel_hi:[0,0,0]" : "+v"(acc[ai][bj][m][n]) : "v"(Bt##8[n]), "v"(At##8[m]), "v"(scl1));   \
        else { _Pragma("unroll") for (int k = 0; k < 2; ++k) acc[ai][bj][m][n] = __builtin_amdgcn_mfma_f32_16x16x32_bf16(Bt[n][k], At[m][k], acc[ai][bj][m][n], 0, 0, 0); } } \
        __builtin_amdgcn_s_setprio(0); } while (0)
#define PG8_WAIT_V(n) asm volatile("s_waitcnt vmcnt(" #n ")" ::: "memory")
#define PG8_WAIT_L(n) asm volatile("s_waitcnt lgkmcnt(" #n ")" ::: "memory")
#define PG8_BAR __builtin_amdgcn_s_barrier()
#define PG8_SCHED __builtin_amdgcn_sched_barrier(0)
    f32x4 acc[2][2][4][2];
#pragma unroll
    for (int a = 0; a < 2; ++a)
#pragma unroll
        for (int b = 0; b < 2; ++b)
#pragma unroll
            for (int m = 0; m < 4; ++m)
#pragma unroll
                for (int n = 0; n < 2; ++n) acc[a][b][m][n] = (f32x4){0.f, 0.f, 0.f, 0.f};
    typedef int i32x8 __attribute__((ext_vector_type(8))); typedef int i32x4 __attribute__((ext_vector_type(4)));
    const char* cA = (const char*)g.A + (size_t)cur.pa * tstepA; const char* cB = (const char*)g.Bt + (size_t)cur.pn * tstepB;
    PG8_STAGE(PG8_SB(0, 0), cB, voffB); PG8_STAGE(PG8_SB(0, 1), cB + hstep, voffB); PG8_STAGE(PG8_SA(0, 0), cA, offA[0]); PG8_STAGE(PG8_SA(0, 1), cA, offA[1]);
    if (wr == 1) PG8_BAR;
    PG8_WAIT_V(2); PG8_BAR;
    PG8_STAGE(PG8_SB(1, 0), cB + kstep, voffB); PG8_STAGE(PG8_SA(1, 0), cA + kstep, offA[0]); PG8_STAGE(PG8_SB(1, 1), cB + hstep + kstep, voffB);
    PG8_WAIT_V(6); PG8_BAR;
    for (;;) {
        const bool has_next = S.next(ui + 1, nxt);
        const char* nA = has_next ? (const char*)g.A + (size_t)nxt.pa * tstepA : cA; const char* nB = has_next ? (const char*)g.Bt + (size_t)nxt.pn * tstepB : cB;
#pragma unroll 1
        for (int t = 0; t < nt; t += 2) {
            const bool last = (t == nt - 2);
            bf16x8 At[4][2], B0[2][2], B1[2][2]; i32x8 At8[4], B08[2], B18[2];
            const char* a1 = cA + (size_t)(t + 1) * kstep;
            const char* a2 = last ? nA : cA + (size_t)(t + 2) * kstep; const char* b2 = last ? nB : cB + (size_t)(t + 2) * kstep;
            const char* a3 = a2 + kstep; const char* b3 = b2 + kstep;
            PG8_LDB(B0, 0, 0); PG8_LDB(B1, 0, 1); PG8_SCHED; PG8_LDA(At, 0, 0); PG8_STAGE(PG8_SA(1, 1), a1, offA[1]);
            PG8_WAIT_V(8); PG8_WAIT_L(0); PG8_BAR; PG8_MMA(0, 0, At, B0); PG8_MMA(0, 1, At, B1); PG8_BAR; PG8_SCHED;
            PG8_LDA(At, 0, 1); PG8_STAGE(PG8_SB(0, 0), b2, voffB); PG8_STAGE(PG8_SB(0, 1), b2 + hstep, voffB); PG8_STAGE(PG8_SA(0, 0), a2, offA[0]);
            PG8_WAIT_V(8); PG8_WAIT_L(0); PG8_BAR; PG8_MMA(1, 0, At, B0); PG8_MMA(1, 1, At, B1); PG8_BAR; PG8_SCHED;
            PG8_LDB(B0, 1, 0); PG8_LDB(B1, 1, 1); PG8_SCHED; PG8_LDA(At, 1, 0); PG8_STAGE(PG8_SA(0, 1), a2, offA[1]);
            PG8_WAIT_V(8); PG8_WAIT_L(0); PG8_BAR; PG8_MMA(0, 0, At, B0); PG8_MMA(0, 1, At, B1); PG8_BAR; PG8_SCHED;
            PG8_LDA(At, 1, 1); PG8_STAGE(PG8_SB(1, 0), b3, voffB); PG8_STAGE(PG8_SB(1, 1), b3 + hstep, voffB); PG8_STAGE(PG8_SA(1, 0), a3, offA[0]);
            PG8_WAIT_V(8); PG8_WAIT_L(0); PG8_BAR; PG8_MMA(1, 0, At, B0); PG8_MMA(1, 1, At, B1); PG8_BAR; PG8_SCHED;
        }
        if (wr == 0) PG8_BAR;
        if constexpr (FP8) asm volatile("s_nop 15\n\ts_nop 15\n\ts_nop 15\n\ts_nop 15" ::: "memory");
        { int l2_; asm volatile("v_mbcnt_lo_u32_b32 %0, -1, 0\n\tv_mbcnt_hi_u32_b32 %0, -1, %0" : "=v"(l2_)); E(acc, cur, wr, wc, l2_ & 15, l2_ >> 4); }
        if (!has_next) break;
#pragma unroll
        for (int a = 0; a < 2; ++a)
#pragma unroll
            for (int b = 0; b < 2; ++b)
#pragma unroll
                for (int m = 0; m < 4; ++m)
#pragma unroll
                    for (int n = 0; n < 2; ++n) acc[a][b][m][n] = (f32x4){0.f, 0.f, 0.f, 0.f};
        cur = nxt; cA = nA; cB = nB; ++ui;
        if (wr == 1) PG8_BAR;
    }
    PG8_WAIT_V(0);
    PG8_BAR;
#undef PG8_SA
#undef PG8_SB
#undef PG8_STAGE
#undef PG8_LDA
#undef PG8_LDB
#undef PG8_MMA
#undef PG8_WAIT_V
#undef PG8_WAIT_L
#undef PG8_BAR
#undef PG8_SCHED
}
}
namespace att {
using bf16_t = unsigned short;
using bf16x8 = __attribute__((ext_vector_type(8))) short;
using s16x4 = __attribute__((ext_vector_type(4))) short;
using f32x16 = __attribute__((ext_vector_type(16))) float;
using u32x4 = __attribute__((ext_vector_type(4))) unsigned;
typedef short v4i16_t __attribute__((ext_vector_type(4)));
typedef __attribute__((address_space(3))) const char* lds_cptr;
typedef float f32x2_t __attribute__((ext_vector_type(2))); typedef __bf16 bf16x2_t __attribute__((ext_vector_type(2)));
constexpr int NW = 8, QBLK = 32, QB = 256, KVBLK = 64;
constexpr int NSLOT = 3, KSLOT = 12288, VSLOT = 8192;
constexpr int LDS_K = 0, LDS_V = NSLOT * KSLOT, LDS_WS = LDS_V + NSLOT * VSLOT, LDS_OST = LDS_WS + NW * 64 * 4, LDS_BYTES = LDS_OST + NW * 4096;
constexpr float NEGBIG = -1.0e30f;
constexpr float THR = 8.0f;

__device__ __forceinline__ int crow(int r, int hi) { return (r & 3) + 8 * (r >> 2) + 4 * hi; }
__device__ __forceinline__ void glds16(const void* gsrc, unsigned lds_dst) { unsigned keep;
    asm volatile("s_mov_b32 %0, m0\n\ts_mov_b32 m0, %2\n\ts_nop 0\n\tglobal_load_lds_dwordx4 %1, off\n\ts_mov_b32 m0, %0" : "=&s"(keep) : "v"(gsrc), "s"(lds_dst) : "memory"); }
__device__ __forceinline__ unsigned cvtpk(float lo, float hi) { f32x2_t v = {lo, hi}; bf16x2_t b = __builtin_convertvector(v, bf16x2_t); return __builtin_bit_cast(unsigned, b); }
__device__ __forceinline__ s16x4 vtr(lds_cptr p) { return __builtin_bit_cast(s16x4, __builtin_amdgcn_ds_read_tr16_b64_v4i16((__attribute__((address_space(3))) v4i16_t*)p)); }
__device__ __forceinline__ float swapmax(float m) { auto rr = __builtin_amdgcn_permlane32_swap(__float_as_uint(m), __float_as_uint(m), false, false); return __builtin_fmaxf(__uint_as_float(rr[0]), __uint_as_float(rr[1])); }
__device__ __forceinline__ float swapadd(float m) { auto rr = __builtin_amdgcn_permlane32_swap(__float_as_uint(m), __float_as_uint(m), false, false); return __uint_as_float(rr[0]) + __uint_as_float(rr[1]); }
__device__ __forceinline__ float fadd_s(float a, float b) { float r; asm("v_add_f32_e32 %0, %1, %2" : "=v"(r) : "v"(a), "v"(b)); return r; }
__device__ __forceinline__ int lane_now() { int l; asm volatile("v_mbcnt_lo_u32_b32 %0, -1, 0\n\tv_mbcnt_hi_u32_b32 %0, -1, %0" : "=v"(l)); return l; }
#ifndef ATT_DEEP5
#define ATT_DEEP5 1
#endif
#ifndef ATT_SHV
#define ATT_SHV 1
#endif
#ifndef ATT_DEEP
#define ATT_DEEP 1
#endif
#ifndef ATT_SMAX
#define ATT_SMAX 1
#endif
#define ATT_WAIT_BAR(N) asm volatile("s_waitcnt vmcnt(" #N ") lgkmcnt(0)\n\ts_barrier" ::: "memory")

struct Job {
    const bf16_t* Q; int qs;
    const bf16_t* K0; int ks0;
    const bf16_t* K1; int ks1;
    const bf16_t* V; int vs;
    bf16_t* O; int os; long omap;
    float* LSE; int ls; long lmap;
    int q0, t_lo, t_hi, max_dist;
    float slope2, sink2;
    const f32x2_t* rope;
    float kmax2[2];
};

template <int NCH, int NMAP, bool ALIBI, int EPI, bool QROPE = false, bool TRUNC = false, int XP = 0, bool STAG = false>
__device__ __forceinline__ void attn_unit(const Job& J, char* shm, unsigned* qhead, volatile __attribute__((address_space(3))) unsigned* qslot, const int wave_id) {
    constexpr int NPK = 2 * NCH * NMAP;
    static_assert(!STAG || NMAP == 1, "STAG: single map");
    constexpr bool DEEP = (ATT_DEEP != 0) && !STAG;
    constexpr int KSL = (NPK > 8) ? KSLOT : 8192;
    constexpr int NS = STAG ? 4 : DEEP ? ((NPK > 8 || !ATT_DEEP5) ? 4 : 5) : 3, LDS_K = 0, LDS_V = NS * KSL, LDS_WS = LDS_V + NS * VSLOT, LDS_OST = LDS_WS + NW * 64 * 4;
    constexpr int AHEAD = DEEP ? NS - 1 : 2;
    static_assert(LDS_OST + NW * 4096 <= 131072, "attention LDS map");
    int lane_; asm volatile("v_mbcnt_lo_u32_b32 %0, -1, 0\n\tv_mbcnt_hi_u32_b32 %0, -1, %0" : "=v"(lane_));
    const int wid = wave_id, lane = lane_, tid = wid * 64 + lane, r32 = lane & 31, hi = lane >> 5;
    unsigned q_next = 0; if (tid == 0) q_next = __hip_atomic_fetch_add(qhead, 1u, __ATOMIC_RELAXED, __HIP_MEMORY_SCOPE_AGENT);
    const unsigned lds0 = (unsigned)(uintptr_t)shm;
    float* wsf = (float*)(shm + LDS_WS) + wid * 64;
    const unsigned koffA = (unsigned)(lane * J.ks0 + wid * 8) * 2u, koffB = (NPK > 8) ? (unsigned)(lane * J.ks1 + wid * 8) * 2u : 0u;
    const unsigned voff = (unsigned)((16 * (wid & 3) + (lane >> 2)) * J.vs + (wid >> 2) * 32 + (lane & 3) * 8) * 2u;
    const long kstepA = (long)KVBLK * J.ks0 * 2, kstepB = (NPK > 8) ? (long)KVBLK * J.ks1 * 2 : 0, vstep = (long)KVBLK * J.vs * 2;
    const unsigned kdst = lds0 + LDS_K + wid * 1024, vdst = lds0 + LDS_V + wid * 1024;
    const bool extraK = (NPK > 8) && (wid < NPK - 8);
#define ATT_DMA(t, slot) do { if (XP == 4) break; pg8::glds_s(koffA, (const char*)J.K0 + (long)(t) * kstepA, kdst + (slot) * KSL); \
        if (extraK) pg8::glds_s(koffB, (const char*)J.K1 + (long)(t) * kstepB, kdst + (slot) * KSL + 8192); \
        pg8::glds_s(voff, (const char*)J.V + (long)(t) * vstep, vdst + (slot) * VSLOT); } while (0)
    const int qw = J.q0 + wid * QBLK;
    const int nq = qw + r32;
    if constexpr (!ALIBI) { if (J.t_lo < J.t_hi) ATT_DMA(J.t_lo, 0); if (J.t_lo + 1 < J.t_hi) ATT_DMA(J.t_lo + 1, 1); if (DEEP && J.t_lo + 2 < J.t_hi) ATT_DMA(J.t_lo + 2, 2); if (AHEAD > 3 && J.t_lo + 3 < J.t_hi) ATT_DMA(J.t_lo + 3, 3); }
    bf16x8 qr[NMAP][NCH];
    { const bf16_t* qp = J.Q + (long)nq * J.qs + hi * 8;
#pragma unroll
      for (int m = 0; m < NMAP; ++m)
#pragma unroll
        for (int c = 0; c < NCH; ++c) qr[m][c] = *reinterpret_cast<const bf16x8*>(qp + (m * NCH + c) * 16); }
    if constexpr (QROPE) {
        const f32x2_t* rt = J.rope + (size_t)nq * 16 + hi * 4;
#pragma unroll
        for (int c = 0; c < 2; ++c) { bf16x8 q = qr[0][NCH - 2 + c]; bf16x8 r;
#pragma unroll
            for (int i = 0; i < 4; ++i) { const f32x2_t cs = rt[c * 8 + i]; const float a = __uint_as_float((unsigned)(unsigned short)q[2 * i] << 16), b = __uint_as_float((unsigned)(unsigned short)q[2 * i + 1] << 16);
                const unsigned w = cvtpk(a * cs.x - b * cs.y, b * cs.x + a * cs.y); r[2 * i] = (short)(w & 0xffffu); r[2 * i + 1] = (short)(w >> 16); }
            qr[0][NCH - 2 + c] = r; }
    }
    int t_lo = J.t_lo; const int t_hi = J.t_hi; int soft_dist = 1 << 28; float qk2row[NMAP]; bool stat = false;
    if constexpr (TRUNC) {
        float b2 = 0.f;
#pragma unroll
        for (int m = 0; m < NMAP; ++m) { float q2 = 0.f;
#pragma unroll
            for (int c = 0; c < NCH; ++c)
#pragma unroll
                for (int e = 0; e < 8; ++e) { const float x = __uint_as_float((unsigned)(unsigned short)qr[m][c][e] << 16); q2 += x * x; }
            q2 = swapadd(q2); qk2row[m] = q2 * J.kmax2[m];
#pragma unroll
            for (int o_ = 1; o_ < 32; o_ <<= 1) q2 = fmaxf(q2, __int_as_float(__builtin_amdgcn_ds_bpermute((lane ^ o_) << 2, __float_as_int(q2))));
            b2 = fmaxf(b2, q2 * J.kmax2[m]); }
        float* xq = (float*)(shm + LDS_OST);
        if (lane == 0) xq[wid] = b2;
        asm volatile("s_waitcnt lgkmcnt(0)\n\ts_barrier" ::: "memory");
        float bm = xq[0];
#pragma unroll
        for (int w_ = 1; w_ < NW; ++w_) bm = fmaxf(bm, xq[w_]);
        if constexpr (ALIBI) {
        const float bound = 2.02f * __builtin_sqrtf(bm) + 80.f;
        const float dmin = bound / J.slope2;
        soft_dist = __builtin_amdgcn_readfirstlane(dmin < 1.0e8f ? (int)dmin + 1 : (1 << 28));
        const int tl = (J.q0 - soft_dist) >> 6; t_lo = tl > t_lo ? tl : t_lo;
        }
        stat = ATT_SMAX && (1.01f * __builtin_sqrtf(bm) <= 50.f);
    }
    if constexpr (ALIBI) { if (t_lo < t_hi) ATT_DMA(t_lo, 0); if (t_lo + 1 < t_hi) ATT_DMA(t_lo + 1, 1); if (DEEP && t_lo + 2 < t_hi) ATT_DMA(t_lo + 2, 2); if (AHEAD > 3 && t_lo + 3 < t_hi) ATT_DMA(t_lo + 3, 3); }
    if (!(t_lo < t_hi)) { __builtin_amdgcn_s_barrier(); if (tid == 0) *qslot = q_next; }
#ifndef ATT_SB
#define ATT_SB 1
#endif
#ifndef ATT_ONES
#define ATT_ONES 0
#endif
#ifndef ATT_HALF
#define ATT_HALF 0
#endif
    constexpr bool ONES = (NMAP == 1) && ATT_ONES;
    float mhat[NMAP], lsum[NMAP]; f32x16 o[NMAP][2]; f32x16 osum, negm;
    float zero_ = 0.f; asm volatile("" : "+v"(zero_));
#pragma unroll
    for (int m = 0; m < NMAP; ++m) { mhat[m] = -1000.f; lsum[m] = 0.f;
#pragma unroll
        for (int r = 0; r < 16; ++r) { o[m][0][r] = zero_; o[m][1][r] = zero_; } }
#pragma unroll
    for (int r = 0; r < 16; ++r) { osum[r] = zero_; negm[r] = 1000.f + zero_; }
    if constexpr (TRUNC) { if (stat) {
#pragma unroll
        for (int m = 0; m < NMAP; ++m) mhat[m] = 1.01f * __builtin_sqrtf(qk2row[m]);
        if (!ALIBI) {
#pragma unroll
            for (int r = 0; r < 16; ++r) negm[r] = -mhat[0]; } } }
    const bf16x8 ones = (bf16x8){0x3f80, 0x3f80, 0x3f80, 0x3f80, 0x3f80, 0x3f80, 0x3f80, 0x3f80};
    const lds_cptr shm3 = (lds_cptr)shm;
    const lds_cptr kp0 = shm3 + LDS_K + hi * 1024 + r32 * 16;
    const lds_cptr vp0 = shm3 + LDS_V + ((lane >> 4) & 1) * 32 + (lane & 3) * 8 + (4 * hi + ((lane & 15) >> 2)) * 64;
    int slot = 0; u32x4 ppw[4]; bool pend = false; const bool late = STAG && ((wid & 1) != 0);
    for (int t = t_lo; t < t_hi; ++t) {
        if (XP == 5) { asm volatile("s_waitcnt vmcnt(3) lgkmcnt(0)" ::: "memory"); } else
        if (AHEAD > 3 && t + 3 < t_hi) { ATT_WAIT_BAR(6); } else
        if (DEEP && t + 2 < t_hi) { if (extraK) ATT_WAIT_BAR(6); else ATT_WAIT_BAR(4); } else
        if (t + 1 < t_hi) { if (extraK) ATT_WAIT_BAR(3); else ATT_WAIT_BAR(2); } else ATT_WAIT_BAR(0);
        if (t == t_lo && tid == 0) *qslot = q_next;
        if (t + AHEAD < t_hi) { const int s2 = (slot + AHEAD >= NS) ? slot + AHEAD - NS : slot + AHEAD; ATT_DMA(t + AHEAD, s2); }
        if constexpr (STAG) { if (pend) { const lds_cptr vq = vp0 + ((slot == 0) ? NS - 1 : slot - 1) * VSLOT;
#pragma unroll
            for (int d0 = 0; d0 < 2; ++d0) {
#pragma unroll
                for (int ks = 0; ks < 4; ++ks) { const s16x4 vl = vtr(vq + d0 * 4096 + ks * 1024), vh = vtr(vq + d0 * 4096 + ks * 1024 + 512);
                    const bf16x8 vf = (bf16x8){vl[0], vl[1], vl[2], vl[3], vh[0], vh[1], vh[2], vh[3]};
                    o[0][d0] = __builtin_amdgcn_mfma_f32_32x32x16_bf16(__builtin_bit_cast(bf16x8, ppw[ks]), vf, o[0][d0], 0, 0, 0); }
                __builtin_amdgcn_sched_barrier(0); }
            pend = false; } }
        const int k_lo = t * KVBLK;
        const int e0 = qw - (k_lo + 31), e1 = qw - (k_lo + 63);
        bool act0 = (k_lo <= qw + QBLK - 1) && (e0 <= J.max_dist) && (!TRUNC || e0 <= soft_dist);
        bool act1 = (k_lo + 32 <= qw + QBLK - 1) && (e1 <= J.max_dist) && (!TRUNC || e1 <= soft_dist);
        if (XP != 8 && (act0 || act1)) {
            bool clean0 = (e0 >= 0) && (qw + QBLK - 1 - k_lo <= J.max_dist), clean1 = (e1 >= 0) && (qw + QBLK - 1 - (k_lo + 32) <= J.max_dist);
            if (!ATT_HALF) { clean0 = clean0 && act0; clean1 = clean1 && act1; act0 = true; act1 = true; }
            const int dq = nq - k_lo;
            const lds_cptr kp = kp0 + slot * KSL; const lds_cptr vp = vp0 + slot * VSLOT;
            u32x4 pwk[4];
#pragma unroll
            for (int m = 0; m < NMAP; ++m) {
                if (ATT_SB) __builtin_amdgcn_sched_barrier(0);
                u32x4 pw[4]; f32x16 p0, p1;
                if (ALIBI) { const float L = -mhat[m] - J.slope2 * (float)(dq - 4 * hi), L1 = L + 32.f * J.slope2;
#pragma unroll
                    for (int r = 0; r < 16; ++r) { float a_ = __builtin_fmaf(J.slope2, (float)crow(r, 0), L), b_ = __builtin_fmaf(J.slope2, (float)crow(r, 0), L1); asm("" : "+v"(a_)); asm("" : "+v"(b_)); p0[r] = a_; p1[r] = b_; } }
                else if (!(act0 && act1)) { p0 = negm; p1 = negm; }
                if (XP == 3) { } else if (act0 && act1) {
#pragma unroll
                    for (int c = 0; c < NCH; ++c) {
                        const bf16x8 b0 = XP == 6 ? qr[m][(c + 1) % NCH] : *(const __attribute__((address_space(3))) bf16x8*)(kp + (m * NCH + c) * 2048);
                        const bf16x8 b1 = XP == 6 ? qr[m][(c + 2) % NCH] : *(const __attribute__((address_space(3))) bf16x8*)(kp + (m * NCH + c) * 2048 + 512);
                        if (!ALIBI && c == 0) { p0 = __builtin_amdgcn_mfma_f32_32x32x16_bf16(b0, qr[m][c], negm, 0, 0, 0); p1 = __builtin_amdgcn_mfma_f32_32x32x16_bf16(b1, qr[m][c], negm, 0, 0, 0); }
                        else { p0 = __builtin_amdgcn_mfma_f32_32x32x16_bf16(b0, qr[m][c], p0, 0, 0, 0);
                               p1 = __builtin_amdgcn_mfma_f32_32x32x16_bf16(b1, qr[m][c], p1, 0, 0, 0); } }
                } else if (act0) {
#pragma unroll
                    for (int c = 0; c < NCH; ++c) p0 = __builtin_amdgcn_mfma_f32_32x32x16_bf16(*(const __attribute__((address_space(3))) bf16x8*)(kp + (m * NCH + c) * 2048), qr[m][c], p0, 0, 0, 0);
                } else {
#pragma unroll
                    for (int c = 0; c < NCH; ++c) p1 = __builtin_amdgcn_mfma_f32_32x32x16_bf16(*(const __attribute__((address_space(3))) bf16x8*)(kp + (m * NCH + c) * 2048 + 512), qr[m][c], p1, 0, 0, 0);
                }
                const int lo = dq - J.max_dist;
                if (!act0) {
#pragma unroll
                    for (int r = 0; r < 16; ++r) p0[r] = NEGBIG;
                } else if (!clean0) {
#pragma unroll
                    for (int r = 0; r < 16; ++r) { const int kl = crow(r, hi); if (kl > dq || kl < lo) p0[r] = NEGBIG; }
                }
                if (!act1) {
#pragma unroll
                    for (int r = 0; r < 16; ++r) p1[r] = NEGBIG;
                } else if (!clean1) {
#pragma unroll
                    for (int r = 0; r < 16; ++r) { const int kl = crow(r, hi) + 32; if (kl > dq || kl < lo) p1[r] = NEGBIG; }
                }
                float rm = 0.f;
                if (XP != 1 && !stat) { float a = __builtin_fmaxf(__builtin_fmaxf(p0[0], p0[1]), p1[0]), b = __builtin_fmaxf(__builtin_fmaxf(p0[2], p0[3]), p1[1]); a = __builtin_fmaxf(__builtin_fmaxf(a, p1[2]), p1[3]);
#pragma unroll
                  for (int r = 4; r < 16; r += 4) { a = __builtin_fmaxf(__builtin_fmaxf(a, p0[r]), p0[r + 1]); b = __builtin_fmaxf(__builtin_fmaxf(b, p0[r + 2]), p0[r + 3]);
                      a = __builtin_fmaxf(__builtin_fmaxf(a, p1[r]), p1[r + 1]); b = __builtin_fmaxf(__builtin_fmaxf(b, p1[r + 2]), p1[r + 3]); }
                  rm = swapmax(__builtin_fmaxf(a, b)); }
                if (__any(rm > THR)) {
                    const float dl = __builtin_fmaxf(rm, 0.f); mhat[m] += dl;
#pragma unroll
                    for (int r = 0; r < 16; ++r) { p0[r] -= dl; p1[r] -= dl; }
                    if (!ALIBI) {
#pragma unroll
                        for (int r = 0; r < 16; ++r) negm[r] = -mhat[m];
                    }
                    const float f = __builtin_amdgcn_exp2f(-dl); lsum[m] *= f;
                    if (hi == 0) wsf[m * 32 + r32] = f;
                    asm volatile("s_waitcnt lgkmcnt(0)" ::: "memory");
#pragma unroll
                    for (int r = 0; r < 16; ++r) { const float fr_ = wsf[m * 32 + crow(r, hi)]; o[m][0][r] *= fr_; o[m][1][r] *= fr_; if (ONES) osum[r] *= fr_; }
                }
                if (act0) { float sacc = 0.f;
#pragma unroll
                    for (int r = 0; r < 16; ++r) { if (XP != 1) { float x_ = __builtin_amdgcn_exp2f(p0[r]); asm("" : "+v"(x_)); p0[r] = x_; if (!ONES) sacc += x_; } }
                    if (!ONES) lsum[m] += sacc;
                    pw[0] = (u32x4){cvtpk(p0[0], p0[1]), cvtpk(p0[2], p0[3]), cvtpk(p0[4], p0[5]), cvtpk(p0[6], p0[7])};
                    pw[1] = (u32x4){cvtpk(p0[8], p0[9]), cvtpk(p0[10], p0[11]), cvtpk(p0[12], p0[13]), cvtpk(p0[14], p0[15])}; }
                if (act1) { float sacc = 0.f;
#pragma unroll
                    for (int r = 0; r < 16; ++r) { if (XP != 1) { float x_ = __builtin_amdgcn_exp2f(p1[r]); asm("" : "+v"(x_)); p1[r] = x_; if (!ONES) sacc += x_; } }
                    if (!ONES) lsum[m] += sacc;
                    pw[2] = (u32x4){cvtpk(p1[0], p1[1]), cvtpk(p1[2], p1[3]), cvtpk(p1[4], p1[5]), cvtpk(p1[6], p1[7])};
                    pw[3] = (u32x4){cvtpk(p1[8], p1[9]), cvtpk(p1[10], p1[11]), cvtpk(p1[12], p1[13]), cvtpk(p1[14], p1[15])}; }
                if (ATT_SB) __builtin_amdgcn_sched_barrier(0);
#define ATT_PV(KS0, KS1) do { _Pragma("unroll") for (int d0 = 0; d0 < 2; ++d0) { _Pragma("unroll") for (int ks = (KS0); ks < (KS1); ++ks) { \
                        bf16x8 vf; if (XP == 7) vf = qr[m][(d0 * 4 + ks) % NCH]; else { const s16x4 vl = vtr(vp + d0 * 4096 + ks * 1024), vh = vtr(vp + d0 * 4096 + ks * 1024 + 512); \
                        vf = (bf16x8){vl[0], vl[1], vl[2], vl[3], vh[0], vh[1], vh[2], vh[3]}; } \
                        o[m][d0] = __builtin_amdgcn_mfma_f32_32x32x16_bf16(__builtin_bit_cast(bf16x8, pw[ks]), vf, o[m][d0], 0, 0, 0); \
                        if (ONES && d0 == 0) osum = __builtin_amdgcn_mfma_f32_32x32x16_bf16(__builtin_bit_cast(bf16x8, pw[ks]), ones, osum, 0, 0, 0); } \
                    if (ATT_SB) __builtin_amdgcn_sched_barrier(0); } } while (0)
#define ATT_PV2(KS0, KS1) do { _Pragma("unroll") for (int d0 = 0; d0 < 2; ++d0) { _Pragma("unroll") for (int ks = (KS0); ks < (KS1); ++ks) { \
                        const s16x4 vl = vtr(vp + d0 * 4096 + ks * 1024), vh = vtr(vp + d0 * 4096 + ks * 1024 + 512); const bf16x8 vf = (bf16x8){vl[0], vl[1], vl[2], vl[3], vh[0], vh[1], vh[2], vh[3]}; \
                        o[0][d0] = __builtin_amdgcn_mfma_f32_32x32x16_bf16(__builtin_bit_cast(bf16x8, pwk[ks]), vf, o[0][d0], 0, 0, 0); \
                        o[NMAP - 1][d0] = __builtin_amdgcn_mfma_f32_32x32x16_bf16(__builtin_bit_cast(bf16x8, pw[ks]), vf, o[NMAP - 1][d0], 0, 0, 0); } \
                    if (ATT_SB) __builtin_amdgcn_sched_barrier(0); } } while (0)
                constexpr bool SHV = (NMAP == 2) && (ATT_SHV != 0) && (XP == 0) && !STAG;
                if (SHV && m == 0) { pwk[0] = pw[0]; pwk[1] = pw[1]; pwk[2] = pw[2]; pwk[3] = pw[3]; }
                else if (SHV) { if (act0 && act1) ATT_PV2(0, 4); else if (act0) ATT_PV2(0, 2); else ATT_PV2(2, 4); }
                else if (XP == 2) { o[m][0][0] += __uint_as_float(pw[0][0] ^ pw[1][1] ^ pw[2][2] ^ pw[3][3]); }
                else if (STAG && late) { ppw[0] = pw[0]; ppw[1] = pw[1]; ppw[2] = pw[2]; ppw[3] = pw[3]; pend = true; }
                else if (act0 && act1) ATT_PV(0, 4); else if (act0) ATT_PV(0, 2); else ATT_PV(2, 4);
#undef ATT_PV
#undef ATT_PV2
            }
        }
        slot = (slot == NS - 1) ? 0 : slot + 1;
    }
    if constexpr (STAG) { if (pend) { const lds_cptr vq = vp0 + ((slot == 0) ? NS - 1 : slot - 1) * VSLOT;
#pragma unroll
        for (int d0 = 0; d0 < 2; ++d0)
#pragma unroll
            for (int ks = 0; ks < 4; ++ks) { const s16x4 vl = vtr(vq + d0 * 4096 + ks * 1024), vh = vtr(vq + d0 * 4096 + ks * 1024 + 512);
                const bf16x8 vf = (bf16x8){vl[0], vl[1], vl[2], vl[3], vh[0], vh[1], vh[2], vh[3]};
                o[0][d0] = __builtin_amdgcn_mfma_f32_32x32x16_bf16(__builtin_bit_cast(bf16x8, ppw[ks]), vf, o[0][d0], 0, 0, 0); } } }
#pragma unroll
    for (int m = 0; m < NMAP; ++m) {
        float l;
        if (ONES) {
            if (r32 == 0) {
#pragma unroll
                for (int r = 0; r < 16; ++r) wsf[crow(r, hi)] = osum[r]; }
            asm volatile("s_waitcnt lgkmcnt(0)" ::: "memory");
            l = wsf[r32];
            asm volatile("s_waitcnt lgkmcnt(0)" ::: "memory");
        } else l = swapadd(lsum[m]);
        if (EPI == 3) l += __builtin_amdgcn_exp2f(J.sink2 - mhat[m]);
        if (EPI == 1) { if (hi == 0) J.LSE[m * J.lmap + (long)nq * J.ls] = mhat[m] + __builtin_amdgcn_logf(l); }
        if (hi == 0) wsf[m * 32 + r32] = l > 0.f ? __builtin_amdgcn_rcpf(l) : 0.f;
    }
    asm volatile("s_waitcnt lgkmcnt(0)" ::: "memory");
#pragma unroll
    for (int m = 0; m < NMAP; ++m) {
        __hip_bfloat16* stg = (__hip_bfloat16*)(shm + LDS_OST) + wid * 2048;
#pragma unroll
        for (int r = 0; r < 16; ++r) { const int orow = crow(r, hi); const float rl = wsf[m * 32 + orow];
#pragma unroll
            for (int d0 = 0; d0 < 2; ++d0) stg[orow * 64 + d0 * 32 + r32] = __float2bfloat16(o[m][d0][r] * rl); }
        asm volatile("s_waitcnt lgkmcnt(0)" ::: "memory");
        bf16_t* Ow = J.O + m * J.omap + (long)qw * J.os;
#pragma unroll
        for (int i = 0; i < 4; ++i) { const int row = i * 8 + (lane >> 3), ch = lane & 7; const u32x4 v = *(const u32x4*)((const bf16_t*)stg + row * 64 + ch * 8);
            *(u32x4*)(Ow + (long)row * J.os + ch * 8) = v; }
        asm volatile("s_waitcnt lgkmcnt(0)" ::: "memory");
    }
    asm volatile("s_waitcnt lgkmcnt(0)\n\ts_barrier" ::: "memory");
#undef ATT_DMA
}
}

namespace att {
constexpr int P_NSLOT = 4, P_LDS_K = 0, P_LDS_V = P_NSLOT * KSLOT, P_LDS_WS = P_LDS_V + P_NSLOT * VSLOT, P_LDS_OST = P_LDS_WS + NW * 64 * 4, P_LDS_BYTES = P_LDS_OST + NW * 4096;
template <int NCH, bool ALIBI, int EPI, bool QROPE = false>
__device__ __forceinline__ void attn_unit2(const Job& J, char* shm, unsigned* qhead, volatile __attribute__((address_space(3))) unsigned* qslot, const int wave_id) {
    constexpr int NQK = 2 * NCH;
    int lane_; asm volatile("v_mbcnt_lo_u32_b32 %0, -1, 0\n\tv_mbcnt_hi_u32_b32 %0, -1, %0" : "=v"(lane_));
    const int wid = wave_id, lane = lane_, tid = wid * 64 + lane, r32 = lane & 31, hi = lane >> 5;
    unsigned q_next = 0; if (tid == 0) q_next = __hip_atomic_fetch_add(qhead, 1u, __ATOMIC_RELAXED, __HIP_MEMORY_SCOPE_AGENT);
    const unsigned lds0 = (unsigned)(uintptr_t)shm;
    float* wsf = (float*)(shm + P_LDS_WS) + wid * 64;
    const unsigned koffA = (unsigned)(lane * J.ks0 + wid * 8) * 2u, koffB = (NQK > 8) ? (unsigned)(lane * J.ks1 + wid * 8) * 2u : 0u;
    const unsigned voff = (unsigned)((16 * (wid & 3) + (lane >> 2)) * J.vs + (wid >> 2) * 32 + (lane & 3) * 8) * 2u;
    const long kstepA = (long)KVBLK * J.ks0 * 2, kstepB = (NQK > 8) ? (long)KVBLK * J.ks1 * 2 : 0, vstep = (long)KVBLK * J.vs * 2;
    const unsigned kdst = lds0 + P_LDS_K + wid * 1024, vdst = lds0 + P_LDS_V + wid * 1024;
    const bool extraK = (NQK > 8) && (wid < NQK - 8);
#define ATT2_DMA(t, slot) do { pg8::glds_s(koffA, (const char*)J.K0 + (long)(t) * kstepA, kdst + (slot) * KSLOT); \
        if (extraK) pg8::glds_s(koffB, (const char*)J.K1 + (long)(t) * kstepB, kdst + (slot) * KSLOT + 8192); \
        pg8::glds_s(voff, (const char*)J.V + (long)(t) * vstep, vdst + (slot) * VSLOT); } while (0)
    const int qw = J.q0 + wid * QBLK, nq = qw + r32;
    bf16x8 qr[NCH];
    { const bf16_t* qp = J.Q + (long)nq * J.qs + hi * 8;
#pragma unroll
      for (int c = 0; c < NCH; ++c) qr[c] = *reinterpret_cast<const bf16x8*>(qp + c * 16); }
    if constexpr (QROPE) {
        const f32x2_t* rt = J.rope + (size_t)nq * 16 + hi * 4;
#pragma unroll
        for (int c = 0; c < 2; ++c) { bf16x8 q = qr[NCH - 2 + c]; bf16x8 r;
#pragma unroll
            for (int i = 0; i < 4; ++i) { const f32x2_t cs = rt[c * 8 + i]; const float a = __uint_as_float((unsigned)(unsigned short)q[2 * i] << 16), b = __uint_as_float((unsigned)(unsigned short)q[2 * i + 1] << 16);
                const unsigned w = cvtpk(a * cs.x - b * cs.y, b * cs.x + a * cs.y); r[2 * i] = (short)(w & 0xffffu); r[2 * i + 1] = (short)(w >> 16); }
            qr[NCH - 2 + c] = r; __builtin_amdgcn_sched_barrier(0); }
    }
    __builtin_amdgcn_sched_barrier(0);
    const int t_lo = J.t_lo, t_hi = J.t_hi;
    int tw_lo = t_lo; if (J.max_dist < (1 << 27)) { const int a = (qw - J.max_dist) >> 6; tw_lo = a > tw_lo ? a : tw_lo; }
    int tw_hi = ((qw + QBLK - 1) >> 6) + 1; tw_hi = tw_hi < t_hi ? tw_hi : t_hi;
    ATT2_DMA(t_lo, 0); if (t_lo + 1 < t_hi) ATT2_DMA(t_lo + 1, 1);
    float mhat = -1000.f, lsum = 0.f; f32x16 o[2], negm, pc0, pc1, pn0, pn1;
    float zero_ = 0.f; asm volatile("" : "+v"(zero_));
#pragma unroll
    for (int r = 0; r < 16; ++r) { o[0][r] = zero_; o[1][r] = zero_; negm[r] = 1000.f + zero_; pc0[r] = zero_; pc1[r] = zero_; }
    const lds_cptr shm3 = (lds_cptr)shm;
    const lds_cptr kp0 = shm3 + P_LDS_K + hi * 1024 + r32 * 16;
    const lds_cptr vp0 = shm3 + P_LDS_V + ((lane >> 4) & 1) * 32 + (lane & 3) * 8 + (4 * hi + ((lane & 15) >> 2)) * 64;
    bool have_cur = false;
#define ATT2_PC(e) ((e) < 16 ? pc0[(e) & 15] : pc1[(e) & 15])
    for (int i = t_lo - 1; i < t_hi; ++i) {
        if (i + 2 < t_hi) { if (extraK) ATT_WAIT_BAR(3); else ATT_WAIT_BAR(2); } else ATT_WAIT_BAR(0);
        if (i == t_lo - 1 && tid == 0) *qslot = q_next;
        if (i + 3 < t_hi) ATT2_DMA(i + 3, (i + 3 - t_lo) & 3);
        const bool do_next = (i + 1 >= tw_lo) && (i + 1 < tw_hi), do_cur = have_cur;
        const lds_cptr kp = kp0 + ((i + 1 - t_lo) & 3) * KSLOT; const lds_cptr vp = vp0 + ((i - t_lo) & 3) * VSLOT;
        const int k_lo = (i + 1) * KVBLK, dq = nq - k_lo;
        u32x4 pw[4]; float sacc = 0.f;
#define ATT2_INIT() do { if (ALIBI) { const float L = -mhat - J.slope2 * (float)(dq - 4 * hi), L1 = L + 32.f * J.slope2; \
                _Pragma("unroll") for (int r = 0; r < 16; ++r) { pn0[r] = __builtin_fmaf(J.slope2, (float)crow(r, 0), L); pn1[r] = __builtin_fmaf(J.slope2, (float)crow(r, 0), L1); } } \
            else { const float L = -mhat; _Pragma("unroll") for (int r = 0; r < 16; ++r) { pn0[r] = L; pn1[r] = L; } } } while (0)
#define ATT2_KLD(j) (*(const __attribute__((address_space(3))) bf16x8*)(kp + ((j) >> 1) * 2048 + ((j) & 1) * 512))
        if (do_next && do_cur) {
            ATT2_INIT();
            bf16x8 kf[NQK]; kf[0] = ATT2_KLD(0); kf[1] = ATT2_KLD(1);
            __builtin_amdgcn_sched_barrier(0);
#pragma unroll
            for (int j = 0; j < NQK; ++j) {
                if (j + 2 < NQK) kf[j + 2] = ATT2_KLD(j + 2);
                if ((j & 1) == 0) pn0 = __builtin_amdgcn_mfma_f32_32x32x16_bf16(kf[j], qr[j >> 1], pn0, 0, 0, 0);
                else pn1 = __builtin_amdgcn_mfma_f32_32x32x16_bf16(kf[j], qr[j >> 1], pn1, 0, 0, 0);
                const int e0 = j * 32 / NQK, e1 = (j + 1) * 32 / NQK;
#pragma unroll
                for (int e = e0; e < e1; ++e) { const float x = __builtin_amdgcn_exp2f(ATT2_PC(e)); if (e < 16) pc0[e & 15] = x; else pc1[e & 15] = x; sacc += x; }
#pragma unroll
                for (int k = e0 / 2; k < e1 / 2; ++k) pw[k >> 2][k & 3] = cvtpk(ATT2_PC(2 * k), ATT2_PC(2 * k + 1));
                asm volatile("" : "+v"(sacc));
                __builtin_amdgcn_sched_barrier(0);
            }
        } else if (do_next) {
            ATT2_INIT();
#pragma unroll
            for (int j = 0; j < NQK; ++j) { const bf16x8 kfj = ATT2_KLD(j);
                if ((j & 1) == 0) pn0 = __builtin_amdgcn_mfma_f32_32x32x16_bf16(kfj, qr[j >> 1], pn0, 0, 0, 0);
                else pn1 = __builtin_amdgcn_mfma_f32_32x32x16_bf16(kfj, qr[j >> 1], pn1, 0, 0, 0); }
        } else if (do_cur) {
#pragma unroll
            for (int e = 0; e < 32; ++e) { const float x = __builtin_amdgcn_exp2f(ATT2_PC(e)); if (e < 16) pc0[e & 15] = x; else pc1[e & 15] = x; sacc += x; }
#pragma unroll
            for (int k = 0; k < 16; ++k) pw[k >> 2][k & 3] = cvtpk(ATT2_PC(2 * k), ATT2_PC(2 * k + 1));
        }
#undef ATT2_INIT
#undef ATT2_KLD
        lsum += sacc;
        if (do_next) { const bool clean = (k_lo + KVBLK - 1 <= qw) && (qw + QBLK - 1 - k_lo <= J.max_dist);
            if (!clean) { const int lo = dq - J.max_dist;
#pragma unroll
                for (int r = 0; r < 16; ++r) { const int kl = crow(r, hi); if (kl > dq || kl < lo) pn0[r] = NEGBIG; if (kl + 32 > dq || kl + 32 < lo) pn1[r] = NEGBIG; } } }
        __builtin_amdgcn_sched_barrier(0);
        float ma = NEGBIG, mb = NEGBIG;
#define ATT2_VLD(g, VL, VH) do { VL = vtr(vp + ((g) >> 2) * 4096 + ((g) & 3) * 1024); VH = vtr(vp + ((g) >> 2) * 4096 + ((g) & 3) * 1024 + 512); } while (0)
        if (do_cur && do_next) {
            s16x4 vl[8], vh[8]; ATT2_VLD(0, vl[0], vh[0]);
            __builtin_amdgcn_sched_barrier(0);
#pragma unroll
            for (int g = 0; g < 8; ++g) {
                if (g + 1 < 8) ATT2_VLD(g + 1, vl[g + 1], vh[g + 1]);
                const bf16x8 vf = (bf16x8){vl[g][0], vl[g][1], vl[g][2], vl[g][3], vh[g][0], vh[g][1], vh[g][2], vh[g][3]};
                o[g >> 2] = __builtin_amdgcn_mfma_f32_32x32x16_bf16(__builtin_bit_cast(bf16x8, pw[g & 3]), vf, o[g >> 2], 0, 0, 0);
                if (g < 4) { ma = __builtin_fmaxf(__builtin_fmaxf(ma, pn0[4 * g]), pn0[4 * g + 1]); mb = __builtin_fmaxf(__builtin_fmaxf(mb, pn0[4 * g + 2]), pn0[4 * g + 3]); }
                else { ma = __builtin_fmaxf(__builtin_fmaxf(ma, pn1[4 * g - 16]), pn1[4 * g - 15]); mb = __builtin_fmaxf(__builtin_fmaxf(mb, pn1[4 * g - 14]), pn1[4 * g - 13]); }
                asm volatile("" : "+v"(ma), "+v"(mb));
                __builtin_amdgcn_sched_barrier(0);
            }
        } else if (do_cur) {
#pragma unroll
            for (int g = 0; g < 8; ++g) { s16x4 vl_, vh_; ATT2_VLD(g, vl_, vh_);
                const bf16x8 vf = (bf16x8){vl_[0], vl_[1], vl_[2], vl_[3], vh_[0], vh_[1], vh_[2], vh_[3]};
                o[g >> 2] = __builtin_amdgcn_mfma_f32_32x32x16_bf16(__builtin_bit_cast(bf16x8, pw[g & 3]), vf, o[g >> 2], 0, 0, 0); }
        } else if (do_next) {
#pragma unroll
            for (int r = 0; r < 16; r += 2) { ma = __builtin_fmaxf(__builtin_fmaxf(ma, pn0[r]), pn0[r + 1]); mb = __builtin_fmaxf(__builtin_fmaxf(mb, pn1[r]), pn1[r + 1]); }
        }
#undef ATT2_VLD
        if (do_next) {
            const float rm = swapmax(__builtin_fmaxf(ma, mb));
            if (__any(rm > THR)) {
                const float dl = __builtin_fmaxf(rm, 0.f); mhat += dl;
#pragma unroll
                for (int r = 0; r < 16; ++r) { pn0[r] -= dl; pn1[r] -= dl; }
                if (!ALIBI) {
#pragma unroll
                    for (int r = 0; r < 16; ++r) negm[r] = -mhat;
                }
                const float f = __builtin_amdgcn_exp2f(-dl); lsum *= f;
                { const int l_ = lane_now(); if (l_ < 32) wsf[l_] = f; }
                asm volatile("s_waitcnt lgkmcnt(0)" ::: "memory");
#pragma unroll
                for (int r = 0; r < 16; ++r) { const float fr_ = wsf[crow(r, hi)]; o[0][r] *= fr_; o[1][r] *= fr_; }
            }
            pc0 = pn0; pc1 = pn1;
        }
        have_cur = do_next;
    }
#undef ATT2_PC
    { float l = swapadd(lsum);
      if (EPI == 3) l += __builtin_amdgcn_exp2f(J.sink2 - mhat);
      if (EPI == 1) { if (hi == 0) J.LSE[(long)nq * J.ls] = mhat + __builtin_amdgcn_logf(l); }
      { const int l_ = lane_now(); if (l_ < 32) wsf[l_] = l > 0.f ? __builtin_amdgcn_rcpf(l) : 0.f; } }
    asm volatile("s_waitcnt lgkmcnt(0)" ::: "memory");
    { __hip_bfloat16* stg = (__hip_bfloat16*)(shm + P_LDS_OST) + wid * 2048;
#pragma unroll
      for (int r = 0; r < 16; ++r) { const int orow = crow(r, hi); const float rl = wsf[orow];
#pragma unroll
          for (int d0 = 0; d0 < 2; ++d0) stg[orow * 64 + d0 * 32 + r32] = __float2bfloat16(o[d0][r] * rl); }
      asm volatile("s_waitcnt lgkmcnt(0)" ::: "memory");
      bf16_t* Ow = J.O + (long)qw * J.os;
#pragma unroll
      for (int i = 0; i < 4; ++i) { const int row = i * 8 + (lane >> 3), ch = lane & 7; const u32x4 v = *(const u32x4*)((const bf16_t*)stg + row * 64 + ch * 8);
          *(u32x4*)(Ow + (long)row * J.os + ch * 8) = v; } }
    asm volatile("s_waitcnt lgkmcnt(0)\n\ts_barrier" ::: "memory");
#undef ATT2_DMA
}
}

namespace att {
constexpr int BW_LDS = 16384;
template <int EPI>
__device__ __forceinline__ void band_wave(const Job& J, char* wl, float* wsf, const int wid, const unsigned q_next, volatile __attribute__((address_space(3))) unsigned* qslot) {
    int lane_; asm volatile("v_mbcnt_lo_u32_b32 %0, -1, 0\n\tv_mbcnt_hi_u32_b32 %0, -1, %0" : "=v"(lane_));
    const int lane = lane_, r32 = lane & 31, hi = lane >> 5;
    const unsigned wl0 = (unsigned)(uintptr_t)wl;
    const int qw = J.q0 + wid * QBLK, nq = qw + r32;
    bf16x8 qr[4];
    { const bf16_t* qp = J.Q + (long)nq * J.qs + hi * 8;
#pragma unroll
      for (int c = 0; c < 4; ++c) qr[c] = *reinterpret_cast<const bf16x8*>(qp + c * 16); }
    const unsigned vlo = (unsigned)((lane >> 2) * J.vs * 2 + (lane & 3) * 16);
    const long klo = (long)r32 * J.ks0 + hi * 8;
    float mhat = -1000.f, lsum = 0.f; f32x16 o[2];
    float zero_ = 0.f; asm volatile("" : "+v"(zero_));
#pragma unroll
    for (int r = 0; r < 16; ++r) { o[0][r] = zero_; o[1][r] = zero_; }
    const lds_cptr wl3 = (lds_cptr)wl;
    const lds_cptr vp0 = wl3 + ((lane >> 4) & 1) * 32 + (lane & 3) * 8 + (4 * hi + ((lane & 15) >> 2)) * 64;
    bf16x8 kA[2][4], kB[2][4], kC[1][4];
#define BW_KB(s, jb) (qw - 128 + 64 * (s) + 32 * (jb))
#define BW_LOADK(dst, s, jb) do { const int kb_ = BW_KB(s, jb) > 0 ? BW_KB(s, jb) : 0; const bf16_t* kp_ = J.K0 + (long)kb_ * J.ks0 + klo; \
        _Pragma("unroll") for (int c = 0; c < 4; ++c) dst[jb][c] = *reinterpret_cast<const bf16x8*>(kp_ + c * 16); } while (0)
#define BW_DMAV(s, jb) do { const int kb_ = BW_KB(s, jb) > 0 ? BW_KB(s, jb) : 0; \
        _Pragma("unroll") for (int i = 0; i < 4; ++i) pg8::glds_s(vlo, (const char*)(J.V + (long)(kb_ + (i & 1) * 16) * J.vs + (i >> 1) * 32), wl0 + ((s) & 1) * 8192 + (jb) * 4096 + (i >> 1) * 2048 + (i & 1) * 1024); } while (0)
    BW_DMAV(0, 0); BW_DMAV(0, 1); BW_DMAV(1, 0); BW_DMAV(1, 1);
    BW_LOADK(kA, 0, 0); BW_LOADK(kA, 0, 1); BW_LOADK(kB, 1, 0); BW_LOADK(kB, 1, 1); BW_LOADK(kC, 2, 0);
#define BW_STEP(s, KF, NB) do { \
        if ((s) != 1) asm volatile("s_waitcnt vmcnt(0)" ::: "memory"); \
        if ((s) == 0 && wid == 0 && lane == 0) *qslot = q_next;       \
        const int kb0 = BW_KB(s, 0), dq = nq - kb0; \
        f32x16 p0, p1; \
        { const float L = -mhat - J.slope2 * (float)(dq - 4 * hi), L1 = L + 32.f * J.slope2; \
          _Pragma("unroll") for (int r = 0; r < 16; ++r) { float a_ = __builtin_fmaf(J.slope2, (float)crow(r, 0), L), b_ = __builtin_fmaf(J.slope2, (float)crow(r, 0), L1); asm("" : "+v"(a_)); asm("" : "+v"(b_)); p0[r] = a_; p1[r] = b_; } } \
        _Pragma("unroll") for (int c = 0; c < 4; ++c) { p0 = __builtin_amdgcn_mfma_f32_32x32x16_bf16(KF[0][c], qr[c], p0, 0, 0, 0); \
            if ((NB) == 2) p1 = __builtin_amdgcn_mfma_f32_32x32x16_bf16(KF[1][c], qr[c], p1, 0, 0, 0); } \
          \
        { const int lo = dq - J.max_dist; const bool v0 = kb0 >= 0, v1 = kb0 + 32 >= 0; \
          if ((s) == 0) { _Pragma("unroll") for (int r = 0; r < 16; ++r) { const int kl = crow(r, hi); if (kl < lo) p0[r] = NEGBIG; } \
              if ((NB) == 2 && J.max_dist < 97) { _Pragma("unroll") for (int r = 0; r < 16; ++r) { const int kl = crow(r, hi) + 32; if (kl < lo) p1[r] = NEGBIG; } } } \
          if ((s) == 2) { _Pragma("unroll") for (int r = 0; r < 16; ++r) { const int kl = crow(r, hi); if (kl > dq) p0[r] = NEGBIG; } } \
          if (!v0) { _Pragma("unroll") for (int r = 0; r < 16; ++r) p0[r] = NEGBIG; } \
          if ((NB) == 2 && !v1) { _Pragma("unroll") for (int r = 0; r < 16; ++r) p1[r] = NEGBIG; } } \
        float rm; \
        { float a = NEGBIG, b = NEGBIG; \
          _Pragma("unroll") for (int r = 0; r < 16; r += 2) { a = __builtin_fmaxf(__builtin_fmaxf(a, p0[r]), p0[r + 1]); if ((NB) == 2) b = __builtin_fmaxf(__builtin_fmaxf(b, p1[r]), p1[r + 1]); } \
          rm = swapmax(__builtin_fmaxf(a, b)); } \
        if (__any(rm > THR)) { const float dl = __builtin_fmaxf(rm, 0.f); mhat += dl; \
            _Pragma("unroll") for (int r = 0; r < 16; ++r) { p0[r] -= dl; p1[r] -= dl; } \
            const float f = __builtin_amdgcn_exp2f(-dl); lsum *= f; \
            if (hi == 0) wsf[r32] = f; \
            asm volatile("s_waitcnt lgkmcnt(0)" ::: "memory"); \
            _Pragma("unroll") for (int r = 0; r < 16; ++r) { const float fr_ = wsf[crow(r, hi)]; o[0][r] *= fr_; o[1][r] *= fr_; } } \
        u32x4 pw[4]; float sacc = 0.f; \
        _Pragma("unroll") for (int r = 0; r < 16; ++r) { float x_ = __builtin_amdgcn_exp2f(p0[r]); asm("" : "+v"(x_)); p0[r] = x_; sacc += x_; if ((NB) == 2) { float y_ = __builtin_amdgcn_exp2f(p1[r]); asm("" : "+v"(y_)); p1[r] = y_; sacc += y_; } } \
        lsum += sacc; \
        pw[0] = (u32x4){cvtpk(p0[0], p0[1]), cvtpk(p0[2], p0[3]), cvtpk(p0[4], p0[5]), cvtpk(p0[6], p0[7])}; \
        pw[1] = (u32x4){cvtpk(p0[8], p0[9]), cvtpk(p0[10], p0[11]), cvtpk(p0[12], p0[13]), cvtpk(p0[14], p0[15])}; \
        if ((NB) == 2) { pw[2] = (u32x4){cvtpk(p1[0], p1[1]), cvtpk(p1[2], p1[3]), cvtpk(p1[4], p1[5]), cvtpk(p1[6], p1[7])}; \
            pw[3] = (u32x4){cvtpk(p1[8], p1[9]), cvtpk(p1[10], p1[11]), cvtpk(p1[12], p1[13]), cvtpk(p1[14], p1[15])}; } \
        const lds_cptr vp = vp0 + ((s) & 1) * 8192; \
        _Pragma("unroll") for (int d0 = 0; d0 < 2; ++d0) _Pragma("unroll") for (int g = 0; g < 2 * (NB); ++g) { \
            const s16x4 vl = vtr(vp + (g >> 1) * 4096 + d0 * 2048 + (g & 1) * 1024), vh = vtr(vp + (g >> 1) * 4096 + d0 * 2048 + (g & 1) * 1024 + 512); \
            const bf16x8 vf = (bf16x8){vl[0], vl[1], vl[2], vl[3], vh[0], vh[1], vh[2], vh[3]}; \
            o[d0] = __builtin_amdgcn_mfma_f32_32x32x16_bf16(__builtin_bit_cast(bf16x8, pw[g]), vf, o[d0], 0, 0, 0); } \
        if ((s) == 0) { asm volatile("s_waitcnt lgkmcnt(0)" ::: "memory"); BW_DMAV(2, 0); } \
    } while (0)
    BW_STEP(0, kA, 2);
    BW_STEP(1, kB, 2);
    BW_STEP(2, kC, 1);
#undef BW_STEP
#undef BW_LOADK
#undef BW_DMAV
#undef BW_KB
    { float l = swapadd(lsum);
      if (EPI == 3) l += __builtin_amdgcn_exp2f(J.sink2 - mhat);
      if (EPI == 1) { if (hi == 0) J.LSE[(long)nq * J.ls] = mhat + __builtin_amdgcn_logf(l); }
      if (hi == 0) wsf[r32] = l > 0.f ? __builtin_amdgcn_rcpf(l) : 0.f; }
    asm volatile("s_waitcnt lgkmcnt(0)" ::: "memory");
    { __hip_bfloat16* stg = (__hip_bfloat16*)(wl + 8192);
#pragma unroll
      for (int r = 0; r < 16; ++r) { const int orow = crow(r, hi); const float rl = wsf[orow];
#pragma unroll
          for (int d0 = 0; d0 < 2; ++d0) stg[orow * 64 + d0 * 32 + r32] = __float2bfloat16(o[d0][r] * rl); }
      asm volatile("s_waitcnt lgkmcnt(0)" ::: "memory");
      bf16_t* Ow = J.O + (long)qw * J.os;
#pragma unroll
      for (int i = 0; i < 4; ++i) { const int row = i * 8 + (lane >> 3), ch = lane & 7; const u32x4 v = *(const u32x4*)((const bf16_t*)stg + row * 64 + ch * 8);
          *(u32x4*)(Ow + (long)row * J.os + ch * 8) = v; } }
    asm volatile("s_waitcnt lgkmcnt(0)" ::: "memory");
}
}
#ifndef MK_PER_PHASE
#define MK_PER_PHASE 0
#endif
constexpr int NWAVES = 8;
constexpr int NB = 4, S = 8192, T = NB * S, D = 1024;
constexpr int NQKV = 2592, NQKVP = 2816;
constexpr int FF = 2816, FE = 3584, NEXP = 8;
constexpr float RMS_EPS = 1e-6f;
#ifndef FFN8
#define FFN8 3
#endif
constexpr float LOG2E = 1.4426950408889634f;
constexpr float MOE_WSCALE = 64.0f;
constexpr int C_QA = 0, C_KA = 256, C_VA = 512, C_QB = 768, C_KB = 1024, C_VB = 1280, C_QD = 1536, C_KD = 1792, C_VD = 1920, C_CQ = 2048, C_CKV = 2432, C_KPE = 2560;

constexpr size_t MiB = 1u << 20;
constexpr size_t WS_CTL = 0, CTL_ZERO_BYTES = 1 * MiB;
constexpr size_t WS_ROPE = 1 * MiB;
constexpr size_t WS_WIN = 2 * MiB, WIN_L = (size_t)NQKVP * D * 2;
constexpr size_t WS_WOUT = 13 * MiB, WOUT_L = (size_t)D * D * 2;
constexpr size_t WS_WUQ = 17 * MiB, WUQ_L = (size_t)512 * 384 * 2;
constexpr size_t WS_WUKV = 17 * MiB + 768 * 1024, WUKV_L = (size_t)512 * 128 * 2;
constexpr size_t WS_W13 = 18 * MiB, WS_W2 = 29 * MiB;
constexpr size_t WS_R1 = 35 * MiB;
constexpr size_t WS_QKV = 99 * MiB, WS_QM = 261 * MiB, WS_KVM = 285 * MiB, WS_OB = 317 * MiB, OB_L = (size_t)T * 256 * 2, WS_LSE = 365 * MiB, LSE_L = (size_t)T * 4 * 4;
constexpr size_t WS_PA = 367 * MiB, WS_PC = 431 * MiB, WS_LA = 463 * MiB, WS_LC = 465 * MiB;
constexpr size_t WS_XB = 440 * MiB, WS_SSQ = 505 * MiB;
constexpr size_t WS_G = 99 * MiB;
constexpr size_t WS_MW13 = 99 * MiB, WS_MW2 = 211 * MiB, WS_GM = 267 * MiB, GM_L = (size_t)64 * 256 * FE  , WS_Y = 379 * MiB;
constexpr size_t WS_RT = 511 * MiB, RT_SEL = 0, RT_GATE = 256 * 1024, RT_POS = 512 * 1024, RT_TOK = 768 * 1024, RT_BLK = 1280 * 1024;
constexpr size_t WS_SSQ2 = 513 * MiB;
constexpr size_t WS_END = 515 * MiB;
static_assert(WS_WIN + 2 * WIN_L <= WS_WOUT && WS_WOUT + 2 * WOUT_L <= WS_WUQ && WS_WUQ + 2 * WUQ_L <= WS_WUKV && WS_WUKV + 2 * WUKV_L <= WS_W13, "ws map 1");
static_assert(WS_W13 + (size_t)2 * FF * D * 2 <= WS_W2 && WS_W2 + (size_t)D * FF * 2 <= WS_R1 && WS_R1 + (size_t)T * D * 2 <= WS_QKV, "ws map 2");
static_assert(WS_QKV + (size_t)T * NQKV * 2 <= WS_QM && WS_QM + (size_t)T * 384 * 2 <= WS_KVM && WS_KVM + (size_t)T * 512 * 2 <= WS_OB && WS_OB + 3 * OB_L <= WS_LSE && WS_LSE + 3 * LSE_L <= WS_RT, "ws map 3");
static_assert(WS_G + (size_t)T * FF * 2 <= WS_XB && WS_XB + (size_t)T * D * 2 <= WS_SSQ && WS_SSQ + (size_t)T * 16 * 4 <= WS_RT, "ws map 4");
static_assert(WS_LSE + 3 * LSE_L <= WS_PA && WS_PA + 4 * OB_L <= WS_PC && WS_PC + 2 * OB_L <= WS_LA && WS_LA + 4 * LSE_L <= WS_LC && WS_LC + 2 * LSE_L <= WS_RT, "ws map 6");
static_assert(WS_MW13 + (size_t)NEXP * 2 * FE * D <= WS_MW2 && WS_MW2 + (size_t)NEXP * D * FE <= WS_GM && WS_GM + 2 * GM_L <= WS_Y && WS_Y + (size_t)264 * 256 * D * 2 <= WS_RT, "ws map 5");
constexpr int CW_TMO = 0, CW_CODE = 1;
constexpr int CW_BAR = 4096;
constexpr int CW_Q = 120000;
constexpr int CW_HIST = 122000;
constexpr int CW_KMAX = 124160;
constexpr int CW_KMAXC = CW_KMAX + 64;
constexpr int CW_RDY = CW_KMAX + 140;
constexpr int CW_KPE = CW_KMAX + 128;
static_assert(CW_HIST + 256 * 8 <= CW_KMAX && (CW_KMAX + 144) * 4 <= (int)CTL_ZERO_BYTES, "CTL words inside the memset region");

constexpr int RING_OFF = 0, RING_BYTES = 131072;
constexpr int LDSCTL_OFF = RING_BYTES, MISC_OFF = LDSCTL_OFF + 320;
constexpr int LDS_BYTES = 147456;

#define GAS __attribute__((address_space(1)))
#define LAS __attribute__((address_space(3)))
typedef unsigned short bf16;
typedef unsigned v4u __attribute__((ext_vector_type(4)));
typedef unsigned v2u __attribute__((ext_vector_type(2)));
typedef float f32x4 __attribute__((ext_vector_type(4)));
typedef float f32x2 __attribute__((ext_vector_type(2)));
typedef GAS unsigned gu32;
#define RLX_AGENT __ATOMIC_RELAXED, __HIP_MEMORY_SCOPE_AGENT
#define LDS_WAIT() asm volatile("s_waitcnt lgkmcnt(0)" ::: "memory")
#define VM_WAIT() asm volatile("s_waitcnt vmcnt(0)" ::: "memory")
__device__ __forceinline__ unsigned f2bf(float f) { unsigned u = __builtin_bit_cast(unsigned, f); return (u + 0x7fffu + ((u >> 16) & 1u)) >> 16; }
__device__ __forceinline__ unsigned pk2(float lo, float hi) { return f2bf(lo) | (f2bf(hi) << 16); }
__device__ __forceinline__ float bflo(unsigned w) { return __uint_as_float(w << 16); }
__device__ __forceinline__ float bfhi(unsigned w) { return __uint_as_float(w & 0xffff0000u); }

#define XB_TMO      128
#define XB_XCNT(j)  (256  + 64 * (j))
#define XB_XSUB(j)  (1280 + 64 * (j))
#define XB_XGEN(j)  (2304 + 64 * (j))
#define XB_TOP      3328
#define XB_TOPGEN   3392
#define XCD_BAR_WORDS 3456
#define XB_SPIN_CAP (1u << 18)
__device__ __forceinline__ unsigned xb_ld(unsigned* p)              { return __hip_atomic_load(p, __ATOMIC_RELAXED, __HIP_MEMORY_SCOPE_AGENT); }
__device__ __forceinline__ unsigned xb_add(unsigned* p, unsigned v) { return __hip_atomic_fetch_add(p, v, __ATOMIC_RELAXED, __HIP_MEMORY_SCOPE_AGENT); }
__device__ __forceinline__ unsigned xb_xcc_id() { return (unsigned)__builtin_amdgcn_s_getreg((3 << 11) | 20) & 0xFu; }
#define XB_SPIN(cond, bar) do { unsigned _sp = 0; while (cond) { __builtin_amdgcn_s_sleep(1); \
    if ((++_sp & 255u) == 0u) { if (xb_ld(&(bar)[XB_TMO])) break; if (_sp > XB_SPIN_CAP) { atomicAdd(&(bar)[XB_TMO], 1u); break; } } } } while (0)
struct XcdBarrier { unsigned* bar; unsigned x; volatile LAS unsigned* st; };
__device__ __forceinline__ XcdBarrier xcd_barrier_post(unsigned* bar, volatile LAS unsigned* st) {
    XcdBarrier b; b.bar = bar; b.x = xb_xcc_id(); b.st = st;
    if (threadIdx.x == 0) (void)xb_add(&bar[XB_XCNT(b.x)], 1u);
    return b;
}
__device__ __forceinline__ void xcd_barrier_complete(unsigned* bar, unsigned x, unsigned& nloc, unsigned& nx) {
    const unsigned G = gridDim.x * gridDim.y * gridDim.z;
    unsigned sum, cnt, mine, sp = 0u;
    for (;;) {
        sum = 0u; cnt = 0u; mine = 0u;
#pragma unroll
        for (unsigned j = 0; j < 16; ++j) { const unsigned c = xb_ld(&bar[XB_XCNT(j)]); sum += c; cnt += (c > 0u) ? 1u : 0u; mine = (j == x) ? c : mine; }
        if (sum == G) break;
        __builtin_amdgcn_s_sleep(1);
        if ((++sp & 255u) == 0u) { if (xb_ld(&bar[XB_TMO])) break; if (sp > XB_SPIN_CAP) { atomicAdd(&bar[XB_TMO], 1u); break; } }
    }
    nloc = mine > 0u ? mine : 1u; nx = cnt > 0u ? cnt : 1u;
}
__device__ __forceinline__ void xcd_barrier(const XcdBarrier& b) {
    asm volatile("s_waitcnt vmcnt(0)" ::: "memory");
    __syncthreads();
    if (threadIdx.x == 0) {
        unsigned* bar = b.bar;
        __builtin_amdgcn_s_waitcnt(0);
        unsigned nloc = b.st[0], nx = b.st[1];
        if (nloc == 0u) { xcd_barrier_complete(bar, b.x, nloc, nx); b.st[0] = nloc; b.st[1] = nx; }
        const unsigned old = xb_add(&bar[XB_XSUB(b.x)], 1u);
        const unsigned gen = old / nloc;
        if (old + 1u == (gen + 1u) * nloc) {
            __builtin_amdgcn_fence(__ATOMIC_RELEASE, "agent");
            asm volatile("s_waitcnt vmcnt(0)" ::: "memory");
            const unsigned og = xb_add(&bar[XB_TOP], 1u);
            const unsigned tg = og / nx;
            if (og + 1u == (tg + 1u) * nx) xb_add(&bar[XB_TOPGEN], 1u);
            else XB_SPIN(xb_ld(&bar[XB_TOPGEN]) == tg, bar);
            __builtin_amdgcn_fence(__ATOMIC_ACQUIRE, "agent");
            xb_add(&bar[XB_XGEN(b.x)], 1u);
            asm volatile("s_waitcnt vmcnt(0)" ::: "memory");
        } else {
            XB_SPIN(xb_ld(&bar[XB_XGEN(b.x)]) == gen, bar);
            __builtin_amdgcn_fence(__ATOMIC_ACQUIRE, "agent");
            asm volatile("s_waitcnt vmcnt(0)" ::: "memory");
        }
    }
    __syncthreads();
}

struct Frame {
    LAS unsigned char* lds;
    volatile LAS unsigned* MISC;
    int tid, lane, wave, vcu, G, bx;
};
#define CAS __attribute__((address_space(4)))
__device__ __forceinline__ const CAS char* kargs() { const CAS char* p = (const CAS char*)__builtin_amdgcn_kernarg_segment_ptr(); asm volatile("" : "+s"(p)); return p; }
__device__ __forceinline__ const float* gin(int k) { return *(const float* const CAS*)(kargs() + 8 * k); }
__device__ __forceinline__ float* gout() { return *(float* const CAS*)(kargs() + 160); }
__device__ __forceinline__ unsigned char* gws() { return *(unsigned char* const CAS*)(kargs() + 168); }
__device__ __forceinline__ gu32* gctl() { return (gu32*)gws(); }
__device__ __forceinline__ float wave_sum(float v, int lane) {
#pragma unroll
    for (int o = 1; o < 64; o <<= 1) v += __int_as_float(__builtin_amdgcn_ds_bpermute((lane ^ o) << 2, __float_as_int(v)));
    return v;
}

__device__ __forceinline__ void wmap(int kind, int aux, int n, int& drow, float& sc) {
    sc = 1.f; drow = n + aux;
    if (kind == 1) {
        if (n < 1536) { drow = n; if (n < 256) sc = 0.17677669529663687f * LOG2E; else if (n >= 768 && n < 1024) sc = 0.125f * LOG2E; }
        else if (n < 2048) drow = n + 512;
        else if (n < 2080) { const int j = n - 2048; drow = C_KPE + (j < 16 ? 2 * j : 2 * (j - 16) + 1); }
        else { drow = n - 544; if (n < 2336) sc = 0.125f * LOG2E; }
    } else if (kind == 2) {
        const int h = n / 96, dd = n % 96; sc = 0.10206207261596575f * LOG2E;
        drow = (dd < 64) ? n : h * 96 + 64 + ((dd - 64) < 16 ? 2 * (dd - 64) : 2 * (dd - 80) + 1);
    } else if (kind == 3) {
        drow = (n >> 7) * 256 + aux * 128 + (n & 127);
    }
}
__device__ __forceinline__ void tr_item(const float* W, int K, int N, bf16* WT, LAS float* scr, int item, int lane, int kind, int aux, const float* kscale = nullptr) {
    const int nblk = N / 32, kb = item / nblk, nb = item % nblk, k0 = 64 * kb, n0 = 32 * nb;
    float wv[32];
#pragma unroll
    for (int i = 0; i < 32; ++i) { const int kk = 2 * i + (lane >> 5); wv[i] = __builtin_nontemporal_load(W + (size_t)(k0 + kk) * N + n0 + (lane & 31)); }
#pragma unroll
    for (int i = 0; i < 32; ++i) { const int kk = 2 * i + (lane >> 5); scr[kk * 33 + (lane & 31)] = wv[i]; }
    LDS_WAIT(); asm volatile("" ::: "memory");
    const int c = lane & 7;
    float kg[8];
#pragma unroll
    for (int e = 0; e < 8; ++e) kg[e] = kscale ? kscale[k0 + 8 * c + e] : 1.0f;
#pragma unroll
    for (int j = 0; j < 4; ++j) { const int n = (lane >> 3) + 8 * j; const LAS float* s = scr + (8 * c) * 33 + n; int drow; float sc; wmap(kind, aux, n0 + n, drow, sc);
        float ks[8];
#pragma unroll
        for (int e = 0; e < 8; ++e) ks[e] = sc * kg[e];
        v4u o; o.x = pk2(s[0 * 33] * ks[0], s[1 * 33] * ks[1]); o.y = pk2(s[2 * 33] * ks[2], s[3 * 33] * ks[3]); o.z = pk2(s[4 * 33] * ks[4], s[5 * 33] * ks[5]); o.w = pk2(s[6 * 33] * ks[6], s[7 * 33] * ks[7]);
        *(GAS v4u*)(WT + (size_t)drow * K + k0 + 8 * c) = o; }
    LDS_WAIT(); asm volatile("" ::: "memory");
}
__device__ __forceinline__ void tr_item8(const float* W, int K, int N, unsigned char* WT, LAS float* scr, int item, int lane, int kind, int aux, float scale, const float* kscale = nullptr) {
    const int nblk = N / 32, kb = item / nblk, nb = item % nblk, k0 = 64 * kb, n0 = 32 * nb;
    float wv[32];
#pragma unroll
    for (int i = 0; i < 32; ++i) { const int kk = 2 * i + (lane >> 5); wv[i] = __builtin_nontemporal_load(W + (size_t)(k0 + kk) * N + n0 + (lane & 31)); }
#pragma unroll
    for (int i = 0; i < 32; ++i) { const int kk = 2 * i + (lane >> 5); scr[kk * 33 + (lane & 31)] = wv[i]; }
    LDS_WAIT(); asm volatile("" ::: "memory");
    const int c = lane & 7;
#pragma unroll
    for (int j = 0; j < 4; ++j) { const int n = (lane >> 3) + 8 * j; const LAS float* s = scr + (8 * c) * 33 + n; int drow; float sc; wmap(kind, aux, n0 + n, drow, sc); sc *= scale;
        float ks[8];
#pragma unroll
        for (int e = 0; e < 8; ++e) ks[e] = kscale ? sc * kscale[k0 + 8 * c + e] : sc;
        int w0 = __builtin_amdgcn_cvt_pk_fp8_f32(s[0 * 33] * ks[0], s[1 * 33] * ks[1], 0, false); w0 = __builtin_amdgcn_cvt_pk_fp8_f32(s[2 * 33] * ks[2], s[3 * 33] * ks[3], w0, true);
        int w1 = __builtin_amdgcn_cvt_pk_fp8_f32(s[4 * 33] * ks[4], s[5 * 33] * ks[5], 0, false); w1 = __builtin_amdgcn_cvt_pk_fp8_f32(s[6 * 33] * ks[6], s[7 * 33] * ks[7], w1, true);
        *(GAS v2u*)(WT + (size_t)drow * K + k0 + 8 * c) = (v2u){(unsigned)w0, (unsigned)w1}; }
    LDS_WAIT(); asm volatile("" ::: "memory");
}
__device__ __forceinline__ void row_load(const float* xrow, int lane, f32x4 (&v)[4]) {
    const GAS f32x4* xr = (const GAS f32x4*)xrow + lane;
#pragma unroll
    for (int j = 0; j < 4; ++j) v[j] = xr[64 * j];
}
__device__ __forceinline__ void rms_fin(const f32x4 (&gn)[4], bf16* orow, int lane, f32x4 (&v)[4]) {
    float s = 0.f;
#pragma unroll
    for (int j = 0; j < 4; ++j) s += (v[j].x * v[j].x + v[j].y * v[j].y) + (v[j].z * v[j].z + v[j].w * v[j].w);
    const float r = 1.0f / sqrtf(wave_sum(s, lane) * (1.f / D) + RMS_EPS);
    GAS unsigned long long* o8 = (GAS unsigned long long*)orow + lane;
#pragma unroll
    for (int j = 0; j < 4; ++j) { v[j] = v[j] * r * gn[j]; o8[64 * j] = (unsigned long long)pk2(v[j].x, v[j].y) | ((unsigned long long)pk2(v[j].z, v[j].w) << 32); }
}
__device__ __forceinline__ void rms_fin8(const f32x4 (&gn)[4], unsigned char* orow, int lane, f32x4 (&v)[4]) {
    float s = 0.f;
#pragma unroll
    for (int j = 0; j < 4; ++j) s += (v[j].x * v[j].x + v[j].y * v[j].y) + (v[j].z * v[j].z + v[j].w * v[j].w);
    const float r = 1.0f / sqrtf(wave_sum(s, lane) * (1.f / D) + RMS_EPS);
    GAS int* o4 = (GAS int*)orow + lane;
#pragma unroll
    for (int j = 0; j < 4; ++j) { v[j] = v[j] * r * gn[j]; int w = __builtin_amdgcn_cvt_pk_fp8_f32(v[j].x, v[j].y, 0, false); w = __builtin_amdgcn_cvt_pk_fp8_f32(v[j].z, v[j].w, w, true); o4[64 * j] = w; }
}
__device__ __forceinline__ void load_gain(const float* g, int lane, f32x4 (&gn)[4]) {
#pragma unroll
    for (int j = 0; j < 4; ++j) gn[j] = *((const GAS f32x4*)g + lane + 64 * j);
}
__device__ __forceinline__ void norm_rows(Frame& F, const float* x, const float* gain, bf16* out) {
    f32x4 gn[4]; load_gain(gain, F.lane, gn);
    const int r0 = F.bx * (T / 256) + F.wave * 16;
    f32x4 cur[4], nxt[4], nx2[4]; row_load(x + (size_t)r0 * D, F.lane, cur); row_load(x + (size_t)(r0 + 1) * D, F.lane, nxt);
    for (int i = 0; i < 16; ++i) { if (i + 2 < 16) row_load(x + (size_t)(r0 + i + 2) * D, F.lane, nx2);
        rms_fin(gn, out + (size_t)(r0 + i) * D, F.lane, cur);
#pragma unroll
        for (int j = 0; j < 4; ++j) { cur[j] = nxt[j]; nxt[j] = nx2[j]; } }
}

__device__ __forceinline__ void p0_prologue(Frame& F) {
    LAS float* scr = (LAS float*)(F.lds + RING_OFF + F.wave * 16384);
    const int gw = F.vcu * NWAVES + F.wave, NGW = F.G * NWAVES;
    constexpr int I_IN = 16 * 81, I_OUT = 16 * 32, I_UQ = 6 * 12, I_UKV = 2 * 16, I_L = I_IN + I_OUT + I_UQ + I_UKV, I_F = 16 * 88, I_F2 = 44 * 32;
    constexpr int NITEMS = 2 * I_L + 2 * I_F + I_F2;
    unsigned char* ws = gws();
    for (int it = gw; it < NITEMS; it += NGW) {
        int r = it;
        if (r < 2 * I_L) { const int l = r / I_L; r -= l * I_L;
            if (r < I_IN) { tr_item(gin(2) + (size_t)l * D * NQKV, D, NQKV, (bf16*)(ws + WS_WIN + l * WIN_L), scr, r, F.lane, 1, 0, l == 1 ? gin(1) + D : nullptr); continue; } r -= I_IN;
            if (r < I_OUT) { tr_item(gin(3) + (size_t)l * D * D, D, D, (bf16*)(ws + WS_WOUT + l * WOUT_L), scr, r, F.lane, 0, 0); continue; } r -= I_OUT;
            if (r < I_UQ) { tr_item(gin(7) + (size_t)l * 384 * 384, 384, 384, (bf16*)(ws + WS_WUQ + l * WUQ_L), scr, r, F.lane, 2, 0, gin(6) + l * 384); continue; } r -= I_UQ;
            tr_item(gin(9) + (size_t)l * 128 * 512, 128, 512, (bf16*)(ws + WS_WUKV + l * WUKV_L), scr, r, F.lane, 0, 0, gin(8) + l * 128); continue; }
        r -= 2 * I_L;
#if FFN8 == 1 || FFN8 == 2
        if (r < I_F) { tr_item8(gin(12), D, FF, ws + WS_W13, scr, r, F.lane, 3, 0, MOE_WSCALE, gin(11)); continue; } r -= I_F;
        if (r < I_F) { tr_item8(gin(13), D, FF, ws + WS_W13, scr, r, F.lane, 3, 1, MOE_WSCALE, gin(11)); continue; } r -= I_F;
#else
        if (r < I_F) { tr_item(gin(12), D, FF, (bf16*)(ws + WS_W13), scr, r, F.lane, 3, 0, gin(11)); continue; } r -= I_F;
        if (r < I_F) { tr_item(gin(13), D, FF, (bf16*)(ws + WS_W13), scr, r, F.lane, 3, 1, gin(11)); continue; } r -= I_F;
#endif
#if FFN8 == 1 || FFN8 == 3
        tr_item8(gin(14), FF, D, ws + WS_W2, scr, r, F.lane, 0, 0, MOE_WSCALE);
#else
        tr_item(gin(14), FF, D, (bf16*)(ws + WS_W2), scr, r, F.lane, 0, 0);
#endif
    }
    { const int gt = (F.vcu * NWAVES + F.wave) * 64 + F.lane, NGT = NGW * 64; const v4u z = {0u, 0u, 0u, 0u};
      for (int l = 0; l < 2; ++l) {
        GAS v4u* p = (GAS v4u*)(ws + WS_WIN + l * WIN_L + (size_t)NQKV * D * 2); const int n1 = (NQKVP - NQKV) * D * 2 / 16;
        for (int i = gt; i < n1; i += NGT) p[i] = z;
        GAS v4u* q = (GAS v4u*)(ws + WS_WUQ + l * WUQ_L + (size_t)384 * 384 * 2); const int n2 = 128 * 384 * 2 / 16;
        for (int i = gt; i < n2; i += NGT) q[i] = z; }
      const double invf[16] = {0.15915494309189535, 0.08949940160889101, 0.050329212104487035, 0.0283021958306234, 0.015915494309189534, 0.008949940160889102, 0.005032921210448704, 0.00283021958306234,
                               0.0015915494309189536, 0.0008949940160889102, 0.0005032921210448703, 0.00028302195830623395, 0.00015915494309189535, 8.949940160889102e-05, 5.0329212104487035e-05, 2.8302195830623396e-05};
      GAS f32x2* rt = (GAS f32x2*)(ws + WS_ROPE);
      for (int i = gt; i < S * 16; i += NGT) { const int pos = i >> 4, j = i & 15; double f = invf[0];
#pragma unroll
          for (int q = 1; q < 16; ++q) f = (j == q) ? invf[q] : f;
          const double rev = (double)pos * f; const float fr = (float)(rev - __builtin_floor(rev));
          rt[i] = (f32x2){__builtin_amdgcn_cosf(fr), __builtin_amdgcn_sinf(fr)}; } }
    norm_rows(F, gin(0), gin(1), (bf16*)(ws + WS_R1));
}
__device__ __forceinline__ void moe_weights(Frame& F) {
    LAS float* scr = (LAS float*)(F.lds + RING_OFF + F.wave * 16384);
    const int gw = F.vcu * NWAVES + F.wave, NGW = F.G * NWAVES;
    constexpr int I_U = 16 * 112, I_D = 56 * 32, I_E = 2 * I_U + I_D, NITEMS = NEXP * I_E;
    for (int it = gw; it < NITEMS; it += NGW) { const int e = it / I_E; int r = it - e * I_E;
        unsigned char* w13 = gws() + WS_MW13 + (size_t)e * 2 * FE * D; unsigned char* w2 = gws() + WS_MW2 + (size_t)e * D * FE;
        if (r < I_U) { tr_item8(gin(16) + (size_t)e * D * FE, D, FE, w13, scr, r, F.lane, 3, 0, MOE_WSCALE); continue; } r -= I_U;
        if (r < I_U) { tr_item8(gin(17) + (size_t)e * D * FE, D, FE, w13, scr, r, F.lane, 3, 1, MOE_WSCALE); continue; } r -= I_U;
        tr_item8(gin(18) + (size_t)e * FE * D, FE, D, w2, scr, r, F.lane, 0, 0, MOE_WSCALE); }
}

__device__ __forceinline__ void mla_prep(Frame& F, int layer) {
    bf16* qkv = (bf16*)(gws() + WS_QKV); const GAS f32x2* rope = (const GAS f32x2*)(gws() + WS_ROPE);
    const int lane = F.lane;
    const int r0 = F.bx * (T / 256) + F.wave * 16;
    float kpm = 0.f;
    float kmx = 0.f;
    for (int i0 = 0; i0 < 16; i0 += 4) { v2u kw4[4]; v4u kp4[4]; f32x2 cs4[4][4];
#pragma unroll
        for (int k = 0; k < 4; ++k) { const int row = r0 + i0 + k; kw4[k] = *((const GAS v2u*)(qkv + (size_t)row * NQKV + C_KA) + lane);
            if (lane < 4) { kp4[k] = *((const GAS v4u*)(qkv + (size_t)row * NQKV + C_KPE) + lane); const GAS f32x2* rt = rope + (size_t)(row & (S - 1)) * 16 + lane * 4; cs4[k][0] = rt[0]; cs4[k][1] = rt[1]; cs4[k][2] = rt[2]; cs4[k][3] = rt[3]; } }
#pragma unroll
        for (int k = 0; k < 4; ++k) { const int row = r0 + i0 + k;
            { const v2u kw = kw4[k]; const float k0 = bflo(kw.x), k1 = bfhi(kw.x), k2 = bflo(kw.y), k3 = bfhi(kw.y);
              float s2 = (k0 * k0 + k1 * k1) + (k2 * k2 + k3 * k3);
#pragma unroll
              for (int o_ = 1; o_ < 8; o_ <<= 1) s2 += __int_as_float(__builtin_amdgcn_ds_bpermute((lane ^ o_) << 2, __float_as_int(s2)));
              kmx = fmaxf(kmx, s2); }
            if (lane < 4) { GAS v4u* kp = (GAS v4u*)(qkv + (size_t)row * NQKV + C_KPE) + lane; const v4u k_ = kp4[k];
                const f32x2 c0 = cs4[k][0], c1 = cs4[k][1], c2 = cs4[k][2], c3 = cs4[k][3]; v4u ko;
                { const float a = bflo(k_.x), b = bfhi(k_.x); ko.x = pk2(a * c0.x - b * c0.y, b * c0.x + a * c0.y); }
                { const float a = bflo(k_.y), b = bfhi(k_.y); ko.y = pk2(a * c1.x - b * c1.y, b * c1.x + a * c1.y); }
                { const float a = bflo(k_.z), b = bfhi(k_.z); ko.z = pk2(a * c2.x - b * c2.y, b * c2.x + a * c2.y); }
                { const float a = bflo(k_.w), b = bfhi(k_.w); ko.w = pk2(a * c3.x - b * c3.y, b * c3.x + a * c3.y); }
                *kp = ko;
                float s2 = ((bflo(ko.x) * bflo(ko.x) + bfhi(ko.x) * bfhi(ko.x)) + (bflo(ko.y) * bflo(ko.y) + bfhi(ko.y) * bfhi(ko.y))) + ((bflo(ko.z) * bflo(ko.z) + bfhi(ko.z) * bfhi(ko.z)) + (bflo(ko.w) * bflo(ko.w) + bfhi(ko.w) * bfhi(ko.w)));
                s2 += __int_as_float(__builtin_amdgcn_ds_bpermute((lane ^ 1) << 2, __float_as_int(s2))); s2 += __int_as_float(__builtin_amdgcn_ds_bpermute((lane ^ 2) << 2, __float_as_int(s2)));
                kpm = fmaxf(kpm, s2); } } }
    if (lane == 0) __hip_atomic_fetch_max((unsigned*)gctl() + CW_KPE + layer * 4 + (r0 >> 13), __float_as_uint(kpm), __ATOMIC_RELAXED, __HIP_MEMORY_SCOPE_AGENT);
    if ((lane & 7) == 0) __hip_atomic_fetch_max((unsigned*)gctl() + CW_KMAX + layer * 32 + (r0 >> 13) * 8 + (lane >> 3), __float_as_uint(kmx), __ATOMIC_RELAXED, __HIP_MEMORY_SCOPE_AGENT);
}

__device__ __forceinline__ float xsum16(float v, int lane) {
#pragma unroll
    for (int o_ = 1; o_ < 16; o_ <<= 1) v += __int_as_float(__builtin_amdgcn_ds_bpermute((lane ^ o_) << 2, __float_as_int(v)));
    return v;
}
__device__ __forceinline__ void merge2(const bf16* pa, const bf16* pb, float la, float lb, bool two, int lane, float (&o)[4]) {
    const v2u a = *((const GAS v2u*)pa + lane); float w0 = 1.f, w1 = 0.f; v2u b = {0u, 0u};
    if (two) { b = *((const GAS v2u*)pb + lane); const float mx = fmaxf(la, lb); w0 = __builtin_amdgcn_exp2f(la - mx); w1 = __builtin_amdgcn_exp2f(lb - mx); const float inv = 1.0f / (w0 + w1); w0 *= inv; w1 *= inv; }
    o[0] = w0 * bflo(a.x) + w1 * bflo(b.x); o[1] = w0 * bfhi(a.x) + w1 * bfhi(b.x); o[2] = w0 * bflo(a.y) + w1 * bflo(b.y); o[3] = w0 * bfhi(a.y) + w1 * bfhi(b.y);
}
__device__ __forceinline__ void merge2r(const v2u a, const v2u b, float la, float lb, bool two, float (&o)[4]) {
    float w0 = 1.f, w1 = 0.f;
    if (two) { const float mx = fmaxf(la, lb); w0 = __builtin_amdgcn_exp2f(la - mx); w1 = __builtin_amdgcn_exp2f(lb - mx); const float inv = 1.0f / (w0 + w1); w0 *= inv; w1 *= inv; }
    o[0] = w0 * bflo(a.x) + w1 * bflo(b.x); o[1] = w0 * bfhi(a.x) + w1 * bfhi(b.x); o[2] = w0 * bflo(a.y) + w1 * bflo(b.y); o[3] = w0 * bfhi(a.y) + w1 * bfhi(b.y);
}
__device__ __forceinline__ void attn_combine(Frame& F, int layer) {
    const bf16* ob = (const bf16*)(gws() + WS_OB); const float* lse = (const float*)(gws() + WS_LSE); bf16* o = (bf16*)(gws() + WS_R1);
    const bf16* pa = (const bf16*)(gws() + WS_PA); const bf16* pc = (const bf16*)(gws() + WS_PC); const float* la = (const float*)(gws() + WS_LA); const float* lc = (const float*)(gws() + WS_LC);
    const int lane = F.lane, h = lane >> 4; const int r0 = F.bx * (T / 256) + F.wave * 16;
    float lam, osc;
    { const float* lp = gin(4) + layer * 128; float a = 0.f, b = 0.f;
      if (lane < 32) { a = lp[lane] * lp[32 + lane]; b = lp[64 + lane] * lp[96 + lane]; }
      a = wave_sum(a, lane); b = wave_sum(b, lane);
      const float lam_init = 0.8f - 0.6f * __expf(-0.3f * (float)layer); lam = __expf(a) - __expf(b) + lam_init; osc = 1.0f - lam_init; }
    const f32x4 sg = *((const GAS f32x4*)(gin(5) + layer * 64) + (lane & 15));
    const size_t TL = (size_t)T * 4, TO = (size_t)T * 256;
    const bool two = (r0 & (S - 1)) >= 4096;
    struct RowIn { float l[3]; v2u b[3]; float lcv[2]; v2u c[2]; float lav[4]; v2u a[4]; };
    for (int i0 = 0; i0 < 16; i0 += 4) { RowIn in[4];
#pragma unroll
        for (int k = 0; k < 4; ++k) { const int row = r0 + i0 + k; const size_t ro = (size_t)row * 256, rl = (size_t)row * 4 + h; RowIn& R = in[k];
            R.l[0] = lse[rl]; R.l[1] = lse[TL + rl]; R.l[2] = lse[2 * TL + rl];
            R.b[0] = *((const GAS v2u*)(ob + ro) + lane); R.b[1] = *((const GAS v2u*)(ob + TO + ro) + lane); R.b[2] = *((const GAS v2u*)(ob + 2 * TO + ro) + lane);
            R.lcv[0] = lc[rl]; R.c[0] = *((const GAS v2u*)(pc + ro) + lane); R.lav[0] = la[rl]; R.lav[2] = la[2 * TL + rl]; R.a[0] = *((const GAS v2u*)(pa + ro) + lane); R.a[2] = *((const GAS v2u*)(pa + 2 * TO + ro) + lane);
            R.lcv[1] = 0.f; R.lav[1] = 0.f; R.lav[3] = 0.f; R.c[1] = (v2u){0u, 0u}; R.a[1] = (v2u){0u, 0u}; R.a[3] = (v2u){0u, 0u};
            if (two) { R.lcv[1] = lc[TL + rl]; R.c[1] = *((const GAS v2u*)(pc + TO + ro) + lane); R.lav[1] = la[TL + rl]; R.lav[3] = la[3 * TL + rl]; R.a[1] = *((const GAS v2u*)(pa + TO + ro) + lane); R.a[3] = *((const GAS v2u*)(pa + 3 * TO + ro) + lane); } }
#pragma unroll
        for (int k = 0; k < 4; ++k) { const int row = r0 + i0 + k; const RowIn& R = in[k];
            { const float l0 = R.l[0], l1 = R.l[1], l2 = R.l[2];
              const float mx = fmaxf(l0, fmaxf(l1, l2)); float w0 = __builtin_amdgcn_exp2f(l0 - mx), w1 = __builtin_amdgcn_exp2f(l1 - mx), w2 = __builtin_amdgcn_exp2f(l2 - mx);
              const float inv = 1.0f / (w0 + w1 + w2); w0 *= inv; w1 *= inv; w2 *= inv;
              const v2u a = R.b[0], b = R.b[1], c = R.b[2];
              v2u r; r.x = pk2(w0 * bflo(a.x) + w1 * bflo(b.x) + w2 * bflo(c.x), w0 * bfhi(a.x) + w1 * bfhi(b.x) + w2 * bfhi(c.x));
              r.y = pk2(w0 * bflo(a.y) + w1 * bflo(b.y) + w2 * bflo(c.y), w0 * bfhi(a.y) + w1 * bfhi(b.y) + w2 * bfhi(c.y));
              *((GAS v2u*)(o + (size_t)row * D + 256) + lane) = r; }
            { float v[4]; merge2r(R.c[0], R.c[1], R.lcv[0], R.lcv[1], two, v);
              v2u r; r.x = pk2(v[0], v[1]); r.y = pk2(v[2], v[3]); *((GAS v2u*)(o + (size_t)row * D + 512) + lane) = r; }
            { float v0[4], v1[4]; merge2r(R.a[0], R.a[1], R.lav[0], R.lav[1], two, v0); merge2r(R.a[2], R.a[3], R.lav[2], R.lav[3], two, v1);
              float d[4], ss = 0.f;
#pragma unroll
              for (int e = 0; e < 4; ++e) { d[e] = v0[e] - lam * v1[e]; ss += d[e] * d[e]; }
              ss = xsum16(ss, lane); const float rs = (1.0f / sqrtf(ss * (1.0f / 64.0f) + RMS_EPS)) * osc;
              v2u r; r.x = pk2(d[0] * rs * sg.x, d[1] * rs * sg.y); r.y = pk2(d[2] * rs * sg.z, d[3] * rs * sg.w); *((GAS v2u*)(o + (size_t)row * D) + lane) = r; } } }
}

__device__ __forceinline__ void norm2_router(Frame& F, int layer, bool moe) {
    const float* x1 = gout(); bf16* h2 = (bf16*)(gws() + WS_R1); const int lane = F.lane;
    f32x4 gn[4]; load_gain(gin(11) + layer * D, lane, gn);
    const int r0 = F.bx * (T / 256) + F.wave * 16;
    f32x4 cur[4], nxt[4]; row_load(x1 + (size_t)r0 * D, lane, cur);
    if (!moe) {
        for (int i = 0; i < 16; ++i) { if (i + 1 < 16) row_load(x1 + (size_t)(r0 + i + 1) * D, lane, nxt);
            rms_fin(gn, h2 + (size_t)(r0 + i) * D, lane, cur);
#pragma unroll
            for (int j = 0; j < 4; ++j) cur[j] = nxt[j]; }
        return; }
    int* sel = (int*)(gws() + WS_RT + RT_SEL); float* gate = (float*)(gws() + WS_RT + RT_GATE);
    const float* rw = gin(15);
    volatile LAS unsigned* lh = F.MISC + 16;
    f32x4 wr[16][2];
#pragma unroll
    for (int j = 0; j < 4; ++j)
#pragma unroll
        for (int c = 0; c < 4; ++c) { const GAS f32x4* wp = (const GAS f32x4*)(rw + (size_t)(4 * lane + 256 * j + c) * 8); wr[j * 4 + c][0] = wp[0]; wr[j * 4 + c][1] = wp[1]; }
    f32x4 nx2[4]; row_load(x1 + (size_t)(r0 + 1) * D, lane, nxt);
    for (int i = 0; i < 16; ++i) { const int row = r0 + i; f32x4 v[4];
        if (i + 2 < 16) row_load(x1 + (size_t)(row + 2) * D, lane, nx2);
#pragma unroll
        for (int j = 0; j < 4; ++j) v[j] = cur[j];
        rms_fin8(gn, (unsigned char*)h2 + (size_t)row * D, lane, v);
#pragma unroll
        for (int j = 0; j < 4; ++j) { cur[j] = nxt[j]; nxt[j] = nx2[j]; }
        float lg[8];
#pragma unroll
        for (int e = 0; e < 8; ++e) lg[e] = 0.f;
#pragma unroll
        for (int j = 0; j < 4; ++j)
#pragma unroll
            for (int c = 0; c < 4; ++c) { const f32x4 wa = wr[j * 4 + c][0], wb = wr[j * 4 + c][1]; const float xv = v[j][c];
                lg[0] += xv * wa.x; lg[1] += xv * wa.y; lg[2] += xv * wa.z; lg[3] += xv * wa.w; lg[4] += xv * wb.x; lg[5] += xv * wb.y; lg[6] += xv * wb.z; lg[7] += xv * wb.w; }
#pragma unroll
        for (int e = 0; e < 8; ++e) lg[e] = wave_sum(lg[e], lane);
        int i1 = 0; float v1 = lg[0];
#pragma unroll
        for (int e = 1; e < 8; ++e) if (lg[e] > v1) { v1 = lg[e]; i1 = e; }
        int i2 = -1; float v2 = -3.0e38f;
#pragma unroll
        for (int e = 0; e < 8; ++e) if (e != i1 && lg[e] > v2) { v2 = lg[e]; i2 = e; }
        const float g1 = 1.0f / (1.0f + __expf(v2 - v1));
        if (lane == 0) { sel[row * 2] = i1; sel[row * 2 + 1] = i2; gate[row * 2] = g1; gate[row * 2 + 1] = 1.0f - g1;
            __hip_atomic_fetch_add((LAS unsigned*)lh + i1, 1u, __ATOMIC_RELAXED, __HIP_MEMORY_SCOPE_WORKGROUP); __hip_atomic_fetch_add((LAS unsigned*)lh + i2, 1u, __ATOMIC_RELAXED, __HIP_MEMORY_SCOPE_WORKGROUP); } }
    __syncthreads();
    if (F.tid < 8) __hip_atomic_store((unsigned*)gctl() + CW_HIST + F.bx * 8 + F.tid, (unsigned)lh[F.tid], RLX_AGENT);
    asm volatile("s_waitcnt vmcnt(0)" ::: "memory"); __syncthreads();
    if (F.tid == 0) { __builtin_amdgcn_fence(__ATOMIC_RELEASE, "agent"); (void)__hip_atomic_fetch_add((unsigned*)gctl() + CW_RDY, 1u, RLX_AGENT); }
}
__device__ __forceinline__ void hist_wait(Frame& F) {
    if (F.tid == 0) { unsigned sp_ = 0; while (__hip_atomic_load((unsigned*)gctl() + CW_RDY, RLX_AGENT) < (unsigned)F.G) { __builtin_amdgcn_s_sleep(2); if (++sp_ > (1u << 22)) break; }
        __builtin_amdgcn_fence(__ATOMIC_ACQUIRE, "agent"); }
    __syncthreads();
}

__device__ __forceinline__ void route_assign(Frame& F) {
    LAS int* L = (LAS int*)(F.lds + RING_OFF);
    const unsigned* hist = (const unsigned*)gctl() + CW_HIST;
    for (int i = F.tid; i < 2048; i += NWAVES * 64) L[i] = (int)__hip_atomic_load(hist + i, RLX_AGENT);
    __syncthreads();
    if (F.tid < 8) { int tot = 0, before = 0;
#pragma unroll 16
        for (int w = 0; w < 256; ++w) { const int c = L[w * 8 + F.tid]; tot += c; before += (w < F.bx) ? c : 0; } L[2048 + F.tid] = tot; L[2048 + 16 + F.tid] = before; }
    __syncthreads();
    if (F.tid == 0) { int ps = 0; for (int e = 0; e < 8; ++e) { const int c = L[2048 + e], pd = (c + 255) / 256 * 256; L[2048 + 8 + e] = ps; L[2048 + 16 + e] += ps; L[2048 + 24 + e] = pd; ps += pd; } L[2048 + 32] = ps / 256; }
    __syncthreads();
    const int* sel = (const int*)(gws() + WS_RT + RT_SEL); int* pos = (int*)(gws() + WS_RT + RT_POS); int* tokv = (int*)(gws() + WS_RT + RT_TOK); int* blk = (int*)(gws() + WS_RT + RT_BLK);
    if (F.wave == 0) {
        const int lane = F.lane; const unsigned long long lt = (1ull << lane) - 1ull;
        int run[8];
#pragma unroll
        for (int e = 0; e < 8; ++e) run[e] = L[2048 + 16 + e];
        int sl[2][2];
#pragma unroll
        for (int half = 0; half < 2; ++half) { const int row = F.bx * 128 + half * 64 + lane; sl[half][0] = sel[row * 2]; sl[half][1] = sel[row * 2 + 1]; }
#pragma unroll
        for (int half = 0; half < 2; ++half) { const int row = F.bx * 128 + half * 64 + lane; const int s0 = sl[half][0], s1 = sl[half][1]; int d0 = 0, d1 = 0;
#pragma unroll
            for (int e = 0; e < 8; ++e) { const unsigned long long m0 = __ballot(s0 == e), m1 = __ballot(s1 == e); const int rk = run[e] + __popcll(m0 & lt) + __popcll(m1 & lt);
                if (s0 == e) d0 = rk; if (s1 == e) d1 = rk; run[e] += __popcll(m0) + __popcll(m1); }
            pos[row * 2] = d0; pos[row * 2 + 1] = d1; tokv[d0] = row; tokv[d1] = row; }
    }
    if (F.bx == 0) {
        const int nblk = L[2048 + 32];
        for (int rb = F.tid; rb < 272; rb += NWAVES * 64) { int e = 0;
#pragma unroll
            for (int q = 0; q < 8; ++q) if (rb * 256 >= L[2048 + 8 + q] + L[2048 + 24 + q]) e = q + 1;
            blk[rb] = e > 7 ? 7 : e; }
        if (F.tid == 0) blk[272] = nblk;
        for (int e = 0; e < 8; ++e) { const int a = L[2048 + 8 + e] + L[2048 + e], b = L[2048 + 8 + e] + L[2048 + 24 + e]; for (int s = a + F.tid; s < b; s += NWAVES * 64) tokv[s] = 0; }
    }
}

__device__ __forceinline__ void final_combine(Frame& F, int mode, int w0) {
    const int lane = F.lane; f32x4 gn[4]; load_gain(gin(19), lane, gn);
    const int* pos = (const int*)(gws() + WS_RT + RT_POS); const float* gate = (const float*)(gws() + WS_RT + RT_GATE); const bf16* Y = (const bf16*)(gws() + WS_Y);
    const int gw = (F.bx - w0) * NWAVES + F.wave, NGW = (F.G - w0) * NWAVES; constexpr int MAINROWS = 256 * 256;
    if (gw < 0) return;
    f32x4 xc[4], xn[4]; v2u ac[4], bc[4], an[4], bn[4]; float g0c = 0.f, g1c = 0.f, g0n = 0.f, g1n = 0.f; int pmc = 0, pmn = 0;
#define FC_LOAD(row, X, A, B, G0, G1, PM) do { const int p0_ = pos[(row) * 2], p1_ = pos[(row) * 2 + 1]; PM = p0_ > p1_ ? p0_ : p1_; G0 = gate[(row) * 2]; G1 = gate[(row) * 2 + 1]; \
        const GAS f32x4* xr_ = (const GAS f32x4*)(gout() + (size_t)(row) * D) + lane; const GAS v2u* y0_ = (const GAS v2u*)(Y + (size_t)p0_ * D) + lane; const GAS v2u* y1_ = (const GAS v2u*)(Y + (size_t)p1_ * D) + lane; \
        _Pragma("unroll") for (int j = 0; j < 4; ++j) { X[j] = xr_[64 * j]; A[j] = y0_[64 * j]; B[j] = y1_[64 * j]; } } while (0)
#define FC_FINISH(row) do { f32x4 v[4]; float s = 0.f; \
        _Pragma("unroll") for (int j = 0; j < 4; ++j) { const v2u a = ac[j], b = bc[j]; f32x4 x = xc[j]; \
            x.x += g0c * bflo(a.x) + g1c * bflo(b.x); x.y += g0c * bfhi(a.x) + g1c * bfhi(b.x); x.z += g0c * bflo(a.y) + g1c * bflo(b.y); x.w += g0c * bfhi(a.y) + g1c * bfhi(b.y); \
            v[j] = x; s += (x.x * x.x + x.y * x.y) + (x.z * x.z + x.w * x.w); } \
        const float r = 1.0f / sqrtf(wave_sum(s, lane) * (1.f / D) + RMS_EPS); \
        GAS f32x4* xw = (GAS f32x4*)(gout() + (size_t)(row) * D) + lane; \
        _Pragma("unroll") for (int j = 0; j < 4; ++j) xw[64 * j] = v[j] * r * gn[j]; } while (0)
    if (mode == 0) {
        if (gw < T) FC_LOAD(gw, xc, ac, bc, g0c, g1c, pmc);
        for (int row = gw; row < T; row += NGW) {
            if (row + NGW < T) FC_LOAD(row + NGW, xn, an, bn, g0n, g1n, pmn);
            if (pmc < MAINROWS) FC_FINISH(row);
#pragma unroll
            for (int j = 0; j < 4; ++j) { xc[j] = xn[j]; ac[j] = an[j]; bc[j] = bn[j]; }
            g0c = g0n; g1c = g1n; pmc = pmn; }
    } else {
        int pm16[16];
#pragma unroll
        for (int k = 0; k < 16; ++k) { const int row = gw + k * NGW; int p0_ = 0, p1_ = 0; if (row < T) { p0_ = pos[row * 2]; p1_ = pos[row * 2 + 1]; } pm16[k] = p0_ > p1_ ? p0_ : p1_; }
#pragma unroll
        for (int k = 0; k < 16; ++k) { const int row = gw + k * NGW;
            if (pm16[k] >= MAINROWS) { FC_LOAD(row, xc, ac, bc, g0c, g1c, pmc); FC_FINISH(row); } }
        for (int row = gw + 16 * NGW; row < T; row += NGW) { const int p0_ = pos[row * 2], p1_ = pos[row * 2 + 1];
            if ((p0_ > p1_ ? p0_ : p1_) < MAINROWS) continue;
            FC_LOAD(row, xc, ac, bc, g0c, g1c, pmc); FC_FINISH(row); }
    }
#undef FC_LOAD
#undef FC_FINISH
}
__device__ __forceinline__ int q_first(Frame& F, gu32* head) {
    __syncthreads();
    if (F.tid == 0) F.MISC[24] = __hip_atomic_fetch_add(head, 1u, RLX_AGENT);
    __syncthreads(); const int u = __builtin_amdgcn_readfirstlane((int)F.MISC[24]); __syncthreads(); return u;
}
#define ATT_QARGS (unsigned*)qh_, (volatile LAS unsigned*)(F.MISC + 24), F.wave
#define ATT_LOOP(head, NUNITS, ...) do { gu32* qh_ = (head); int u_ = q_first(F, qh_); while (u_ < (NUNITS)) { bool ran_ = false; \
        { const int u = u_; __VA_ARGS__ } if (ran_) u_ = __builtin_amdgcn_readfirstlane((int)F.MISC[24]); else u_ = q_first(F, qh_); } } while (0)

#ifndef ATT_PIPE_C
#define ATT_PIPE_C 0
#endif
#ifndef ATT_PIPE_D
#define ATT_PIPE_D 0
#endif
#ifndef ATT_PIPE_B
#define ATT_PIPE_B 0
#endif
__device__ __forceinline__ void attn_phase(Frame& F, int layer, int rep = 0) {
    char* shm = (char*)F.lds + RING_OFF;
    const att::bf16_t* qkv = (const att::bf16_t*)(gws() + WS_QKV); const att::bf16_t* qm = (const att::bf16_t*)(gws() + WS_QM); const att::bf16_t* kvm = (const att::bf16_t*)(gws() + WS_KVM);
    att::bf16_t* o = (att::bf16_t*)(gws() + WS_R1); att::bf16_t* ob = (att::bf16_t*)(gws() + WS_OB); float* lse = (float*)(gws() + WS_LSE);
    att::bf16_t* pa = (att::bf16_t*)(gws() + WS_PA); att::bf16_t* pc = (att::bf16_t*)(gws() + WS_PC); float* la = (float*)(gws() + WS_LA); float* lc = (float*)(gws() + WS_LC);
    gu32* heads = gctl() + CW_Q + layer * 4 * 64 + rep * 512;
    const int BIG = 1 << 28;
    __syncthreads();
    if (F.tid < 68) { const unsigned* src = (const unsigned*)gctl() + (F.tid < 32 ? CW_KMAX + layer * 32 + F.tid : F.tid < 64 ? CW_KMAXC + layer * 32 + (F.tid - 32) : CW_KPE + layer * 4 + (F.tid - 64));
        F.MISC[32 + F.tid] = __hip_atomic_load(src, RLX_AGENT); }
#ifndef DBG_SKIP_C
#define DBG_SKIP_C 0
#endif
#ifndef PROBE_AC
#define PROBE_AC 0
#endif
  for (int pass = 0; pass < (PROBE_AC ? 2 : 1); ++pass)
    ATT_LOOP(heads + pass * 64, 1568, {
        const bool isC = (u >= 196 && u < 980);
        if (pass == 1 && (isC ? PROBE_AC != 2 : PROBE_AC != 1)) { }
        else if (isC) {
            const int i = u - 196; int qb, bh, ck;
            if (i < 272) { ck = 0; bh = i / 17; qb = 31 - (i % 17); }   else { const int j = i - 272, g = j >> 5, r = j & 31; if (r < 16) { ck = 1; qb = 31 - g; bh = r; } else { ck = 0; qb = 14 - g; bh = r - 16; } }
            if (qb >= 0 && !DBG_SKIP_C) {
                const int b_ = bh >> 2, h = bh & 3, nt = 4 * qb + 4; const long rb = (long)b_ * S;
                att::Job J; J.Q = qm + rb * 384 + h * 96; J.qs = 384; J.K0 = kvm + rb * 512 + h * 128; J.ks0 = 512; J.K1 = qkv + rb * NQKV + C_KPE; J.ks1 = NQKV;
                J.V = kvm + rb * 512 + h * 128 + 64; J.vs = 512; J.O = pc + (size_t)ck * T * 256 + rb * 256 + h * 64; J.os = 256; J.omap = 0; J.LSE = lc + (size_t)ck * T * 4 + rb * 4 + h; J.ls = 4; J.lmap = 0;
                J.q0 = qb * 256; J.t_lo = ck ? 0 : (nt > 64 ? nt - 64 : 0); J.t_hi = ck ? nt - 64 : nt; J.max_dist = BIG; J.slope2 = 0.f; J.sink2 = 0.f; J.rope = (const att::f32x2_t*)(gws() + WS_ROPE); J.kmax2[1] = 0.f;
                J.kmax2[0] = (__uint_as_float(__builtin_amdgcn_readfirstlane(F.MISC[64 + bh * 2])) + __uint_as_float(__builtin_amdgcn_readfirstlane(F.MISC[64 + bh * 2 + 1]))) + __uint_as_float(__builtin_amdgcn_readfirstlane(F.MISC[96 + b_]));
#ifndef PROBE_XP
#define PROBE_XP 0
#endif
#ifndef PROBE_STAG
#define PROBE_STAG 0
#endif
#ifndef ATT_SMAX_C
#define ATT_SMAX_C 1
#endif
#ifndef ATT_STAG_C
#define ATT_STAG_C 0
#endif
                if (pass == 1) { J.O = (att::bf16_t*)(gws() + (size_t)470 * MiB) + (size_t)ck * T * 256 + rb * 256 + h * 64; J.LSE = (float*)(gws() + (size_t)504 * MiB) + (size_t)ck * T * 4 + rb * 4 + h;
                    att::attn_unit<6, 1, false, 1, true, true, PROBE_XP, (PROBE_STAG != 0)>(J, shm, ATT_QARGS); }
                else if constexpr (ATT_PIPE_C) att::attn_unit2<6, false, 1, true>(J, shm, ATT_QARGS); else att::attn_unit<6, 1, false, 1, true, (ATT_SMAX_C != 0), 0, (ATT_STAG_C != 0)>(J, shm, ATT_QARGS);
                ran_ = true;
            }
        } else {
            const int i = u < 196 ? u : u - 784; const int h = 3 - i / 196, ii = i % 196; int qb, b_, ck;
            if (ii < 68) { ck = 0; qb = 31 - (ii >> 2); b_ = ii & 3; } else { const int j = ii - 68, g = j >> 3, r = j & 7; if (r < 4) { ck = 1; qb = 31 - g; b_ = r; } else { ck = 0; qb = 14 - g; b_ = r - 4; } }
            if (qb >= 0) {
                const int nt = 4 * qb + 4; const long rb = (long)b_ * S;
                att::Job J; J.Q = qkv + rb * NQKV + C_QA + h * 64; J.qs = NQKV; J.K0 = qkv + rb * NQKV + C_KA + h * 64; J.ks0 = NQKV; J.K1 = nullptr; J.ks1 = 0;
                J.V = qkv + rb * NQKV + C_VA + h * 64; J.vs = NQKV; J.O = pa + (size_t)ck * T * 256 + rb * 256 + h * 64; J.os = 256; J.omap = (long)2 * T * 256;
                J.LSE = la + (size_t)ck * T * 4 + rb * 4 + h; J.ls = 4; J.lmap = (long)2 * T * 4;
                J.q0 = qb * 256; J.t_lo = ck ? 0 : (nt > 64 ? nt - 64 : 0); J.t_hi = ck ? nt - 64 : nt; J.max_dist = BIG; J.slope2 = exp2f(-(2.f / 3.f) * (float)(3 * h + 1)) * LOG2E; J.sink2 = 0.f; J.rope = nullptr;
                J.kmax2[0] = __uint_as_float(__builtin_amdgcn_readfirstlane(F.MISC[32 + b_ * 8 + h * 2])); J.kmax2[1] = __uint_as_float(__builtin_amdgcn_readfirstlane(F.MISC[32 + b_ * 8 + h * 2 + 1]));
                att::attn_unit<2, 2, true, 1, false, true>(J, shm, ATT_QARGS); ran_ = true;
            }
        }
    });
    __syncthreads();
    {
        char* wl = shm + F.wave * att::BW_LDS; float* wsfb = (float*)((char*)F.lds + MISC_OFF + 1024) + F.wave * 64;
#ifndef PROBE_BAND
#define PROBE_BAND 1
#endif
      for (int pass = 0; pass < PROBE_BAND; ++pass) {
        gu32* bq = heads + (2 + pass) * 64;
        int u = q_first(F, bq); int par_ = 0;
        while (u < 2048) {
            unsigned un_ = 0; if (F.tid == 0) un_ = __hip_atomic_fetch_add(bq, 1u, RLX_AGENT);
            const int ws_ = F.wave;
            att::Job J; J.K1 = nullptr; J.ks1 = 0; J.omap = 0; J.lmap = 0; J.rope = nullptr; J.kmax2[0] = 0.f; J.kmax2[1] = 0.f; J.t_lo = 0; J.t_hi = 0;
            if (u < 512) {
                const int qb = u >> 4, bh = u & 15, b_ = bh >> 2, h = bh & 3, g = h >> 1; const long rb = (long)b_ * S;
                J.Q = qkv + rb * NQKV + C_QD + h * 64; J.qs = NQKV; J.K0 = qkv + rb * NQKV + C_KD + g * 64; J.ks0 = NQKV; J.V = qkv + rb * NQKV + C_VD + g * 64; J.vs = NQKV;
                J.O = o + rb * D + 768 + h * 64; J.os = D; J.LSE = nullptr; J.ls = 0; J.q0 = qb * 256; J.max_dist = 127; J.slope2 = exp2f(-2.f * (float)(h + 1)) * LOG2E;
                J.sink2 = __builtin_bit_cast(float, __builtin_amdgcn_readfirstlane(__builtin_bit_cast(int, gin(10)[layer * 4 + h]))) * LOG2E;
                att::band_wave<3>(J, wl, wsfb, ws_, un_, F.MISC + 26 + par_);
            } else {
                const int v = u - 512, pat = v >> 9, w2 = v & 511, bh = w2 & 15, b_ = bh >> 2, h = bh & 3, w = w2 >> 4;
                const int dsh = 2 * pat, d = 1 << dsh; const int nblk = 32 >> dsh, cls = w / nblk, qb = w % nblk; const long rb = (long)b_ * S + cls;
                J.Q = qkv + rb * NQKV + C_QB + h * 64; J.qs = NQKV * d; J.K0 = qkv + rb * NQKV + C_KB + h * 64; J.ks0 = NQKV * d; J.V = qkv + rb * NQKV + C_VB + h * 64; J.vs = NQKV * d;
                J.O = ob + (size_t)pat * T * 256 + rb * 256 + h * 64; J.os = 256 * d; J.LSE = lse + (size_t)pat * T * 4 + rb * 4 + h; J.ls = 4 * d;
                J.q0 = qb * 256; J.max_dist = 128; J.slope2 = exp2f(-(2.f / 3.f) * (float)(3 * h + 2)) * (float)d * LOG2E; J.sink2 = 0.f;
                att::band_wave<1>(J, wl, wsfb, ws_, un_, F.MISC + 26 + par_);
            }
            asm volatile("s_waitcnt lgkmcnt(0)\n\ts_barrier" ::: "memory"); u = __builtin_amdgcn_readfirstlane((int)F.MISC[26 + par_]); par_ ^= 1;
        }
      }
    }
}

constexpr int G1_DEFER = 5;
struct SkipColOrder { pg8::StaticOrder s;
    __device__ __forceinline__ bool next(int i, pg8::Unit& u) const { if (!s.next(i, u)) return false; if (u.pn >= G1_DEFER) ++u.pn; return true; } };
struct OneTileOrder { int pm, pn;
    __device__ __forceinline__ bool next(int i, pg8::Unit& u) const { if (pm < 0 || i >= 1) return false; u.pm = pm; u.pa = pm; u.pn = pn; return true; } };

struct MoeUpOrder { int rbl, e, pn0, cnt;
    __device__ __forceinline__ bool next(int i, pg8::Unit& u) const { if (rbl < 0 || i >= cnt) return false; u.pm = rbl; u.pa = 0; u.pn = e * 28 + pn0 + i; return true; } };
struct MoeDownOrder { int rbl, e, pn0;
    __device__ __forceinline__ bool next(int i, pg8::Unit& u) const { if (rbl < 0 || i >= 1) return false; u.pm = rbl; u.pa = rbl; u.pn = e * 4 + pn0; return true; } };

__device__ __forceinline__ Frame fresh(const Frame& F) { Frame P = F; int lane_; asm volatile("v_mbcnt_lo_u32_b32 %0, -1, 0\n\tv_mbcnt_hi_u32_b32 %0, -1, %0" : "=v"(lane_) :: "memory"); asm volatile("" : "+s"(P.wave), "+s"(P.bx), "+s"(P.G));
    P.lane = lane_; P.tid = P.wave * 64 + lane_; P.vcu = (P.bx % 8) * (P.G / 8) + P.bx / 8; return P; }
#ifndef WGM_G4
#define WGM_G4 6
#endif
#ifndef WGM_G1
#define WGM_G1 8
#endif
#ifndef REP_P0
#define REP_P0 1
#endif
#ifndef REP_G1
#define REP_G1 1
#endif
#ifndef REP_G2
#define REP_G2 1
#endif
#ifndef REP_AT
#define REP_AT 1
#endif
#ifndef REP_CB
#define REP_CB 1
#endif
#ifndef REP_G4
#define REP_G4 1
#endif
#ifndef REP_N1
#define REP_N1 1
#endif
#ifndef REP_MW
#define REP_MW 1
#endif
#ifndef REP_G6
#define REP_G6 1
#endif
#ifndef REP_G7
#define REP_G7 1
#endif
#ifndef REP_R2
#define REP_R2 1
#endif
struct Args { const float* in[20]; float* out; unsigned char* ws; int ph_lo, ph_hi, li, pad; };
__global__ void __launch_bounds__(NWAVES * 64, 2) fwd(Args args) {
    extern __shared__ __attribute__((aligned(16))) unsigned char lds[];
    Frame F0;
    F0.lds = (LAS unsigned char*)lds;
    F0.MISC = (volatile LAS unsigned*)(F0.lds + MISC_OFF);
    F0.tid = 0; F0.lane = 0; F0.wave = __builtin_amdgcn_readfirstlane((int)threadIdx.x >> 6);
    F0.G = gridDim.x; F0.bx = blockIdx.x; F0.vcu = 0;
    for (int u = threadIdx.x; u < (LDS_BYTES - LDSCTL_OFF) / 4; u += NWAVES * 64) ((LAS unsigned*)(F0.lds + LDSCTL_OFF))[u] = 0u;
    __syncthreads();
#define KA_LO (*(const int CAS*)(kargs() + 176))
#define KA_HI (*(const int CAS*)(kargs() + 180))
#define KA_LI (*(const int CAS*)(kargs() + 184))
#define MK_BAR() XcdBarrier bar; bar.bar = (unsigned*)(gctl() + CW_BAR) + KA_LI * XCD_BAR_WORDS; bar.x = xb_xcc_id(); bar.st = (volatile LAS unsigned*)((LAS unsigned char*)lds + MISC_OFF) + 8
    if (!MK_PER_PHASE) { MK_BAR(); (void)xcd_barrier_post(bar.bar, bar.st); }
    int ph = 0;
#define PH_ON() (ph >= KA_LO && ph < KA_HI)
#define PH_END() do { if (PH_ON() && ph + 1 < KA_HI) { if (MK_PER_PHASE) { if (threadIdx.x == 0) __hip_atomic_store(gctl() + CW_TMO, 0xBADBA0u, RLX_AGENT); } else { MK_BAR(); xcd_barrier(bar); } } ++ph; } while (0)
#define ws gws()
#define R1 ((bf16*)(gws() + WS_R1))
#define QKV ((bf16*)(gws() + WS_QKV))

    if (PH_ON()) for (int rep = 0; rep < REP_P0; ++rep) { Frame F = fresh(F0); p0_prologue(F); }
    PH_END();
#ifndef PROBE_NBAR
#define PROBE_NBAR 0
#endif
    for (int xb_ = 0; xb_ < PROBE_NBAR; ++xb_) { MK_BAR(); xcd_barrier(bar); }
    for (int l = 0; l < 2; ++l) {
        if (PH_ON()) for (int rep = 0; rep < REP_G1; ++rep) { Frame F = fresh(F0); pg8::Gemm g{R1, (const bf16*)(ws + WS_WIN + l * WIN_L), D, D, nullptr}; SkipColOrder So; So.s.init(T, NQKVP - 256, F.G, F.bx, WGM_G1);
            pg8::EpiBf16Q E{QKV, NQKV, NQKV, l == 1 ? (const float*)(ws + WS_SSQ) : nullptr, (float*)(ws + WS_SSQ2)}; pg8::gemm_phase<pg8::EpiBf16Q, SkipColOrder>(F.lds + RING_OFF, g, So, E, F.wave); }
        PH_END();
        if (PH_ON()) for (int rep = 0; rep < REP_G2; ++rep) { Frame F = fresh(F0); const int half = F.G / 2;
            if (rep == 0) mla_prep(F, l);
            { pg8::Gemm g{QKV + C_CKV, (const bf16*)(ws + WS_WUKV + l * WUKV_L), 128, NQKV, nullptr}; pg8::StaticOrder So; So.init(T, 512, F.G, F.bx);
              pg8::EpiBf16K E{(bf16*)(ws + WS_KVM), (unsigned*)gctl() + CW_KMAXC + l * 32, (const float*)(ws + WS_SSQ2)}; pg8::gemm_phase<pg8::EpiBf16K, pg8::StaticOrder>(F.lds + RING_OFF, g, So, E, F.wave); }
            if (F.bx < half) {
              pg8::Gemm g{QKV + C_CQ, (const bf16*)(ws + WS_WUQ + l * WUQ_L), 384, NQKV, nullptr}; pg8::StaticOrder So; So.init(T, 512, half, F.bx);
              pg8::EpiBf16R E{(bf16*)(ws + WS_QM), (const float*)(ws + WS_SSQ2)}; pg8::gemm_phase<pg8::EpiBf16R, pg8::StaticOrder>(F.lds + RING_OFF, g, So, E, F.wave);
            } else {
              pg8::Gemm g{R1, (const bf16*)(ws + WS_WIN + l * WIN_L), D, D, nullptr}; OneTileOrder So; So.pm = F.bx - half < T / 256 ? F.bx - half : -1; So.pn = G1_DEFER;
              pg8::EpiBf16 E{QKV, NQKV, NQKV, 0, 1.0f, l == 1 ? (const float*)(ws + WS_SSQ) : nullptr}; pg8::gemm_phase<pg8::EpiBf16, OneTileOrder>(F.lds + RING_OFF, g, So, E, F.wave); }
        }
        PH_END();
        if (PH_ON()) for (int rep = 0; rep < REP_AT; ++rep) { Frame F = fresh(F0); attn_phase(F, l, rep); }
        PH_END();
        if (PH_ON()) for (int rep = 0; rep < REP_CB; ++rep) { Frame F = fresh(F0); attn_combine(F, l); }
        PH_END();
        if (PH_ON()) { Frame F = fresh(F0); pg8::Gemm g{R1, (const bf16*)(ws + WS_WOUT + l * WOUT_L), D, D, nullptr}; pg8::StaticOrder So; So.init(T, D, F.G, F.bx);
            pg8::EpiResid E{l == 0 ? gin(0) : (const float*)gout(), gout(), D, l == 0 ? (bf16*)(ws + WS_XB) : nullptr, l == 0 ? (float*)(ws + WS_SSQ) : nullptr, 1.0f, (FFN8 == 1 || FFN8 == 2)}; pg8::gemm_phase<pg8::EpiResid, pg8::StaticOrder>(F.lds + RING_OFF, g, So, E, F.wave); }
        PH_END();
        if (l == 1) {
        if (PH_ON()) { Frame F = fresh(F0); norm2_router(F, l, true); for (int rep = 0; rep < REP_MW; ++rep) moe_weights(F);
            __syncthreads(); hist_wait(F); route_assign(F); }
        PH_END();
        }
        if (l == 0) {
            if (PH_ON()) for (int rep = 0; rep < REP_G4; ++rep) { Frame F = fresh(F0); pg8::StaticOrder So; So.init(T, 2 * FF, F.G, F.bx, WGM_G4);
#if FFN8 == 1 || FFN8 == 2
                pg8::Gemm g{(const bf16*)(ws + WS_XB), (const bf16*)(ws + WS_W13), D / 2, D / 2, nullptr};
#if FFN8 == 1
                pg8::EpiSwiglu8 E{(void*)(ws + WS_G), FF, 22, 1.0f / MOE_WSCALE, (const float*)(ws + WS_SSQ)}; pg8::gemm_phase<pg8::EpiSwiglu8, pg8::StaticOrder, false, true>(F.lds + RING_OFF, g, So, E, F.wave); }
#else
                pg8::EpiSwiglu E{(void*)(ws + WS_G), FF, 22, 1.0f / MOE_WSCALE, (const float*)(ws + WS_SSQ)}; pg8::gemm_phase<pg8::EpiSwiglu, pg8::StaticOrder, false, true>(F.lds + RING_OFF, g, So, E, F.wave); }
#endif
#else
                pg8::Gemm g{(const bf16*)(ws + WS_XB), (const bf16*)(ws + WS_W13), D, D, nullptr};
#if FFN8 == 3
                pg8::EpiSwiglu8 E{(void*)(ws + WS_G), FF, 22, 1.0f, (const float*)(ws + WS_SSQ)}; pg8::gemm_phase<pg8::EpiSwiglu8, pg8::StaticOrder>(F.lds + RING_OFF, g, So, E, F.wave); }
#else
                pg8::EpiSwiglu E{(void*)(ws + WS_G), FF, 22, 1.0f, (const float*)(ws + WS_SSQ)}; pg8::gemm_phase<pg8::EpiSwiglu, pg8::StaticOrder>(F.lds + RING_OFF, g, So, E, F.wave); }
#endif
#endif
            PH_END();
            if (PH_ON()) { Frame F = fresh(F0); pg8::StaticOrder So; So.init(T, D, F.G, F.bx);
#if FFN8 == 1 || FFN8 == 3
                pg8::Gemm g{(const bf16*)(ws + WS_G), (const bf16*)(ws + WS_W2), FF / 2, FF / 2, nullptr};
                pg8::EpiResid E{(const float*)gout(), gout(), D, R1, (float*)(ws + WS_SSQ), 1.0f / MOE_WSCALE, false}; pg8::gemm_phase<pg8::EpiResid, pg8::StaticOrder, false, true>(F.lds + RING_OFF, g, So, E, F.wave); }
#else
                pg8::Gemm g{(const bf16*)(ws + WS_G), (const bf16*)(ws + WS_W2), FF, FF, nullptr};
                pg8::EpiResid E{(const float*)gout(), gout(), D, R1, (float*)(ws + WS_SSQ)}; pg8::gemm_phase<pg8::EpiResid, pg8::StaticOrder>(F.lds + RING_OFF, g, So, E, F.wave); }
#endif
            PH_END();
        } else {
            const int* blk = (const int*)(ws + WS_RT + RT_BLK); const int* tokv = (const int*)(ws + WS_RT + RT_TOK);
            for (int p = 0; p < 6; ++p) {
                if (PH_ON()) {
                    if (p >= 1) for (int rep = 0; rep < REP_G7; ++rep) { Frame F = fresh(F0); const int q = p - 1; const int nblk = __builtin_amdgcn_readfirstlane(blk[272]); const int nrem4 = nblk > 256 ? (nblk - 256) * 4 : 0;
                        const bool rem = (q == 4);
                        const int rb = rem ? 256 + (F.bx >> 2) : q * 64 + (F.vcu >> 2); MoeDownOrder So; So.rbl = rb < nblk ? (rem ? (F.bx >> 2) : (F.vcu >> 2)) : -1; So.e = rb < nblk ? __builtin_amdgcn_readfirstlane(blk[rb]) : 0; So.pn0 = rem ? (F.bx & 3) : (F.vcu & 3);
                        if (!rem || F.bx < nrem4) {
                            pg8::Gemm g{(const bf16*)(ws + WS_GM + (size_t)(q & 1) * GM_L), (const bf16*)(ws + WS_MW2), FE / 2, FE / 2, nullptr};
                            pg8::EpiBf16 E{(bf16*)(ws + WS_Y) + (size_t)q * 64 * 256 * D, D, D, 4, 1.0f / MOE_WSCALE}; pg8::gemm_phase<pg8::EpiBf16, MoeDownOrder, false, true>(F.lds + RING_OFF, g, So, E, F.wave); }
                        else final_combine(F, 0, nrem4); }
                    if (p <= 4) for (int rep = 0; rep < REP_G6; ++rep) { Frame F = fresh(F0); const int nblk = __builtin_amdgcn_readfirstlane(blk[272]);
                        const bool rem6 = (p == 4); const int lb = rem6 ? F.vcu / 28 : (F.vcu >> 2);
                        const int rb = p * 64 + lb; MoeUpOrder So; So.rbl = rb < nblk ? lb : -1; So.e = rb < nblk ? __builtin_amdgcn_readfirstlane(blk[rb]) : 0; So.pn0 = rem6 ? F.vcu % 28 : (F.vcu & 3) * 7; So.cnt = rem6 ? 1 : 7;
                        pg8::Gemm g{R1, (const bf16*)(ws + WS_MW13), D / 2, D / 2, tokv + (rb < nblk ? rb : 0) * 256};
                        pg8::EpiSwiglu8 E{(void*)(ws + WS_GM + (size_t)(p & 1) * GM_L), FE, 28, 1.0f / MOE_WSCALE}; pg8::gemm_phase<pg8::EpiSwiglu8, MoeUpOrder, true, true>(F.lds + RING_OFF, g, So, E, F.wave); }
                }
                PH_END();
            }
            if (PH_ON()) { Frame F = fresh(F0); final_combine(F, 1, 0); }
            PH_END();
        }
    }
#undef PH_ON
#undef PH_END
#undef ws
#undef R1
#undef QKV
}
static_assert(sizeof(Args) == 192 && offsetof(Args, out) == 160 && offsetof(Args, ws) == 168 && offsetof(Args, ph_lo) == 176 && offsetof(Args, ph_hi) == 180 && offsetof(Args, li) == 184, "kernarg offsets");
constexpr int N_PHASES = 1 + (5 + 2) + (5 + 1 + 6 + 1);

extern "C" void kernel_launch(void* const* d_in, const int* in_sizes, int n_in, void* d_out, int out_size, void* d_ws, size_t ws_size, hipStream_t stream) {
    static int grid = 0;
    if (grid == 0) {
        if (n_in != 20 || in_sizes[0] != T * D || out_size != T * D || ws_size < WS_END) { fprintf(stderr, "kernel_launch: unexpected shapes (n_in %d, in0 %d, out %d, ws %zu < %zu); nothing launched\n", n_in, n_in > 0 ? in_sizes[0] : -1, out_size, ws_size, (size_t)WS_END); grid = -1; return; }
        int dev = 0, cus = 0, per_cu = 0;
        if (hipGetDevice(&dev) != hipSuccess || hipDeviceGetAttribute(&cus, hipDeviceAttributeMultiprocessorCount, dev) != hipSuccess) { grid = -1; return; }
        if (hipFuncSetAttribute((const void*)fwd, hipFuncAttributeMaxDynamicSharedMemorySize, LDS_BYTES) != hipSuccess) { fprintf(stderr, "kernel_launch: hipFuncSetAttribute failed\n"); grid = -1; return; }
        if (hipOccupancyMaxActiveBlocksPerMultiprocessor(&per_cu, (const void*)fwd, NWAVES * 64, LDS_BYTES) != hipSuccess || per_cu < 1) { fprintf(stderr, "kernel_launch: occupancy query reports %d workgroups per CU\n", per_cu); }
        (void)hipGetLastError();
        if (cus < 256) { fprintf(stderr, "kernel_launch: %d CUs < 256: the 256-workgroup grid would not be resident; nothing launched\n", cus); grid = -1; return; }
        grid = 256;
    }
    if (grid < 0) return;
    if (hipMemsetAsync((char*)d_ws + WS_CTL, 0, CTL_ZERO_BYTES, stream) != hipSuccess) return;
    Args a{};
    for (int i = 0; i < 20; ++i) a.in[i] = (const float*)d_in[i];
    a.out = (float*)d_out; a.ws = (unsigned char*)d_ws; a.pad = 0;
#if MK_PER_PHASE
    for (int li = 0; li < N_PHASES; ++li) { a.ph_lo = li; a.ph_hi = li + 1; a.li = 0; hipLaunchKernelGGL(fwd, dim3(grid), dim3(NWAVES * 64), LDS_BYTES, stream, a); }
#else
#ifndef DBG_PH_HI
#define DBG_PH_HI N_PHASES
#endif
    a.ph_lo = 0; a.ph_hi = DBG_PH_HI; a.li = 0;
    hipLaunchKernelGGL(fwd, dim3(grid), dim3(NWAVES * 64), LDS_BYTES, stream, a);
#endif
    const hipError_t le = hipPeekAtLastError();
    if (le != hipSuccess) fprintf(stderr, "kernel_launch: launch failed: %s\n", hipGetErrorName(le));
}
```

```cpp
#include <hip/hip_runtime.h>
#include <hip/hip_bf16.h>
#include <cstdio>
#include <cstdint>
#include <cstddef>
#include <cmath>

namespace pg8 {
#define PG8_LAS __attribute__((address_space(3)))
typedef unsigned short bf16_t;
typedef short bf16x8 __attribute__((ext_vector_type(8)));
typedef float f32x4 __attribute__((ext_vector_type(4)));
typedef float f32x2 __attribute__((ext_vector_type(2)));
typedef unsigned u32x4 __attribute__((ext_vector_type(4)));
constexpr int BM = 256, BK = 64, HALF = 128, HTB = HALF * BK * 2  , STAGE_BYTES = 8 * HTB, NXCD = 8, WGM = 8;

__host__ __device__ __forceinline__ int lds_byte(int r, int c) { const int st = (r >> 4) * 2 + (c >> 5), rr = r & 15, cc = c & 31, ob = rr * 64 + cc * 2; return st * 1024 + (ob ^ (((ob >> 9) & 1) << 5)); }
__host__ __device__ __forceinline__ void stage_rc(int b, int& R, int& C) { const int st = b / 1024, sb = b % 1024, swz = sb ^ (((sb >> 9) & 1) << 5); R = (st >> 1) * 16 + swz / 64; C = (st & 1) * 32 + (swz % 64) / 2; }
__host__ __device__ __forceinline__ int perm32(int rho) { const int n = rho >> 4, i = rho & 15; return 8 * (i >> 2) + 4 * n + (i & 3); }

struct Unit { int pm, pn, pa; };
struct Gemm { const bf16_t* A; const bf16_t* Bt; int K, lda; const int* gidx; };

struct StaticOrder {
    int nM, nN, nwg, G, c, wgm;
    __host__ __device__ void init(int M, int N, int G_, int c_, int wgm_ = WGM) { nM = M / BM; nN = N / BM; nwg = nM * nN; G = G_; c = c_; wgm = wgm_; }
    __host__ __device__ bool next(int i, Unit& u) const {
        const long L = (long)i * G + c; if (L >= nwg) return false;
        int wgid = (int)L; { const int q = nwg / NXCD, r = nwg % NXCD, xcd = wgid % NXCD, off = wgid / NXCD; wgid = (xcd < r ? xcd * (q + 1) : r * (q + 1) + (xcd - r) * q) + off; }
        const int nig = wgm * nN, gid = wgid / nig, fm = gid * wgm, gsz = (nM - fm) < wgm ? (nM - fm) : wgm;
        u.pm = fm + ((wgid % nig) % gsz); u.pn = (wgid % nig) / gsz; u.pa = u.pm; return true;
    }
};

__device__ __forceinline__ unsigned cvt_pk_bf16(float lo, float hi) { unsigned r; asm volatile("v_cvt_pk_bf16_f32 %0, %1, %2" : "=v"(r) : "v"(lo), "v"(hi)); return r; }

__device__ __forceinline__ float rms_scale16(const float* ssq, int row) { const f32x4* p = (const f32x4*)(ssq + (size_t)row * 16); const f32x4 a = p[0], b = p[1], c = p[2], d = p[3];
    const float s = ((a[0] + a[1]) + (a[2] + a[3])) + ((b[0] + b[1]) + (b[2] + b[3])) + ((c[0] + c[1]) + (c[2] + c[3])) + ((d[0] + d[1]) + (d[2] + d[3])); return 1.0f / sqrtf(s * (1.0f / 1024.0f) + 1e-6f); }
struct RowScale { float r0, r1;
    __device__ __forceinline__ void init(const float* ssq, int unit_row0, int wr, int lane) { r0 = rms_scale16(ssq, unit_row0 + wr * 64 + lane); r1 = rms_scale16(ssq, unit_row0 + HALF + wr * 64 + lane); }
    __device__ __forceinline__ float get(int ai, int m, int fr) const { return __int_as_float(__builtin_amdgcn_ds_bpermute((m * 16 + fr) << 2, __float_as_int(ai ? r1 : r0))); } };
template <int OFF, int CNT> __device__ __forceinline__ float rms_part(const float* ssq, int row) { const float* p = ssq + (size_t)row * 16 + OFF; float s = 0.f;
#pragma unroll
    for (int i = 0; i < CNT; i += 4) { const f32x4 a = *(const f32x4*)(p + i); s += (a[0] + a[1]) + (a[2] + a[3]); }
    return 1.0f / sqrtf(s * (1.0f / (32.0f * CNT)) + 1e-6f); }
template <int OFF, int CNT> struct RowScaleP { float r0, r1;
    __device__ __forceinline__ void init(const float* ssq, int unit_row0, int wr, int lane) { r0 = rms_part<OFF, CNT>(ssq, unit_row0 + wr * 64 + lane); r1 = rms_part<OFF, CNT>(ssq, unit_row0 + HALF + wr * 64 + lane); }
    __device__ __forceinline__ float get(int ai, int m, int fr) const { return __int_as_float(__builtin_amdgcn_ds_bpermute((m * 16 + fr) << 2, __float_as_int(ai ? r1 : r0))); } };
struct EpiBf16Q {
    static constexpr bool PERM = true;
    bf16_t* O; int ldc; int ncols; const float* ssq; float* ssq2;
    __device__ __forceinline__ void operator()(const f32x4 (&acc)[2][2][4][2], const Unit& u, int wr, int wc, int fr, int fq) const {
        const int row0 = u.pm * BM + wr * 64 + fr; const int col0 = u.pn * BM + wc * 32 + 8 * fq; const int ln = fq * 16 + fr;
        const bool lat = (u.pn == 8 || u.pn == 9);
        RowScale R; if (ssq) R.init(ssq, u.pm * BM, wr, fq * 16 + fr);
#pragma unroll
        for (int ai = 0; ai < 2; ++ai)
#pragma unroll
            for (int m = 0; m < 4; ++m) { const int row = row0 + ai * HALF + m * 16; bf16_t* rowp = O + (size_t)row * ldc + col0; const float rs = ssq ? R.get(ai, m, fr) : 1.0f;
#pragma unroll
                for (int bj = 0; bj < 2; ++bj) { const f32x4 v0 = acc[ai][bj][m][0] * rs, v1 = acc[ai][bj][m][1] * rs;
                    u32x4 w; w.x = cvt_pk_bf16(v0[0], v0[1]); w.y = cvt_pk_bf16(v0[2], v0[3]); w.z = cvt_pk_bf16(v1[0], v1[1]); w.w = cvt_pk_bf16(v1[2], v1[3]);
                    if (col0 + bj * HALF < ncols) *(u32x4*)(rowp + bj * HALF) = w;
                    if (lat) { float ss = ((v0[0] * v0[0] + v0[1] * v0[1]) + (v0[2] * v0[2] + v0[3] * v0[3])) + ((v1[0] * v1[0] + v1[1] * v1[1]) + (v1[2] * v1[2] + v1[3] * v1[3]));
                        ss += __int_as_float(__builtin_amdgcn_ds_bpermute((ln ^ 16) << 2, __float_as_int(ss))); ss += __int_as_float(__builtin_amdgcn_ds_bpermute((ln ^ 32) << 2, __float_as_int(ss)));
                        if (fq == 0) ssq2[(size_t)row * 16 + (u.pn - 8) * 8 + bj * 4 + wc] = ss; } } }
    }
};
struct EpiBf16R {
    static constexpr bool PERM = true;
    bf16_t* O; const float* ssq2;
    __device__ __forceinline__ void operator()(const f32x4 (&acc)[2][2][4][2], const Unit& u, int wr, int wc, int fr, int fq) const {
        const int row0 = u.pm * BM + wr * 64 + fr; const int col0 = u.pn * BM + wc * 32 + 8 * fq;
        RowScaleP<0, 12> R; R.init(ssq2, u.pm * BM, wr, fq * 16 + fr);
#pragma unroll
        for (int ai = 0; ai < 2; ++ai)
#pragma unroll
            for (int m = 0; m < 4; ++m) { const int row = row0 + ai * HALF + m * 16; bf16_t* rowp = O + (size_t)row * 384 + col0; const float rs = R.get(ai, m, fr);
#pragma unroll
                for (int bj = 0; bj < 2; ++bj) { const f32x4 v0 = acc[ai][bj][m][0] * rs, v1 = acc[ai][bj][m][1] * rs;
                    u32x4 w; w.x = cvt_pk_bf16(v0[0], v0[1]); w.y = cvt_pk_bf16(v0[2], v0[3]); w.z = cvt_pk_bf16(v1[0], v1[1]); w.w = cvt_pk_bf16(v1[2], v1[3]);
                    if (col0 + bj * HALF < 384) *(u32x4*)(rowp + bj * HALF) = w; } }
    }
};
struct EpiBf16 {
    static constexpr bool PERM = true;
    bf16_t* O; int ldc; int ncols; int nt; float sc = 1.0f; const float* ssq = nullptr;
    __device__ __forceinline__ void operator()(const f32x4 (&acc)[2][2][4][2], const Unit& u, int wr, int wc, int fr, int fq) const {
        const int row0 = u.pm * BM + wr * 64 + fr; const int col0 = (nt ? u.pn % nt : u.pn) * BM + wc * 32 + 8 * fq;
        RowScale R; if (ssq) R.init(ssq, u.pm * BM, wr, fq * 16 + fr);
#pragma unroll
        for (int ai = 0; ai < 2; ++ai)
#pragma unroll
            for (int m = 0; m < 4; ++m) { const int row = row0 + ai * HALF + m * 16; bf16_t* rowp = O + (size_t)row * ldc + col0; const float rs = ssq ? sc * R.get(ai, m, fr) : sc;
#pragma unroll
                for (int bj = 0; bj < 2; ++bj) { const f32x4 v0 = acc[ai][bj][m][0] * rs, v1 = acc[ai][bj][m][1] * rs;
                    u32x4 w; w.x = cvt_pk_bf16(v0[0], v0[1]); w.y = cvt_pk_bf16(v0[2], v0[3]); w.z = cvt_pk_bf16(v1[0], v1[1]); w.w = cvt_pk_bf16(v1[2], v1[3]);
                    if (col0 + bj * HALF < ncols) *(u32x4*)(rowp + bj * HALF) = w; } }
    }
};
struct EpiBf16K {
    static constexpr bool PERM = true;
    bf16_t* O; unsigned* kmax; const float* ssq2;
    __device__ __forceinline__ void operator()(const f32x4 (&acc)[2][2][4][2], const Unit& u, int wr, int wc, int fr, int fq) const {
        const int row0 = u.pm * BM + wr * 64 + fr; const int col0 = u.pn * BM + wc * 32 + 8 * fq; const int ln = fq * 16 + fr;
        float mx0 = 0.f, mx1 = 0.f;
        RowScaleP<12, 4> R; R.init(ssq2, u.pm * BM, wr, ln);
#pragma unroll
        for (int ai = 0; ai < 2; ++ai)
#pragma unroll
            for (int m = 0; m < 4; ++m) { const int row = row0 + ai * HALF + m * 16; bf16_t* rowp = O + (size_t)row * 512 + col0; const float rs = R.get(ai, m, fr);
#pragma unroll
                for (int bj = 0; bj < 2; ++bj) { const f32x4 v0 = acc[ai][bj][m][0] * rs, v1 = acc[ai][bj][m][1] * rs;
                    u32x4 w; w.x = cvt_pk_bf16(v0[0], v0[1]); w.y = cvt_pk_bf16(v0[2], v0[3]); w.z = cvt_pk_bf16(v1[0], v1[1]); w.w = cvt_pk_bf16(v1[2], v1[3]);
                    *(u32x4*)(rowp + bj * HALF) = w;
                    if (wc < 2) { float ss = ((v0[0] * v0[0] + v0[1] * v0[1]) + (v0[2] * v0[2] + v0[3] * v0[3])) + ((v1[0] * v1[0] + v1[1] * v1[1]) + (v1[2] * v1[2] + v1[3] * v1[3]));
                        ss += __int_as_float(__builtin_amdgcn_ds_bpermute((ln ^ 16) << 2, __float_as_int(ss))); ss += __int_as_float(__builtin_amdgcn_ds_bpermute((ln ^ 32) << 2, __float_as_int(ss)));
                        if (bj == 0) mx0 = __builtin_fmaxf(mx0, ss); else mx1 = __builtin_fmaxf(mx1, ss); } } }
        if (wc < 2) {
#pragma unroll
            for (int o_ = 1; o_ < 16; o_ <<= 1) { mx0 = __builtin_fmaxf(mx0, __int_as_float(__builtin_amdgcn_ds_bpermute((ln ^ o_) << 2, __float_as_int(mx0)))); mx1 = __builtin_fmaxf(mx1, __int_as_float(__builtin_amdgcn_ds_bpermute((ln ^ o_) << 2, __float_as_int(mx1)))); }
            if (ln == 0) { unsigned* kp = kmax + (((u.pm * BM) >> 13) * 4 + 2 * u.pn) * 2 + wc;
                __hip_atomic_fetch_max(kp, __float_as_uint(mx0), __ATOMIC_RELAXED, __HIP_MEMORY_SCOPE_AGENT); __hip_atomic_fetch_max(kp + 2, __float_as_uint(mx1), __ATOMIC_RELAXED, __HIP_MEMORY_SCOPE_AGENT); } }
    }
};
struct EpiRope {
    static constexpr bool PERM = true;
    bf16_t* O; const f32x2* rope;
    __device__ __forceinline__ void operator()(const f32x4 (&acc)[2][2][4][2], const Unit& u, int wr, int wc, int fr, int fq) const {
        const int row0 = u.pm * BM + wr * 64 + fr; const int col0 = u.pn * BM + wc * 32 + 8 * fq;
#pragma unroll
        for (int bj = 0; bj < 2; ++bj) { const int col = col0 + bj * HALF; if (col >= 384) continue;
            const int dd = col % 96; const bool rp = dd >= 64; const int j0 = rp ? ((dd - 64) >> 1) : 0;
            const f32x2* rt0 = rope + (size_t)(row0 & 8191) * 16 + j0; bf16_t* op0 = O + (size_t)row0 * 384 + col;
#pragma unroll
            for (int ai = 0; ai < 2; ++ai)
#pragma unroll
                for (int m = 0; m < 4; ++m) { const int dr = ai * HALF + m * 16; f32x4 v0 = acc[ai][bj][m][0], v1 = acc[ai][bj][m][1];
                    { const f32x2* rt = rt0 + dr * 16; f32x2 c0 = rt[0], c1 = rt[1], c2 = rt[2], c3 = rt[3];
                        if (!rp) { c0 = (f32x2){1.f, 0.f}; c1 = c0; c2 = c0; c3 = c0; }
                        f32x4 a, b; a[0] = v0[0] * c0.x - v0[1] * c0.y; a[1] = v0[1] * c0.x + v0[0] * c0.y; a[2] = v0[2] * c1.x - v0[3] * c1.y; a[3] = v0[3] * c1.x + v0[2] * c1.y;
                        b[0] = v1[0] * c2.x - v1[1] * c2.y; b[1] = v1[1] * c2.x + v1[0] * c2.y; b[2] = v1[2] * c3.x - v1[3] * c3.y; b[3] = v1[3] * c3.x + v1[2] * c3.y; v0 = a; v1 = b; }
                    u32x4 w; w.x = cvt_pk_bf16(v0[0], v0[1]); w.y = cvt_pk_bf16(v0[2], v0[3]); w.z = cvt_pk_bf16(v1[0], v1[1]); w.w = cvt_pk_bf16(v1[2], v1[3]);
                    *(u32x4*)(op0 + (size_t)dr * 384) = w; asm volatile("" ::: "memory"); } }
    }
};
struct EpiResid {
    static constexpr bool PERM = true;
    const float* base; float* out; int ldc; bf16_t* xb = nullptr; float* ssq = nullptr; float sc = 1.0f; bool xb8 = false;
    __device__ __forceinline__ void operator()(const f32x4 (&acc)[2][2][4][2], const Unit& u, int wr, int wc, int fr, int fq) const {
        const int row0 = u.pm * BM + wr * 64 + fr; const int col0 = u.pn * BM + wc * 32 + 8 * fq;
#pragma unroll
        for (int ai = 0; ai < 2; ++ai)
#pragma unroll
            for (int mp = 0; mp < 4; mp += 2) {
                f32x4 bb[2][2][2];
#pragma unroll
                for (int mi = 0; mi < 2; ++mi) { const size_t off = (size_t)(row0 + ai * HALF + (mp + mi) * 16) * ldc + col0;
                    bb[mi][0][0] = *(const f32x4*)(base + off); bb[mi][0][1] = *(const f32x4*)(base + off + 4); bb[mi][1][0] = *(const f32x4*)(base + off + HALF); bb[mi][1][1] = *(const f32x4*)(base + off + HALF + 4); }
#pragma unroll
                for (int mi = 0; mi < 2; ++mi) { const int m = mp + mi; const int row = row0 + ai * HALF + m * 16; const size_t off = (size_t)row * ldc + col0; float ss = 0.f;
#pragma unroll
                    for (int bj = 0; bj < 2; ++bj) { const f32x4 b0 = bb[mi][bj][0], b1 = bb[mi][bj][1];
                        const f32x4 x0 = b0 + acc[ai][bj][m][0] * sc, x1 = b1 + acc[ai][bj][m][1] * sc;
                        *(f32x4*)(out + off + bj * HALF) = x0; *(f32x4*)(out + off + bj * HALF + 4) = x1;
                        if (xb) { if (xb8) { int w0 = __builtin_amdgcn_cvt_pk_fp8_f32(x0[0], x0[1], 0, false); w0 = __builtin_amdgcn_cvt_pk_fp8_f32(x0[2], x0[3], w0, true);
                                int w1 = __builtin_amdgcn_cvt_pk_fp8_f32(x1[0], x1[1], 0, false); w1 = __builtin_amdgcn_cvt_pk_fp8_f32(x1[2], x1[3], w1, true);
                                typedef int i32x2 __attribute__((ext_vector_type(2))); *(i32x2*)((char*)xb + off + bj * HALF) = (i32x2){w0, w1}; }
                            else { u32x4 w; w.x = cvt_pk_bf16(x0[0], x0[1]); w.y = cvt_pk_bf16(x0[2], x0[3]); w.z = cvt_pk_bf16(x1[0], x1[1]); w.w = cvt_pk_bf16(x1[2], x1[3]); *(u32x4*)(xb + off + bj * HALF) = w; }
                            ss += ((x0[0] * x0[0] + x0[1] * x0[1]) + (x0[2] * x0[2] + x0[3] * x0[3])) + ((x1[0] * x1[0] + x1[1] * x1[1]) + (x1[2] * x1[2] + x1[3] * x1[3])); } }
                    if (xb) { const int ln = fq * 16 + fr;
                        ss += __int_as_float(__builtin_amdgcn_ds_bpermute((ln ^ 16) << 2, __float_as_int(ss))); ss += __int_as_float(__builtin_amdgcn_ds_bpermute((ln ^ 32) << 2, __float_as_int(ss)));
                        if (fq == 0) ssq[(size_t)row * 16 + u.pn * 4 + wc] = ss; } }
                asm volatile("" ::: "memory"); }
    }
};
template <bool F8OUT> struct EpiSwigluT {
    static constexpr bool PERM = true;
    void* G; int ldc; int ntile; float sc; const float* ssq = nullptr;
    __device__ __forceinline__ void operator()(const f32x4 (&acc)[2][2][4][2], const Unit& u, int wr, int wc, int fr, int fq) const {
        const int row0 = u.pm * BM + wr * 64 + fr; const int col0 = (u.pn % ntile) * HALF + wc * 32 + 8 * fq;
        RowScale R; if (ssq) R.init(ssq, u.pm * BM, wr, fq * 16 + fr);
#pragma unroll
        for (int ai = 0; ai < 2; ++ai)
#pragma unroll
            for (int m = 0; m < 4; ++m) { float g[8]; const float rs = ssq ? sc * R.get(ai, m, fr) : sc;
#pragma unroll
                for (int n = 0; n < 2; ++n)
#pragma unroll
                    for (int e = 0; e < 4; ++e) { const float a = acc[ai][0][m][n][e] * rs, b = acc[ai][1][m][n][e] * rs;
                        const float s = __builtin_amdgcn_rcpf(1.0f + __builtin_amdgcn_exp2f(-1.4426950408889634f * a)); g[n * 4 + e] = a * s * b; }
                if constexpr (F8OUT) { int w0 = __builtin_amdgcn_cvt_pk_fp8_f32(g[0], g[1], 0, false); w0 = __builtin_amdgcn_cvt_pk_fp8_f32(g[2], g[3], w0, true);
                    int w1 = __builtin_amdgcn_cvt_pk_fp8_f32(g[4], g[5], 0, false); w1 = __builtin_amdgcn_cvt_pk_fp8_f32(g[6], g[7], w1, true);
                    typedef int i32x2 __attribute__((ext_vector_type(2)));
                    *(i32x2*)((char*)G + (size_t)(row0 + ai * HALF + m * 16) * ldc + col0) = (i32x2){w0, w1}; }
                else { u32x4 w; w.x = cvt_pk_bf16(g[0], g[1]); w.y = cvt_pk_bf16(g[2], g[3]); w.z = cvt_pk_bf16(g[4], g[5]); w.w = cvt_pk_bf16(g[6], g[7]);
                    *(u32x4*)((bf16_t*)G + (size_t)(row0 + ai * HALF + m * 16) * ldc + col0) = w; } }
    }
};
typedef EpiSwigluT<false> EpiSwiglu;
typedef EpiSwigluT<true> EpiSwiglu8;

__device__ __forceinline__ void glds_s(unsigned voff, const char* sbase, unsigned lds_dst) { unsigned keep;
    asm volatile("s_mov_b32 %0, m0\n\ts_mov_b32 m0, %3\n\ts_nop 0\n\tglobal_load_lds_dwordx4 %1, %2\n\ts_mov_b32 m0, %0" : "=&s"(keep) : "v"(voff), "s"(sbase), "s"(lds_dst) : "memory"); }
template <class Epi, class Sched, bool GATHER = false, bool FP8 = false>
__device__ __forceinline__ void gemm_phase(PG8_LAS unsigned char* lds, const Gemm g, const Sched& S, const Epi& E, const int wave_id) {
    int lane_; asm volatile("v_mbcnt_lo_u32_b32 %0, -1, 0\n\tv_mbcnt_hi_u32_b32 %0, -1, %0" : "=v"(lane_));
    const int wid = wave_id, lane = lane_, tid = wid * 64 + lane, wr = wid >> 2, wc = wid & 3, fr = lane & 15, fq = lane >> 4;
    const int K = g.K, nt = K / BK;
    Unit cur, nxt; int ui = 0;
    if (!S.next(0, cur)) return;
    unsigned offA[2][2], voffB[2];
#pragma unroll
    for (int i = 0; i < 2; ++i) { int R, C; stage_rc(tid * 16 + i * 8192, R, C); const int Rb = Epi::PERM ? ((R & ~31) + perm32(R & 31)) : R;
        voffB[i] = (unsigned)(Rb * K + C) * 2u;
#pragma unroll
        for (int h = 0; h < 2; ++h) {
            if constexpr (GATHER) { const int tok = g.gidx[h * HALF + R]; offA[h][i] = (unsigned)tok * (unsigned)(g.lda * 2) + (unsigned)C * 2u; }
            else offA[h][i] = (unsigned)((h * HALF + R) * g.lda + C) * 2u; } }
    if constexpr (GATHER) asm volatile("s_waitcnt vmcnt(0)" ::: "memory");
    const size_t kstep = (size_t)(BK * 2);
    const size_t hstep = (size_t)HALF * K * 2;
    const size_t tstepB = 2 * hstep, tstepA = (size_t)BM * g.lda * 2;
    const unsigned ldsw = (unsigned)wid * 1024u; const unsigned lds0 = (unsigned)(uintptr_t)lds;
    int scl1 = 0x7f7f7f7f; asm volatile("" : "+v"(scl1));
    const int aoff = lds_byte(wr * 64 + fr, fq * 8), boff = lds_byte(wc * 32 + fr, fq * 8);
#define PG8_SA(b, h) (((b) * 2 + (h)) * HTB)
#define PG8_SB(b, h) ((4 + (b) * 2 + (h)) * HTB)
#define PG8_STAGE(bufoff, gbase, voff) do { _Pragma("unroll") for (int _i = 0; _i < 2; ++_i) \
        glds_s((voff)[_i], (const char*)(gbase), lds0 + (unsigned)(bufoff) + ldsw + _i * 8192u); } while (0)
#define PG8_LDA(dst, b, h) do { if constexpr (FP8) { _Pragma("unroll") for (int m = 0; m < 4; ++m) { const i32x4 lo_ = *(const PG8_LAS i32x4*)(lds + PG8_SA(b, h) + aoff + m * 2048), hi_ = *(const PG8_LAS i32x4*)(lds + PG8_SA(b, h) + aoff + m * 2048 + 1024); \
        dst##8[m] = (i32x8){lo_[0], lo_[1], lo_[2], lo_[3], hi_[0], hi_[1], hi_[2], hi_[3]}; } } \
    else { _Pragma("unroll") for (int m = 0; m < 4; ++m) _Pragma("unroll") for (int k = 0; k < 2; ++k) dst[m][k] = *(const PG8_LAS bf16x8*)(lds + PG8_SA(b, h) + aoff + m * 2048 + k * 1024); } } while (0)
#define PG8_LDB(dst, b, h) do { if constexpr (FP8) { _Pragma("unroll") for (int n = 0; n < 2; ++n) { const i32x4 lo_ = *(const PG8_LAS i32x4*)(lds + PG8_SB(b, h) + boff + n * 2048), hi_ = *(const PG8_LAS i32x4*)(lds + PG8_SB(b, h) + boff + n * 2048 + 1024); \
        dst##8[n] = (i32x8){lo_[0], lo_[1], lo_[2], lo_[3], hi_[0], hi_[1], hi_[2], hi_[3]}; } } \
    else { _Pragma("unroll") for (int n = 0; n < 2; ++n) _Pragma("unroll") for (int k = 0; k < 2; ++k) dst[n][k] = *(const PG8_LAS bf16x8*)(lds + PG8_SB(b, h) + boff + n * 2048 + k * 1024); } } while (0)
#define PG8_MMA(ai, bj, At, Bt) do { __builtin_amdgcn_s_setprio(1); _Pragma("unroll") for (int m = 0; m < 4; ++m) _Pragma("unroll") for (int n = 0; n < 2; ++n) { \
        if constexpr (FP8) asm volatile("v_mfma_scale_f32_16x16x128_f8f6f4 %0, %1, %2, %0, %3, %3 op_sel_hi:[0,0,0]" : "+v"(acc[ai][bj][m][n]) : "v"(Bt##8[n]), "v"(At##8[m]), "v"(scl1));   \
        else { _Pragma("unroll") for (int k = 0; k < 2; ++k) acc[ai][bj][m][n] = __builtin_amdgcn_mfma_f32_16x16x32_bf16(Bt[n][k], At[m][k], acc[ai][bj][m][n], 0, 0, 0); } } \
        __builtin_amdgcn_s_setprio(0); } while (0)
#define PG8_WAIT_V(n) asm volatile("s_waitcnt vmcnt(" #n ")" ::: "memory")
#define PG8_WAIT_L(n) asm volatile("s_waitcnt lgkmcnt(" #n ")" ::: "memory")
#define PG8_BAR __builtin_amdgcn_s_barrier()
#define PG8_SCHED __builtin_amdgcn_sched_barrier(0)
    f32x4 acc[2][2][4][2];
#pragma unroll
    for (int a = 0; a < 2; ++a)
#pragma unroll
        for (int b = 0; b < 2; ++b)
#pragma unroll
            for (int m = 0; m < 4; ++m)
#pragma unroll
                for (int n = 0; n < 2; ++n) acc[a][b][m][n] = (f32x4){0.f, 0.f, 0.f, 0.f};
    typedef int i32x8 __attribute__((ext_vector_type(8))); typedef int i32x4 __attribute__((ext_vector_type(4)));
    const char* cA = (const char*)g.A + (size_t)cur.pa * tstepA; const char* cB = (const char*)g.Bt + (size_t)cur.pn * tstepB;
    PG8_STAGE(PG8_SB(0, 0), cB, voffB); PG8_STAGE(PG8_SB(0, 1), cB + hstep, voffB); PG8_STAGE(PG8_SA(0, 0), cA, offA[0]); PG8_STAGE(PG8_SA(0, 1), cA, offA[1]);
    if (wr == 1) PG8_BAR;
    PG8_WAIT_V(2); PG8_BAR;
    PG8_STAGE(PG8_SB(1, 0), cB + kstep, voffB); PG8_STAGE(PG8_SA(1, 0), cA + kstep, offA[0]); PG8_STAGE(PG8_SB(1, 1), cB + hstep + kstep, voffB);
    PG8_WAIT_V(6); PG8_BAR;
    for (;;) {
        const bool has_next = S.next(ui + 1, nxt);
        const char* nA = has_next ? (const char*)g.A + (size_t)nxt.pa * tstepA : cA; const char* nB = has_next ? (const char*)g.Bt + (size_t)nxt.pn * tstepB : cB;
#pragma unroll 1
        for (int t = 0; t < nt; t += 2) {
            const bool last = (t == nt - 2);
            bf16x8 At[4][2], B0[2][2], B1[2][2]; i32x8 At8[4], B08[2], B18[2];
            const char* a1 = cA + (size_t)(t + 1) * kstep;
            const char* a2 = last ? nA : cA + (size_t)(t + 2) * kstep; const char* b2 = last ? nB : cB + (size_t)(t + 2) * kstep;
            const char* a3 = a2 + kstep; const char* b3 = b2 + kstep;
            PG8_LDB(B0, 0, 0); PG8_LDB(B1, 0, 1); PG8_SCHED; PG8_LDA(At, 0, 0); PG8_STAGE(PG8_SA(1, 1), a1, offA[1]);
            PG8_WAIT_V(8); PG8_WAIT_L(0); PG8_BAR; PG8_MMA(0, 0, At, B0); PG8_MMA(0, 1, At, B1); PG8_BAR; PG8_SCHED;
            PG8_LDA(At, 0, 1); PG8_STAGE(PG8_SB(0, 0), b2, voffB); PG8_STAGE(PG8_SB(0, 1), b2 + hstep, voffB); PG8_STAGE(PG8_SA(0, 0), a2, offA[0]);
            PG8_WAIT_V(8); PG8_WAIT_L(0); PG8_BAR; PG8_MMA(1, 0, At, B0); PG8_MMA(1, 1, At, B1); PG8_BAR; PG8_SCHED;
            PG8_LDB(B0, 1, 0); PG8_LDB(B1, 1, 1); PG8_SCHED; PG8_LDA(At, 1, 0); PG8_STAGE(PG8_SA(0, 1), a2, offA[1]);
            PG8_WAIT_V(8); PG8_WAIT_L(0); PG8_BAR; PG8_MMA(0, 0, At, B0); PG8_MMA(0, 1, At, B1); PG8_BAR; PG8_SCHED;
            PG8_LDA(At, 1, 1); PG8_STAGE(PG8_SB(1, 0), b3, voffB); PG8_STAGE(PG8_SB(1, 1), b3 + hstep, voffB); PG8_STAGE(PG8_SA(1, 0), a3, offA[0]);
            PG8_WAIT_V(8); PG8_WAIT_L(0); PG8_BAR; PG8_MMA(1, 0, At, B0); PG8_MMA(1, 1, At, B1); PG8_BAR; PG8_SCHED;
        }
        if (wr == 0) PG8_BAR;
        if constexpr (FP8) asm volatile("s_nop 15\n\ts_nop 15\n\ts_nop 15\n\ts_nop 15" ::: "memory");
        { int l2_; asm volatile("v_mbcnt_lo_u32_b32 %0, -1, 0\n\tv_mbcnt_hi_u32_b32 %0, -1, %0" : "=v"(l2_)); E(acc, cur, wr, wc, l2_ & 15, l2_ >> 4); }
        if (!has_next) break;
#pragma unroll
        for (int a = 0; a < 2; ++a)
#pragma unroll
            for (int b = 0; b < 2; ++b)
#pragma unroll
                for (int m = 0; m < 4; ++m)
#pragma unroll
                    for (int n = 0; n < 2; ++n) acc[a][b][m][n] = (f32x4){0.f, 0.f, 0.f, 0.f};
        cur = nxt; cA = nA; cB = nB; ++ui;
        if (wr == 1) PG8_BAR;
    }
    PG8_WAIT_V(0);
    PG8_BAR;
#undef PG8_SA
#undef PG8_SB
#undef PG8_STAGE
#undef PG8_LDA
#undef PG8_LDB
#undef PG8_MMA
#undef PG8_WAIT_V
#undef PG8_WAIT_L
#undef PG8_BAR
#undef PG8_SCHED
}
}
namespace att {
using bf16_t = unsigned short;
using bf16x8 = __attribute__((ext_vector_type(8))) short;
using s16x4 = __attribute__((ext_vector_type(4))) short;
using f32x16 = __attribute__((ext_vector_type(16))) float;
using u32x4 = __attribute__((ext_vector_type(4))) unsigned;
typedef short v4i16_t __attribute__((ext_vector_type(4)));
typedef __attribute__((address_space(3))) const char* lds_cptr;
typedef float f32x2_t __attribute__((ext_vector_type(2))); typedef __bf16 bf16x2_t __attribute__((ext_vector_type(2)));
constexpr int NW = 8, QBLK = 32, QB = 256, KVBLK = 64;
constexpr int NSLOT = 3, KSLOT = 12288, VSLOT = 8192;
constexpr int LDS_K = 0, LDS_V = NSLOT * KSLOT, LDS_WS = LDS_V + NSLOT * VSLOT, LDS_OST = LDS_WS + NW * 64 * 4, LDS_BYTES = LDS_OST + NW * 4096;
constexpr float NEGBIG = -1.0e30f;
constexpr float THR = 8.0f;

__device__ __forceinline__ int crow(int r, int hi) { return (r & 3) + 8 * (r >> 2) + 4 * hi; }
__device__ __forceinline__ void glds16(const void* gsrc, unsigned lds_dst) { unsigned keep;
    asm volatile("s_mov_b32 %0, m0\n\ts_mov_b32 m0, %2\n\ts_nop 0\n\tglobal_load_lds_dwordx4 %1, off\n\ts_mov_b32 m0, %0" : "=&s"(keep) : "v"(gsrc), "s"(lds_dst) : "memory"); }
__device__ __forceinline__ unsigned cvtpk(float lo, float hi) { f32x2_t v = {lo, hi}; bf16x2_t b = __builtin_convertvector(v, bf16x2_t); return __builtin_bit_cast(unsigned, b); }
__device__ __forceinline__ s16x4 vtr(lds_cptr p) { return __builtin_bit_cast(s16x4, __builtin_amdgcn_ds_read_tr16_b64_v4i16((__attribute__((address_space(3))) v4i16_t*)p)); }
__device__ __forceinline__ float swapmax(float m) { auto rr = __builtin_amdgcn_permlane32_swap(__float_as_uint(m), __float_as_uint(m), false, false); return __builtin_fmaxf(__uint_as_float(rr[0]), __uint_as_float(rr[1])); }
__device__ __forceinline__ float swapadd(float m) { auto rr = __builtin_amdgcn_permlane32_swap(__float_as_uint(m), __float_as_uint(m), false, false); return __uint_as_float(rr[0]) + __uint_as_float(rr[1]); }
__device__ __forceinline__ float fadd_s(float a, float b) { float r; asm("v_add_f32_e32 %0, %1, %2" : "=v"(r) : "v"(a), "v"(b)); return r; }
__device__ __forceinline__ int lane_now() { int l; asm volatile("v_mbcnt_lo_u32_b32 %0, -1, 0\n\tv_mbcnt_hi_u32_b32 %0, -1, %0" : "=v"(l)); return l; }
#ifndef ATT_SHV
#define ATT_SHV 1
#endif
#ifndef ATT_DEEP
#define ATT_DEEP 1
#endif
#ifndef ATT_SMAX
#define ATT_SMAX 1
#endif
#define ATT_WAIT_BAR(N) asm volatile("s_waitcnt vmcnt(" #N ") lgkmcnt(0)\n\ts_barrier" ::: "memory")

struct Job {
    const bf16_t* Q; int qs;
    const bf16_t* K0; int ks0;
    const bf16_t* K1; int ks1;
    const bf16_t* V; int vs;
    bf16_t* O; int os; long omap;
    float* LSE; int ls; long lmap;
    int q0, t_lo, t_hi, max_dist;
    float slope2, sink2;
    const f32x2_t* rope;
    float kmax2[2];
};

template <int NCH, int NMAP, bool ALIBI, int EPI, bool QROPE = false, bool TRUNC = false, int XP = 0, bool STAG = false>
__device__ __forceinline__ void attn_unit(const Job& J, char* shm, unsigned* qhead, volatile __attribute__((address_space(3))) unsigned* qslot, const int wave_id) {
    constexpr int NPK = 2 * NCH * NMAP;
    static_assert(!STAG || NMAP == 1, "STAG: single map");
    constexpr bool DEEP = (ATT_DEEP != 0) && !STAG;
    constexpr int AHEAD = DEEP ? 3 : 2;
    constexpr int NS = (STAG || DEEP) ? 4 : 3, LDS_K = 0, LDS_V = NS * KSLOT, LDS_WS = LDS_V + NS * VSLOT, LDS_OST = LDS_WS + NW * 64 * 4;
    int lane_; asm volatile("v_mbcnt_lo_u32_b32 %0, -1, 0\n\tv_mbcnt_hi_u32_b32 %0, -1, %0" : "=v"(lane_));
    const int wid = wave_id, lane = lane_, tid = wid * 64 + lane, r32 = lane & 31, hi = lane >> 5;
    unsigned q_next = 0; if (tid == 0) q_next = __hip_atomic_fetch_add(qhead, 1u, __ATOMIC_RELAXED, __HIP_MEMORY_SCOPE_AGENT);
    const unsigned lds0 = (unsigned)(uintptr_t)shm;
    float* wsf = (float*)(shm + LDS_WS) + wid * 64;
    const unsigned koffA = (unsigned)(lane * J.ks0 + wid * 8) * 2u, koffB = (NPK > 8) ? (unsigned)(lane * J.ks1 + wid * 8) * 2u : 0u;
    const unsigned voff = (unsigned)((16 * (wid & 3) + (lane >> 2)) * J.vs + (wid >> 2) * 32 + (lane & 3) * 8) * 2u;
    const long kstepA = (long)KVBLK * J.ks0 * 2, kstepB = (NPK > 8) ? (long)KVBLK * J.ks1 * 2 : 0, vstep = (long)KVBLK * J.vs * 2;
    const unsigned kdst = lds0 + LDS_K + wid * 1024, vdst = lds0 + LDS_V + wid * 1024;
    const bool extraK = (NPK > 8) && (wid < NPK - 8);
#define ATT_DMA(t, slot) do { if (XP == 4) break; pg8::glds_s(koffA, (const char*)J.K0 + (long)(t) * kstepA, kdst + (slot) * KSLOT); \
        if (extraK) pg8::glds_s(koffB, (const char*)J.K1 + (long)(t) * kstepB, kdst + (slot) * KSLOT + 8192); \
        pg8::glds_s(voff, (const char*)J.V + (long)(t) * vstep, vdst + (slot) * VSLOT); } while (0)
    const int qw = J.q0 + wid * QBLK;
    const int nq = qw + r32;
    if constexpr (!ALIBI) { if (J.t_lo < J.t_hi) ATT_DMA(J.t_lo, 0); if (J.t_lo + 1 < J.t_hi) ATT_DMA(J.t_lo + 1, 1); if (DEEP && J.t_lo + 2 < J.t_hi) ATT_DMA(J.t_lo + 2, 2); }
    bf16x8 qr[NMAP][NCH];
    { const bf16_t* qp = J.Q + (long)nq * J.qs + hi * 8;
#pragma unroll
      for (int m = 0; m < NMAP; ++m)
#pragma unroll
        for (int c = 0; c < NCH; ++c) qr[m][c] = *reinterpret_cast<const bf16x8*>(qp + (m * NCH + c) * 16); }
    if constexpr (QROPE) {
        const f32x2_t* rt = J.rope + (size_t)nq * 16 + hi * 4;
#pragma unroll
        for (int c = 0; c < 2; ++c) { bf16x8 q = qr[0][NCH - 2 + c]; bf16x8 r;
#pragma unroll
            for (int i = 0; i < 4; ++i) { const f32x2_t cs = rt[c * 8 + i]; const float a = __uint_as_float((unsigned)(unsigned short)q[2 * i] << 16), b = __uint_as_float((unsigned)(unsigned short)q[2 * i + 1] << 16);
                const unsigned w = cvtpk(a * cs.x - b * cs.y, b * cs.x + a * cs.y); r[2 * i] = (short)(w & 0xffffu); r[2 * i + 1] = (short)(w >> 16); }
            qr[0][NCH - 2 + c] = r; }
    }
    int t_lo = J.t_lo; const int t_hi = J.t_hi; int soft_dist = 1 << 28; float qk2row[NMAP]; bool stat = false;
    if constexpr (TRUNC) {
        float b2 = 0.f;
#pragma unroll
        for (int m = 0; m < NMAP; ++m) { float q2 = 0.f;
#pragma unroll
            for (int c = 0; c < NCH; ++c)
#pragma unroll
                for (int e = 0; e < 8; ++e) { const float x = __uint_as_float((unsigned)(unsigned short)qr[m][c][e] << 16); q2 += x * x; }
            q2 = swapadd(q2); qk2row[m] = q2 * J.kmax2[m];
#pragma unroll
            for (int o_ = 1; o_ < 32; o_ <<= 1) q2 = fmaxf(q2, __int_as_float(__builtin_amdgcn_ds_bpermute((lane ^ o_) << 2, __float_as_int(q2))));
            b2 = fmaxf(b2, q2 * J.kmax2[m]); }
        float* xq = (float*)(shm + LDS_OST);
        if (lane == 0) xq[wid] = b2;
        asm volatile("s_waitcnt lgkmcnt(0)\n\ts_barrier" ::: "memory");
        float bm = xq[0];
#pragma unroll
        for (int w_ = 1; w_ < NW; ++w_) bm = fmaxf(bm, xq[w_]);
        if constexpr (ALIBI) {
        const float bound = 2.02f * __builtin_sqrtf(bm) + 80.f;
        const float dmin = bound / J.slope2;
        soft_dist = __builtin_amdgcn_readfirstlane(dmin < 1.0e8f ? (int)dmin + 1 : (1 << 28));
        const int tl = (J.q0 - soft_dist) >> 6; t_lo = tl > t_lo ? tl : t_lo;
        }
        stat = ATT_SMAX && (1.01f * __builtin_sqrtf(bm) <= 50.f);
    }
    if constexpr (ALIBI) { if (t_lo < t_hi) ATT_DMA(t_lo, 0); if (t_lo + 1 < t_hi) ATT_DMA(t_lo + 1, 1); if (DEEP && t_lo + 2 < t_hi) ATT_DMA(t_lo + 2, 2); }
    if (!(t_lo < t_hi)) { __builtin_amdgcn_s_barrier(); if (tid == 0) *qslot = q_next; }
#ifndef ATT_SB
#define ATT_SB 1
#endif
#ifndef ATT_ONES
#define ATT_ONES 0
#endif
#ifndef ATT_HALF
#define ATT_HALF 0
#endif
    constexpr bool ONES = (NMAP == 1) && ATT_ONES;
    float mhat[NMAP], lsum[NMAP]; f32x16 o[NMAP][2]; f32x16 osum, negm;
    float zero_ = 0.f; asm volatile("" : "+v"(zero_));
#pragma unroll
    for (int m = 0; m < NMAP; ++m) { mhat[m] = -1000.f; lsum[m] = 0.f;
#pragma unroll
        for (int r = 0; r < 16; ++r) { o[m][0][r] = zero_; o[m][1][r] = zero_; } }
#pragma unroll
    for (int r = 0; r < 16; ++r) { osum[r] = zero_; negm[r] = 1000.f + zero_; }
    if constexpr (TRUNC) { if (stat) {
#pragma unroll
        for (int m = 0; m < NMAP; ++m) mhat[m] = 1.01f * __builtin_sqrtf(qk2row[m]);
        if (!ALIBI) {
#pragma unroll
            for (int r = 0; r < 16; ++r) negm[r] = -mhat[0]; } } }
    const bf16x8 ones = (bf16x8){0x3f80, 0x3f80, 0x3f80, 0x3f80, 0x3f80, 0x3f80, 0x3f80, 0x3f80};
    const lds_cptr shm3 = (lds_cptr)shm;
    const lds_cptr kp0 = shm3 + LDS_K + hi * 1024 + r32 * 16;
    const lds_cptr vp0 = shm3 + LDS_V + ((lane >> 4) & 1) * 32 + (lane & 3) * 8 + (4 * hi + ((lane & 15) >> 2)) * 64;
    int slot = 0; u32x4 ppw[4]; bool pend = false; const bool late = STAG && ((wid & 1) != 0);
    for (int t = t_lo; t < t_hi; ++t) {
        if (XP == 5) { asm volatile("s_waitcnt vmcnt(3) lgkmcnt(0)" ::: "memory"); } else
        if (DEEP && t + 2 < t_hi) { if (extraK) ATT_WAIT_BAR(6); else ATT_WAIT_BAR(4); } else
        if (t + 1 < t_hi) { if (extraK) ATT_WAIT_BAR(3); else ATT_WAIT_BAR(2); } else ATT_WAIT_BAR(0);
        if (t == t_lo && tid == 0) *qslot = q_next;
        if (t + AHEAD < t_hi) { const int s2 = (slot + AHEAD >= NS) ? slot + AHEAD - NS : slot + AHEAD; ATT_DMA(t + AHEAD, s2); }
        if constexpr (STAG) { if (pend) { const lds_cptr vq = vp0 + ((slot == 0) ? NS - 1 : slot - 1) * VSLOT;
#pragma unroll
            for (int d0 = 0; d0 < 2; ++d0) {
#pragma unroll
                for (int ks = 0; ks < 4; ++ks) { const s16x4 vl = vtr(vq + d0 * 4096 + ks * 1024), vh = vtr(vq + d0 * 4096 + ks * 1024 + 512);
                    const bf16x8 vf = (bf16x8){vl[0], vl[1], vl[2], vl[3], vh[0], vh[1], vh[2], vh[3]};
                    o[0][d0] = __builtin_amdgcn_mfma_f32_32x32x16_bf16(__builtin_bit_cast(bf16x8, ppw[ks]), vf, o[0][d0], 0, 0, 0); }
                __builtin_amdgcn_sched_barrier(0); }
            pend = false; } }
        const int k_lo = t * KVBLK;
        const int e0 = qw - (k_lo + 31), e1 = qw - (k_lo + 63);
        bool act0 = (k_lo <= qw + QBLK - 1) && (e0 <= J.max_dist) && (!TRUNC || e0 <= soft_dist);
        bool act1 = (k_lo + 32 <= qw + QBLK - 1) && (e1 <= J.max_dist) && (!TRUNC || e1 <= soft_dist);
        if (XP != 8 && (act0 || act1)) {
            bool clean0 = (e0 >= 0) && (qw + QBLK - 1 - k_lo <= J.max_dist), clean1 = (e1 >= 0) && (qw + QBLK - 1 - (k_lo + 32) <= J.max_dist);
            if (!ATT_HALF) { clean0 = clean0 && act0; clean1 = clean1 && act1; act0 = true; act1 = true; }
            const int dq = nq - k_lo;
            const lds_cptr kp = kp0 + slot * KSLOT; const lds_cptr vp = vp0 + slot * VSLOT;
            u32x4 pwk[4];
#pragma unroll
            for (int m = 0; m < NMAP; ++m) {
                if (ATT_SB) __builtin_amdgcn_sched_barrier(0);
                u32x4 pw[4]; f32x16 p0, p1;
                if (ALIBI) { const float L = -mhat[m] - J.slope2 * (float)(dq - 4 * hi), L1 = L + 32.f * J.slope2;
#pragma unroll
                    for (int r = 0; r < 16; ++r) { float a_ = __builtin_fmaf(J.slope2, (float)crow(r, 0), L), b_ = __builtin_fmaf(J.slope2, (float)crow(r, 0), L1); asm("" : "+v"(a_)); asm("" : "+v"(b_)); p0[r] = a_; p1[r] = b_; } }
                else if (!(act0 && act1)) { p0 = negm; p1 = negm; }
                if (XP == 3) { } else if (act0 && act1) {
#pragma unroll
                    for (int c = 0; c < NCH; ++c) {
                        const bf16x8 b0 = XP == 6 ? qr[m][(c + 1) % NCH] : *(const __attribute__((address_space(3))) bf16x8*)(kp + (m * NCH + c) * 2048);
                        const bf16x8 b1 = XP == 6 ? qr[m][(c + 2) % NCH] : *(const __attribute__((address_space(3))) bf16x8*)(kp + (m * NCH + c) * 2048 + 512);
                        if (!ALIBI && c == 0) { p0 = __builtin_amdgcn_mfma_f32_32x32x16_bf16(b0, qr[m][c], negm, 0, 0, 0); p1 = __builtin_amdgcn_mfma_f32_32x32x16_bf16(b1, qr[m][c], negm, 0, 0, 0); }
                        else { p0 = __builtin_amdgcn_mfma_f32_32x32x16_bf16(b0, qr[m][c], p0, 0, 0, 0);
                               p1 = __builtin_amdgcn_mfma_f32_32x32x16_bf16(b1, qr[m][c], p1, 0, 0, 0); } }
                } else if (act0) {
#pragma unroll
                    for (int c = 0; c < NCH; ++c) p0 = __builtin_amdgcn_mfma_f32_32x32x16_bf16(*(const __attribute__((address_space(3))) bf16x8*)(kp + (m * NCH + c) * 2048), qr[m][c], p0, 0, 0, 0);
                } else {
#pragma unroll
                    for (int c = 0; c < NCH; ++c) p1 = __builtin_amdgcn_mfma_f32_32x32x16_bf16(*(const __attribute__((address_space(3))) bf16x8*)(kp + (m * NCH + c) * 2048 + 512), qr[m][c], p1, 0, 0, 0);
                }
                const int lo = dq - J.max_dist;
                if (!act0) {
#pragma unroll
                    for (int r = 0; r < 16; ++r) p0[r] = NEGBIG;
                } else if (!clean0) {
#pragma unroll
                    for (int r = 0; r < 16; ++r) { const int kl = crow(r, hi); if (kl > dq || kl < lo) p0[r] = NEGBIG; }
                }
                if (!act1) {
#pragma unroll
                    for (int r = 0; r < 16; ++r) p1[r] = NEGBIG;
                } else if (!clean1) {
#pragma unroll
                    for (int r = 0; r < 16; ++r) { const int kl = crow(r, hi) + 32; if (kl > dq || kl < lo) p1[r] = NEGBIG; }
                }
                float rm = 0.f;
                if (XP != 1 && !stat) { float a = __builtin_fmaxf(__builtin_fmaxf(p0[0], p0[1]), p1[0]), b = __builtin_fmaxf(__builtin_fmaxf(p0[2], p0[3]), p1[1]); a = __builtin_fmaxf(__builtin_fmaxf(a, p1[2]), p1[3]);
#pragma unroll
                  for (int r = 4; r < 16; r += 4) { a = __builtin_fmaxf(__builtin_fmaxf(a, p0[r]), p0[r + 1]); b = __builtin_fmaxf(__builtin_fmaxf(b, p0[r + 2]), p0[r + 3]);
                      a = __builtin_fmaxf(__builtin_fmaxf(a, p1[r]), p1[r + 1]); b = __builtin_fmaxf(__builtin_fmaxf(b, p1[r + 2]), p1[r + 3]); }
                  rm = swapmax(__builtin_fmaxf(a, b)); }
                if (__any(rm > THR)) {
                    const float dl = __builtin_fmaxf(rm, 0.f); mhat[m] += dl;
#pragma unroll
                    for (int r = 0; r < 16; ++r) { p0[r] -= dl; p1[r] -= dl; }
                    if (!ALIBI) {
#pragma unroll
                        for (int r = 0; r < 16; ++r) negm[r] = -mhat[m];
                    }
                    const float f = __builtin_amdgcn_exp2f(-dl); lsum[m] *= f;
                    if (hi == 0) wsf[m * 32 + r32] = f;
                    asm volatile("s_waitcnt lgkmcnt(0)" ::: "memory");
#pragma unroll
                    for (int r = 0; r < 16; ++r) { const float fr_ = wsf[m * 32 + crow(r, hi)]; o[m][0][r] *= fr_; o[m][1][r] *= fr_; if (ONES) osum[r] *= fr_; }
                }
                if (act0) { float sacc = 0.f;
#pragma unroll
                    for (int r = 0; r < 16; ++r) { if (XP != 1) { float x_ = __builtin_amdgcn_exp2f(p0[r]); asm("" : "+v"(x_)); p0[r] = x_; if (!ONES) sacc += x_; } }
                    if (!ONES) lsum[m] += sacc;
                    pw[0] = (u32x4){cvtpk(p0[0], p0[1]), cvtpk(p0[2], p0[3]), cvtpk(p0[4], p0[5]), cvtpk(p0[6], p0[7])};
                    pw[1] = (u32x4){cvtpk(p0[8], p0[9]), cvtpk(p0[10], p0[11]), cvtpk(p0[12], p0[13]), cvtpk(p0[14], p0[15])}; }
                if (act1) { float sacc = 0.f;
#pragma unroll
                    for (int r = 0; r < 16; ++r) { if (XP != 1) { float x_ = __builtin_amdgcn_exp2f(p1[r]); asm("" : "+v"(x_)); p1[r] = x_; if (!ONES) sacc += x_; } }
                    if (!ONES) lsum[m] += sacc;
                    pw[2] = (u32x4){cvtpk(p1[0], p1[1]), cvtpk(p1[2], p1[3]), cvtpk(p1[4], p1[5]), cvtpk(p1[6], p1[7])};
                    pw[3] = (u32x4){cvtpk(p1[8], p1[9]), cvtpk(p1[10], p1[11]), cvtpk(p1[12], p1[13]), cvtpk(p1[14], p1[15])}; }
                if (ATT_SB) __builtin_amdgcn_sched_barrier(0);
#define ATT_PV(KS0, KS1) do { _Pragma("unroll") for (int d0 = 0; d0 < 2; ++d0) { _Pragma("unroll") for (int ks = (KS0); ks < (KS1); ++ks) { \
                        bf16x8 vf; if (XP == 7) vf = qr[m][(d0 * 4 + ks) % NCH]; else { const s16x4 vl = vtr(vp + d0 * 4096 + ks * 1024), vh = vtr(vp + d0 * 4096 + ks * 1024 + 512); \
                        vf = (bf16x8){vl[0], vl[1], vl[2], vl[3], vh[0], vh[1], vh[2], vh[3]}; } \
                        o[m][d0] = __builtin_amdgcn_mfma_f32_32x32x16_bf16(__builtin_bit_cast(bf16x8, pw[ks]), vf, o[m][d0], 0, 0, 0); \
                        if (ONES && d0 == 0) osum = __builtin_amdgcn_mfma_f32_32x32x16_bf16(__builtin_bit_cast(bf16x8, pw[ks]), ones, osum, 0, 0, 0); } \
                    if (ATT_SB) __builtin_amdgcn_sched_barrier(0); } } while (0)
#define ATT_PV2(KS0, KS1) do { _Pragma("unroll") for (int d0 = 0; d0 < 2; ++d0) { _Pragma("unroll") for (int ks = (KS0); ks < (KS1); ++ks) { \
                        const s16x4 vl = vtr(vp + d0 * 4096 + ks * 1024), vh = vtr(vp + d0 * 4096 + ks * 1024 + 512); const bf16x8 vf = (bf16x8){vl[0], vl[1], vl[2], vl[3], vh[0], vh[1], vh[2], vh[3]}; \
                        o[0][d0] = __builtin_amdgcn_mfma_f32_32x32x16_bf16(__builtin_bit_cast(bf16x8, pwk[ks]), vf, o[0][d0], 0, 0, 0); \
                        o[NMAP - 1][d0] = __builtin_amdgcn_mfma_f32_32x32x16_bf16(__builtin_bit_cast(bf16x8, pw[ks]), vf, o[NMAP - 1][d0], 0, 0, 0); } \
                    if (ATT_SB) __builtin_amdgcn_sched_barrier(0); } } while (0)
                constexpr bool SHV = (NMAP == 2) && (ATT_SHV != 0) && (XP == 0) && !STAG;
                if (SHV && m == 0) { pwk[0] = pw[0]; pwk[1] = pw[1]; pwk[2] = pw[2]; pwk[3] = pw[3]; }
                else if (SHV) { if (act0 && act1) ATT_PV2(0, 4); else if (act0) ATT_PV2(0, 2); else ATT_PV2(2, 4); }
                else if (XP == 2) { o[m][0][0] += __uint_as_float(pw[0][0] ^ pw[1][1] ^ pw[2][2] ^ pw[3][3]); }
                else if (STAG && late) { ppw[0] = pw[0]; ppw[1] = pw[1]; ppw[2] = pw[2]; ppw[3] = pw[3]; pend = true; }
                else if (act0 && act1) ATT_PV(0, 4); else if (act0) ATT_PV(0, 2); else ATT_PV(2, 4);
#undef ATT_PV
#undef ATT_PV2
            }
        }
        slot = (slot == NS - 1) ? 0 : slot + 1;
    }
    if constexpr (STAG) { if (pend) { const lds_cptr vq = vp0 + ((slot == 0) ? NS - 1 : slot - 1) * VSLOT;
#pragma unroll
        for (int d0 = 0; d0 < 2; ++d0)
#pragma unroll
            for (int ks = 0; ks < 4; ++ks) { const s16x4 vl = vtr(vq + d0 * 4096 + ks * 1024), vh = vtr(vq + d0 * 4096 + ks * 1024 + 512);
                const bf16x8 vf = (bf16x8){vl[0], vl[1], vl[2], vl[3], vh[0], vh[1], vh[2], vh[3]};
                o[0][d0] = __builtin_amdgcn_mfma_f32_32x32x16_bf16(__builtin_bit_cast(bf16x8, ppw[ks]), vf, o[0][d0], 0, 0, 0); } } }
#pragma unroll
    for (int m = 0; m < NMAP; ++m) {
        float l;
        if (ONES) {
            if (r32 == 0) {
#pragma unroll
                for (int r = 0; r < 16; ++r) wsf[crow(r, hi)] = osum[r]; }
            asm volatile("s_waitcnt lgkmcnt(0)" ::: "memory");
            l = wsf[r32];
            asm volatile("s_waitcnt lgkmcnt(0)" ::: "memory");
        } else l = swapadd(lsum[m]);
        if (EPI == 3) l += __builtin_amdgcn_exp2f(J.sink2 - mhat[m]);
        if (EPI == 1) { if (hi == 0) J.LSE[m * J.lmap + (long)nq * J.ls] = mhat[m] + __builtin_amdgcn_logf(l); }
        if (hi == 0) wsf[m * 32 + r32] = l > 0.f ? __builtin_amdgcn_rcpf(l) : 0.f;
    }
    asm volatile("s_waitcnt lgkmcnt(0)" ::: "memory");
#pragma unroll
    for (int m = 0; m < NMAP; ++m) {
        __hip_bfloat16* stg = (__hip_bfloat16*)(shm + LDS_OST) + wid * 2048;
#pragma unroll
        for (int r = 0; r < 16; ++r) { const int orow = crow(r, hi); const float rl = wsf[m * 32 + orow];
#pragma unroll
            for (int d0 = 0; d0 < 2; ++d0) stg[orow * 64 + d0 * 32 + r32] = __float2bfloat16(o[m][d0][r] * rl); }
        asm volatile("s_waitcnt lgkmcnt(0)" ::: "memory");
        bf16_t* Ow = J.O + m * J.omap + (long)qw * J.os;
#pragma unroll
        for (int i = 0; i < 4; ++i) { const int row = i * 8 + (lane >> 3), ch = lane & 7; const u32x4 v = *(const u32x4*)((const bf16_t*)stg + row * 64 + ch * 8);
            *(u32x4*)(Ow + (long)row * J.os + ch * 8) = v; }
        asm volatile("s_waitcnt lgkmcnt(0)" ::: "memory");
    }
    asm volatile("s_waitcnt lgkmcnt(0)\n\ts_barrier" ::: "memory");
#undef ATT_DMA
}
}

namespace att {
constexpr int P_NSLOT = 4, P_LDS_K = 0, P_LDS_V = P_NSLOT * KSLOT, P_LDS_WS = P_LDS_V + P_NSLOT * VSLOT, P_LDS_OST = P_LDS_WS + NW * 64 * 4, P_LDS_BYTES = P_LDS_OST + NW * 4096;
template <int NCH, bool ALIBI, int EPI, bool QROPE = false>
__device__ __forceinline__ void attn_unit2(const Job& J, char* shm, unsigned* qhead, volatile __attribute__((address_space(3))) unsigned* qslot, const int wave_id) {
    constexpr int NQK = 2 * NCH;
    int lane_; asm volatile("v_mbcnt_lo_u32_b32 %0, -1, 0\n\tv_mbcnt_hi_u32_b32 %0, -1, %0" : "=v"(lane_));
    const int wid = wave_id, lane = lane_, tid = wid * 64 + lane, r32 = lane & 31, hi = lane >> 5;
    unsigned q_next = 0; if (tid == 0) q_next = __hip_atomic_fetch_add(qhead, 1u, __ATOMIC_RELAXED, __HIP_MEMORY_SCOPE_AGENT);
    const unsigned lds0 = (unsigned)(uintptr_t)shm;
    float* wsf = (float*)(shm + P_LDS_WS) + wid * 64;
    const unsigned koffA = (unsigned)(lane * J.ks0 + wid * 8) * 2u, koffB = (NQK > 8) ? (unsigned)(lane * J.ks1 + wid * 8) * 2u : 0u;
    const unsigned voff = (unsigned)((16 * (wid & 3) + (lane >> 2)) * J.vs + (wid >> 2) * 32 + (lane & 3) * 8) * 2u;
    const long kstepA = (long)KVBLK * J.ks0 * 2, kstepB = (NQK > 8) ? (long)KVBLK * J.ks1 * 2 : 0, vstep = (long)KVBLK * J.vs * 2;
    const unsigned kdst = lds0 + P_LDS_K + wid * 1024, vdst = lds0 + P_LDS_V + wid * 1024;
    const bool extraK = (NQK > 8) && (wid < NQK - 8);
#define ATT2_DMA(t, slot) do { pg8::glds_s(koffA, (const char*)J.K0 + (long)(t) * kstepA, kdst + (slot) * KSLOT); \
        if (extraK) pg8::glds_s(koffB, (const char*)J.K1 + (long)(t) * kstepB, kdst + (slot) * KSLOT + 8192); \
        pg8::glds_s(voff, (const char*)J.V + (long)(t) * vstep, vdst + (slot) * VSLOT); } while (0)
    const int qw = J.q0 + wid * QBLK, nq = qw + r32;
    bf16x8 qr[NCH];
    { const bf16_t* qp = J.Q + (long)nq * J.qs + hi * 8;
#pragma unroll
      for (int c = 0; c < NCH; ++c) qr[c] = *reinterpret_cast<const bf16x8*>(qp + c * 16); }
    if constexpr (QROPE) {
        const f32x2_t* rt = J.rope + (size_t)nq * 16 + hi * 4;
#pragma unroll
        for (int c = 0; c < 2; ++c) { bf16x8 q = qr[NCH - 2 + c]; bf16x8 r;
#pragma unroll
            for (int i = 0; i < 4; ++i) { const f32x2_t cs = rt[c * 8 + i]; const float a = __uint_as_float((unsigned)(unsigned short)q[2 * i] << 16), b = __uint_as_float((unsigned)(unsigned short)q[2 * i + 1] << 16);
                const unsigned w = cvtpk(a * cs.x - b * cs.y, b * cs.x + a * cs.y); r[2 * i] = (short)(w & 0xffffu); r[2 * i + 1] = (short)(w >> 16); }
            qr[NCH - 2 + c] = r; __builtin_amdgcn_sched_barrier(0); }
    }
    __builtin_amdgcn_sched_barrier(0);
    const int t_lo = J.t_lo, t_hi = J.t_hi;
    int tw_lo = t_lo; if (J.max_dist < (1 << 27)) { const int a = (qw - J.max_dist) >> 6; tw_lo = a > tw_lo ? a : tw_lo; }
    int tw_hi = ((qw + QBLK - 1) >> 6) + 1; tw_hi = tw_hi < t_hi ? tw_hi : t_hi;
    ATT2_DMA(t_lo, 0); if (t_lo + 1 < t_hi) ATT2_DMA(t_lo + 1, 1);
    float mhat = -1000.f, lsum = 0.f; f32x16 o[2], negm, pc0, pc1, pn0, pn1;
    float zero_ = 0.f; asm volatile("" : "+v"(zero_));
#pragma unroll
    for (int r = 0; r < 16; ++r) { o[0][r] = zero_; o[1][r] = zero_; negm[r] = 1000.f + zero_; pc0[r] = zero_; pc1[r] = zero_; }
    const lds_cptr shm3 = (lds_cptr)shm;
    const lds_cptr kp0 = shm3 + P_LDS_K + hi * 1024 + r32 * 16;
    const lds_cptr vp0 = shm3 + P_LDS_V + ((lane >> 4) & 1) * 32 + (lane & 3) * 8 + (4 * hi + ((lane & 15) >> 2)) * 64;
    bool have_cur = false;
#define ATT2_PC(e) ((e) < 16 ? pc0[(e) & 15] : pc1[(e) & 15])
    for (int i = t_lo - 1; i < t_hi; ++i) {
        if (i + 2 < t_hi) { if (extraK) ATT_WAIT_BAR(3); else ATT_WAIT_BAR(2); } else ATT_WAIT_BAR(0);
        if (i == t_lo - 1 && tid == 0) *qslot = q_next;
        if (i + 3 < t_hi) ATT2_DMA(i + 3, (i + 3 - t_lo) & 3);
        const bool do_next = (i + 1 >= tw_lo) && (i + 1 < tw_hi), do_cur = have_cur;
        const lds_cptr kp = kp0 + ((i + 1 - t_lo) & 3) * KSLOT; const lds_cptr vp = vp0 + ((i - t_lo) & 3) * VSLOT;
        const int k_lo = (i + 1) * KVBLK, dq = nq - k_lo;
        u32x4 pw[4]; float sacc = 0.f;
#define ATT2_INIT() do { if (ALIBI) { const float L = -mhat - J.slope2 * (float)(dq - 4 * hi), L1 = L + 32.f * J.slope2; \
                _Pragma("unroll") for (int r = 0; r < 16; ++r) { pn0[r] = __builtin_fmaf(J.slope2, (float)crow(r, 0), L); pn1[r] = __builtin_fmaf(J.slope2, (float)crow(r, 0), L1); } } \
            else { const float L = -mhat; _Pragma("unroll") for (int r = 0; r < 16; ++r) { pn0[r] = L; pn1[r] = L; } } } while (0)
#define ATT2_KLD(j) (*(const __attribute__((address_space(3))) bf16x8*)(kp + ((j) >> 1) * 2048 + ((j) & 1) * 512))
        if (do_next && do_cur) {
            ATT2_INIT();
            bf16x8 kf[NQK]; kf[0] = ATT2_KLD(0); kf[1] = ATT2_KLD(1);
            __builtin_amdgcn_sched_barrier(0);
#pragma unroll
            for (int j = 0; j < NQK; ++j) {
                if (j + 2 < NQK) kf[j + 2] = ATT2_KLD(j + 2);
                if ((j & 1) == 0) pn0 = __builtin_amdgcn_mfma_f32_32x32x16_bf16(kf[j], qr[j >> 1], pn0, 0, 0, 0);
                else pn1 = __builtin_amdgcn_mfma_f32_32x32x16_bf16(kf[j], qr[j >> 1], pn1, 0, 0, 0);
                const int e0 = j * 32 / NQK, e1 = (j + 1) * 32 / NQK;
#pragma unroll
                for (int e = e0; e < e1; ++e) { const float x = __builtin_amdgcn_exp2f(ATT2_PC(e)); if (e < 16) pc0[e & 15] = x; else pc1[e & 15] = x; sacc += x; }
#pragma unroll
                for (int k = e0 / 2; k < e1 / 2; ++k) pw[k >> 2][k & 3] = cvtpk(ATT2_PC(2 * k), ATT2_PC(2 * k + 1));
                asm volatile("" : "+v"(sacc));
                __builtin_amdgcn_sched_barrier(0);
            }
        } else if (do_next) {
            ATT2_INIT();
#pragma unroll
            for (int j = 0; j < NQK; ++j) { const bf16x8 kfj = ATT2_KLD(j);
                if ((j & 1) == 0) pn0 = __builtin_amdgcn_mfma_f32_32x32x16_bf16(kfj, qr[j >> 1], pn0, 0, 0, 0);
                else pn1 = __builtin_amdgcn_mfma_f32_32x32x16_bf16(kfj, qr[j >> 1], pn1, 0, 0, 0); }
        } else if (do_cur) {
#pragma unroll
            for (int e = 0; e < 32; ++e) { const float x = __builtin_amdgcn_exp2f(ATT2_PC(e)); if (e < 16) pc0[e & 15] = x; else pc1[e & 15] = x; sacc += x; }
#pragma unroll
            for (int k = 0; k < 16; ++k) pw[k >> 2][k & 3] = cvtpk(ATT2_PC(2 * k), ATT2_PC(2 * k + 1));
        }
#undef ATT2_INIT
#undef ATT2_KLD
        lsum += sacc;
        if (do_next) { const bool clean = (k_lo + KVBLK - 1 <= qw) && (qw + QBLK - 1 - k_lo <= J.max_dist);
            if (!clean) { const int lo = dq - J.max_dist;
#pragma unroll
                for (int r = 0; r < 16; ++r) { const int kl = crow(r, hi); if (kl > dq || kl < lo) pn0[r] = NEGBIG; if (kl + 32 > dq || kl + 32 < lo) pn1[r] = NEGBIG; } } }
        __builtin_amdgcn_sched_barrier(0);
        float ma = NEGBIG, mb = NEGBIG;
#define ATT2_VLD(g, VL, VH) do { VL = vtr(vp + ((g) >> 2) * 4096 + ((g) & 3) * 1024); VH = vtr(vp + ((g) >> 2) * 4096 + ((g) & 3) * 1024 + 512); } while (0)
        if (do_cur && do_next) {
            s16x4 vl[8], vh[8]; ATT2_VLD(0, vl[0], vh[0]);
            __builtin_amdgcn_sched_barrier(0);
#pragma unroll
            for (int g = 0; g < 8; ++g) {
                if (g + 1 < 8) ATT2_VLD(g + 1, vl[g + 1], vh[g + 1]);
                const bf16x8 vf = (bf16x8){vl[g][0], vl[g][1], vl[g][2], vl[g][3], vh[g][0], vh[g][1], vh[g][2], vh[g][3]};
                o[g >> 2] = __builtin_amdgcn_mfma_f32_32x32x16_bf16(__builtin_bit_cast(bf16x8, pw[g & 3]), vf, o[g >> 2], 0, 0, 0);
                if (g < 4) { ma = __builtin_fmaxf(__builtin_fmaxf(ma, pn0[4 * g]), pn0[4 * g + 1]); mb = __builtin_fmaxf(__builtin_fmaxf(mb, pn0[4 * g + 2]), pn0[4 * g + 3]); }
                else { ma = __builtin_fmaxf(__builtin_fmaxf(ma, pn1[4 * g - 16]), pn1[4 * g - 15]); mb = __builtin_fmaxf(__builtin_fmaxf(mb, pn1[4 * g - 14]), pn1[4 * g - 13]); }
                asm volatile("" : "+v"(ma), "+v"(mb));
                __builtin_amdgcn_sched_barrier(0);
            }
        } else if (do_cur) {
#pragma unroll
            for (int g = 0; g < 8; ++g) { s16x4 vl_, vh_; ATT2_VLD(g, vl_, vh_);
                const bf16x8 vf = (bf16x8){vl_[0], vl_[1], vl_[2], vl_[3], vh_[0], vh_[1], vh_[2], vh_[3]};
                o[g >> 2] = __builtin_amdgcn_mfma_f32_32x32x16_bf16(__builtin_bit_cast(bf16x8, pw[g & 3]), vf, o[g >> 2], 0, 0, 0); }
        } else if (do_next) {
#pragma unroll
            for (int r = 0; r < 16; r += 2) { ma = __builtin_fmaxf(__builtin_fmaxf(ma, pn0[r]), pn0[r + 1]); mb = __builtin_fmaxf(__builtin_fmaxf(mb, pn1[r]), pn1[r + 1]); }
        }
#undef ATT2_VLD
        if (do_next) {
            const float rm = swapmax(__builtin_fmaxf(ma, mb));
            if (__any(rm > THR)) {
                const float dl = __builtin_fmaxf(rm, 0.f); mhat += dl;
#pragma unroll
                for (int r = 0; r < 16; ++r) { pn0[r] -= dl; pn1[r] -= dl; }
                if (!ALIBI) {
#pragma unroll
                    for (int r = 0; r < 16; ++r) negm[r] = -mhat;
                }
                const float f = __builtin_amdgcn_exp2f(-dl); lsum *= f;
                { const int l_ = lane_now(); if (l_ < 32) wsf[l_] = f; }
                asm volatile("s_waitcnt lgkmcnt(0)" ::: "memory");
#pragma unroll
                for (int r = 0; r < 16; ++r) { const float fr_ = wsf[crow(r, hi)]; o[0][r] *= fr_; o[1][r] *= fr_; }
            }
            pc0 = pn0; pc1 = pn1;
        }
        have_cur = do_next;
    }
#undef ATT2_PC
    { float l = swapadd(lsum);
      if (EPI == 3) l += __builtin_amdgcn_exp2f(J.sink2 - mhat);
      if (EPI == 1) { if (hi == 0) J.LSE[(long)nq * J.ls] = mhat + __builtin_amdgcn_logf(l); }
      { const int l_ = lane_now(); if (l_ < 32) wsf[l_] = l > 0.f ? __builtin_amdgcn_rcpf(l) : 0.f; } }
    asm volatile("s_waitcnt lgkmcnt(0)" ::: "memory");
    { __hip_bfloat16* stg = (__hip_bfloat16*)(shm + P_LDS_OST) + wid * 2048;
#pragma unroll
      for (int r = 0; r < 16; ++r) { const int orow = crow(r, hi); const float rl = wsf[orow];
#pragma unroll
          for (int d0 = 0; d0 < 2; ++d0) stg[orow * 64 + d0 * 32 + r32] = __float2bfloat16(o[d0][r] * rl); }
      asm volatile("s_waitcnt lgkmcnt(0)" ::: "memory");
      bf16_t* Ow = J.O + (long)qw * J.os;
#pragma unroll
      for (int i = 0; i < 4; ++i) { const int row = i * 8 + (lane >> 3), ch = lane & 7; const u32x4 v = *(const u32x4*)((const bf16_t*)stg + row * 64 + ch * 8);
          *(u32x4*)(Ow + (long)row * J.os + ch * 8) = v; } }
    asm volatile("s_waitcnt lgkmcnt(0)\n\ts_barrier" ::: "memory");
#undef ATT2_DMA
}
}

namespace att {
constexpr int BW_LDS = 16384;
template <int EPI>
__device__ __forceinline__ void band_wave(const Job& J, char* wl, float* wsf, const int wid, const unsigned q_next, volatile __attribute__((address_space(3))) unsigned* qslot) {
    int lane_; asm volatile("v_mbcnt_lo_u32_b32 %0, -1, 0\n\tv_mbcnt_hi_u32_b32 %0, -1, %0" : "=v"(lane_));
    const int lane = lane_, r32 = lane & 31, hi = lane >> 5;
    const unsigned wl0 = (unsigned)(uintptr_t)wl;
    const int qw = J.q0 + wid * QBLK, nq = qw + r32;
    bf16x8 qr[4];
    { const bf16_t* qp = J.Q + (long)nq * J.qs + hi * 8;
#pragma unroll
      for (int c = 0; c < 4; ++c) qr[c] = *reinterpret_cast<const bf16x8*>(qp + c * 16); }
    const unsigned vlo = (unsigned)((lane >> 2) * J.vs * 2 + (lane & 3) * 16);
    const long klo = (long)r32 * J.ks0 + hi * 8;
    float mhat = -1000.f, lsum = 0.f; f32x16 o[2];
    float zero_ = 0.f; asm volatile("" : "+v"(zero_));
#pragma unroll
    for (int r = 0; r < 16; ++r) { o[0][r] = zero_; o[1][r] = zero_; }
    const lds_cptr wl3 = (lds_cptr)wl;
    const lds_cptr vp0 = wl3 + ((lane >> 4) & 1) * 32 + (lane & 3) * 8 + (4 * hi + ((lane & 15) >> 2)) * 64;
    bf16x8 kA[2][4], kB[2][4], kC[1][4];
#define BW_KB(s, jb) (qw - 128 + 64 * (s) + 32 * (jb))
#define BW_LOADK(dst, s, jb) do { const int kb_ = BW_KB(s, jb) > 0 ? BW_KB(s, jb) : 0; const bf16_t* kp_ = J.K0 + (long)kb_ * J.ks0 + klo; \
        _Pragma("unroll") for (int c = 0; c < 4; ++c) dst[jb][c] = *reinterpret_cast<const bf16x8*>(kp_ + c * 16); } while (0)
#define BW_DMAV(s, jb) do { const int kb_ = BW_KB(s, jb) > 0 ? BW_KB(s, jb) : 0; \
        _Pragma("unroll") for (int i = 0; i < 4; ++i) pg8::glds_s(vlo, (const char*)(J.V + (long)(kb_ + (i & 1) * 16) * J.vs + (i >> 1) * 32), wl0 + ((s) & 1) * 8192 + (jb) * 4096 + (i >> 1) * 2048 + (i & 1) * 1024); } while (0)
    BW_DMAV(0, 0); BW_DMAV(0, 1); BW_DMAV(1, 0); BW_DMAV(1, 1);
    BW_LOADK(kA, 0, 0); BW_LOADK(kA, 0, 1); BW_LOADK(kB, 1, 0); BW_LOADK(kB, 1, 1); BW_LOADK(kC, 2, 0);
#define BW_STEP(s, KF, NB) do { \
        if ((s) != 1) asm volatile("s_waitcnt vmcnt(0)" ::: "memory"); \
        if ((s) == 0 && wid == 0 && lane == 0) *qslot = q_next;       \
        const int kb0 = BW_KB(s, 0), dq = nq - kb0; \
        f32x16 p0, p1; \
        { const float L = -mhat - J.slope2 * (float)(dq - 4 * hi), L1 = L + 32.f * J.slope2; \
          _Pragma("unroll") for (int r = 0; r < 16; ++r) { float a_ = __builtin_fmaf(J.slope2, (float)crow(r, 0), L), b_ = __builtin_fmaf(J.slope2, (float)crow(r, 0), L1); asm("" : "+v"(a_)); asm("" : "+v"(b_)); p0[r] = a_; p1[r] = b_; } } \
        _Pragma("unroll") for (int c = 0; c < 4; ++c) { p0 = __builtin_amdgcn_mfma_f32_32x32x16_bf16(KF[0][c], qr[c], p0, 0, 0, 0); \
            if ((NB) == 2) p1 = __builtin_amdgcn_mfma_f32_32x32x16_bf16(KF[1][c], qr[c], p1, 0, 0, 0); } \
          \
        { const int lo = dq - J.max_dist; const bool v0 = kb0 >= 0, v1 = kb0 + 32 >= 0; \
          if ((s) == 0) { _Pragma("unroll") for (int r = 0; r < 16; ++r) { const int kl = crow(r, hi); if (kl < lo) p0[r] = NEGBIG; } \
              if ((NB) == 2 && J.max_dist < 97) { _Pragma("unroll") for (int r = 0; r < 16; ++r) { const int kl = crow(r, hi) + 32; if (kl < lo) p1[r] = NEGBIG; } } } \
          if ((s) == 2) { _Pragma("unroll") for (int r = 0; r < 16; ++r) { const int kl = crow(r, hi); if (kl > dq) p0[r] = NEGBIG; } } \
          if (!v0) { _Pragma("unroll") for (int r = 0; r < 16; ++r) p0[r] = NEGBIG; } \
          if ((NB) == 2 && !v1) { _Pragma("unroll") for (int r = 0; r < 16; ++r) p1[r] = NEGBIG; } } \
        float rm; \
        { float a = NEGBIG, b = NEGBIG; \
          _Pragma("unroll") for (int r = 0; r < 16; r += 2) { a = __builtin_fmaxf(__builtin_fmaxf(a, p0[r]), p0[r + 1]); if ((NB) == 2) b = __builtin_fmaxf(__builtin_fmaxf(b, p1[r]), p1[r + 1]); } \
          rm = swapmax(__builtin_fmaxf(a, b)); } \
        if (__any(rm > THR)) { const float dl = __builtin_fmaxf(rm, 0.f); mhat += dl; \
            _Pragma("unroll") for (int r = 0; r < 16; ++r) { p0[r] -= dl; p1[r] -= dl; } \
            const float f = __builtin_amdgcn_exp2f(-dl); lsum *= f; \
            if (hi == 0) wsf[r32] = f; \
            asm volatile("s_waitcnt lgkmcnt(0)" ::: "memory"); \
            _Pragma("unroll") for (int r = 0; r < 16; ++r) { const float fr_ = wsf[crow(r, hi)]; o[0][r] *= fr_; o[1][r] *= fr_; } } \
        u32x4 pw[4]; float sacc = 0.f; \
        _Pragma("unroll") for (int r = 0; r < 16; ++r) { float x_ = __builtin_amdgcn_exp2f(p0[r]); asm("" : "+v"(x_)); p0[r] = x_; sacc += x_; if ((NB) == 2) { float y_ = __builtin_amdgcn_exp2f(p1[r]); asm("" : "+v"(y_)); p1[r] = y_; sacc += y_; } } \
        lsum += sacc; \
        pw[0] = (u32x4){cvtpk(p0[0], p0[1]), cvtpk(p0[2], p0[3]), cvtpk(p0[4], p0[5]), cvtpk(p0[6], p0[7])}; \
        pw[1] = (u32x4){cvtpk(p0[8], p0[9]), cvtpk(p0[10], p0[11]), cvtpk(p0[12], p0[13]), cvtpk(p0[14], p0[15])}; \
        if ((NB) == 2) { pw[2] = (u32x4){cvtpk(p1[0], p1[1]), cvtpk(p1[2], p1[3]), cvtpk(p1[4], p1[5]), cvtpk(p1[6], p1[7])}; \
            pw[3] = (u32x4){cvtpk(p1[8], p1[9]), cvtpk(p1[10], p1[11]), cvtpk(p1[12], p1[13]), cvtpk(p1[14], p1[15])}; } \
        const lds_cptr vp = vp0 + ((s) & 1) * 8192; \
        _Pragma("unroll") for (int d0 = 0; d0 < 2; ++d0) _Pragma("unroll") for (int g = 0; g < 2 * (NB); ++g) { \
            const s16x4 vl = vtr(vp + (g >> 1) * 4096 + d0 * 2048 + (g & 1) * 1024), vh = vtr(vp + (g >> 1) * 4096 + d0 * 2048 + (g & 1) * 1024 + 512); \
            const bf16x8 vf = (bf16x8){vl[0], vl[1], vl[2], vl[3], vh[0], vh[1], vh[2], vh[3]}; \
            o[d0] = __builtin_amdgcn_mfma_f32_32x32x16_bf16(__builtin_bit_cast(bf16x8, pw[g]), vf, o[d0], 0, 0, 0); } \
        if ((s) == 0) { asm volatile("s_waitcnt lgkmcnt(0)" ::: "memory"); BW_DMAV(2, 0); } \
    } while (0)
    BW_STEP(0, kA, 2);
    BW_STEP(1, kB, 2);
    BW_STEP(2, kC, 1);
#undef BW_STEP
#undef BW_LOADK
#undef BW_DMAV
#undef BW_KB
    { float l = swapadd(lsum);
      if (EPI == 3) l += __builtin_amdgcn_exp2f(J.sink2 - mhat);
      if (EPI == 1) { if (hi == 0) J.LSE[(long)nq * J.ls] = mhat + __builtin_amdgcn_logf(l); }
      if (hi == 0) wsf[r32] = l > 0.f ? __builtin_amdgcn_rcpf(l) : 0.f; }
    asm volatile("s_waitcnt lgkmcnt(0)" ::: "memory");
    { __hip_bfloat16* stg = (__hip_bfloat16*)(wl + 8192);
#pragma unroll
      for (int r = 0; r < 16; ++r) { const int orow = crow(r, hi); const float rl = wsf[orow];
#pragma unroll
          for (int d0 = 0; d0 < 2; ++d0) stg[orow * 64 + d0 * 32 + r32] = __float2bfloat16(o[d0][r] * rl); }
      asm volatile("s_waitcnt lgkmcnt(0)" ::: "memory");
      bf16_t* Ow = J.O + (long)qw * J.os;
#pragma unroll
      for (int i = 0; i < 4; ++i) { const int row = i * 8 + (lane >> 3), ch = lane & 7; const u32x4 v = *(const u32x4*)((const bf16_t*)stg + row * 64 + ch * 8);
          *(u32x4*)(Ow + (long)row * J.os + ch * 8) = v; } }
    asm volatile("s_waitcnt lgkmcnt(0)" ::: "memory");
}
}
#ifndef MK_PER_PHASE
#define MK_PER_PHASE 0
#endif
constexpr int NWAVES = 8;
constexpr int NB = 4, S = 8192, T = NB * S, D = 1024;
constexpr int NQKV = 2592, NQKVP = 2816;
constexpr int FF = 2816, FE = 3584, NEXP = 8;
constexpr float RMS_EPS = 1e-6f;
#ifndef FFN8
#define FFN8 3
#endif
constexpr float LOG2E = 1.4426950408889634f;
constexpr float MOE_WSCALE = 64.0f;
constexpr int C_QA = 0, C_KA = 256, C_VA = 512, C_QB = 768, C_KB = 1024, C_VB = 1280, C_QD = 1536, C_KD = 1792, C_VD = 1920, C_CQ = 2048, C_CKV = 2432, C_KPE = 2560;

constexpr size_t MiB = 1u << 20;
constexpr size_t WS_CTL = 0, CTL_ZERO_BYTES = 1 * MiB;
constexpr size_t WS_ROPE = 1 * MiB;
constexpr size_t WS_WIN = 2 * MiB, WIN_L = (size_t)NQKVP * D * 2;
constexpr size_t WS_WOUT = 13 * MiB, WOUT_L = (size_t)D * D * 2;
constexpr size_t WS_WUQ = 17 * MiB, WUQ_L = (size_t)512 * 384 * 2;
constexpr size_t WS_WUKV = 17 * MiB + 768 * 1024, WUKV_L = (size_t)512 * 128 * 2;
constexpr size_t WS_W13 = 18 * MiB, WS_W2 = 29 * MiB;
constexpr size_t WS_R1 = 35 * MiB;
constexpr size_t WS_QKV = 99 * MiB, WS_QM = 261 * MiB, WS_KVM = 285 * MiB, WS_OB = 317 * MiB, OB_L = (size_t)T * 256 * 2, WS_LSE = 365 * MiB, LSE_L = (size_t)T * 4 * 4;
constexpr size_t WS_PA = 367 * MiB, WS_PC = 431 * MiB, WS_LA = 463 * MiB, WS_LC = 465 * MiB;
constexpr size_t WS_XB = 440 * MiB, WS_SSQ = 505 * MiB;
constexpr size_t WS_G = 99 * MiB;
constexpr size_t WS_MW13 = 99 * MiB, WS_MW2 = 211 * MiB, WS_GM = 267 * MiB, GM_L = (size_t)64 * 256 * FE  , WS_Y = 379 * MiB;
constexpr size_t WS_RT = 511 * MiB, RT_SEL = 0, RT_GATE = 256 * 1024, RT_POS = 512 * 1024, RT_TOK = 768 * 1024, RT_BLK = 1280 * 1024;
constexpr size_t WS_SSQ2 = 513 * MiB;
constexpr size_t WS_END = 515 * MiB;
static_assert(WS_WIN + 2 * WIN_L <= WS_WOUT && WS_WOUT + 2 * WOUT_L <= WS_WUQ && WS_WUQ + 2 * WUQ_L <= WS_WUKV && WS_WUKV + 2 * WUKV_L <= WS_W13, "ws map 1");
static_assert(WS_W13 + (size_t)2 * FF * D * 2 <= WS_W2 && WS_W2 + (size_t)D * FF * 2 <= WS_R1 && WS_R1 + (size_t)T * D * 2 <= WS_QKV, "ws map 2");
static_assert(WS_QKV + (size_t)T * NQKV * 2 <= WS_QM && WS_QM + (size_t)T * 384 * 2 <= WS_KVM && WS_KVM + (size_t)T * 512 * 2 <= WS_OB && WS_OB + 3 * OB_L <= WS_LSE && WS_LSE + 3 * LSE_L <= WS_RT, "ws map 3");
static_assert(WS_G + (size_t)T * FF * 2 <= WS_XB && WS_XB + (size_t)T * D * 2 <= WS_SSQ && WS_SSQ + (size_t)T * 16 * 4 <= WS_RT, "ws map 4");
static_assert(WS_LSE + 3 * LSE_L <= WS_PA && WS_PA + 4 * OB_L <= WS_PC && WS_PC + 2 * OB_L <= WS_LA && WS_LA + 4 * LSE_L <= WS_LC && WS_LC + 2 * LSE_L <= WS_RT, "ws map 6");
static_assert(WS_MW13 + (size_t)NEXP * 2 * FE * D <= WS_MW2 && WS_MW2 + (size_t)NEXP * D * FE <= WS_GM && WS_GM + 2 * GM_L <= WS_Y && WS_Y + (size_t)264 * 256 * D * 2 <= WS_RT, "ws map 5");
constexpr int CW_TMO = 0, CW_CODE = 1;
constexpr int CW_BAR = 4096;
constexpr int CW_Q = 120000;
constexpr int CW_HIST = 122000;
constexpr int CW_KMAX = 124160;
constexpr int CW_KMAXC = CW_KMAX + 64;
constexpr int CW_RDY = CW_KMAX + 140;
constexpr int CW_KPE = CW_KMAX + 128;
static_assert(CW_HIST + 256 * 8 <= CW_KMAX && (CW_KMAX + 144) * 4 <= (int)CTL_ZERO_BYTES, "CTL words inside the memset region");

constexpr int RING_OFF = 0, RING_BYTES = 131072;
constexpr int LDSCTL_OFF = RING_BYTES, MISC_OFF = LDSCTL_OFF + 320;
constexpr int LDS_BYTES = 147456;

#define GAS __attribute__((address_space(1)))
#define LAS __attribute__((address_space(3)))
typedef unsigned short bf16;
typedef unsigned v4u __attribute__((ext_vector_type(4)));
typedef unsigned v2u __attribute__((ext_vector_type(2)));
typedef float f32x4 __attribute__((ext_vector_type(4)));
typedef float f32x2 __attribute__((ext_vector_type(2)));
typedef GAS unsigned gu32;
#define RLX_AGENT __ATOMIC_RELAXED, __HIP_MEMORY_SCOPE_AGENT
#define LDS_WAIT() asm volatile("s_waitcnt lgkmcnt(0)" ::: "memory")
#define VM_WAIT() asm volatile("s_waitcnt vmcnt(0)" ::: "memory")
__device__ __forceinline__ unsigned f2bf(float f) { unsigned u = __builtin_bit_cast(unsigned, f); return (u + 0x7fffu + ((u >> 16) & 1u)) >> 16; }
__device__ __forceinline__ unsigned pk2(float lo, float hi) { return f2bf(lo) | (f2bf(hi) << 16); }
__device__ __forceinline__ float bflo(unsigned w) { return __uint_as_float(w << 16); }
__device__ __forceinline__ float bfhi(unsigned w) { return __uint_as_float(w & 0xffff0000u); }

#define XB_TMO      128
#define XB_XCNT(j)  (256  + 64 * (j))
#define XB_XSUB(j)  (1280 + 64 * (j))
#define XB_XGEN(j)  (2304 + 64 * (j))
#define XB_TOP      3328
#define XB_TOPGEN   3392
#define XCD_BAR_WORDS 3456
#define XB_SPIN_CAP (1u << 18)
__device__ __forceinline__ unsigned xb_ld(unsigned* p)              { return __hip_atomic_load(p, __ATOMIC_RELAXED, __HIP_MEMORY_SCOPE_AGENT); }
__device__ __forceinline__ unsigned xb_add(unsigned* p, unsigned v) { return __hip_atomic_fetch_add(p, v, __ATOMIC_RELAXED, __HIP_MEMORY_SCOPE_AGENT); }
__device__ __forceinline__ unsigned xb_xcc_id() { return (unsigned)__builtin_amdgcn_s_getreg((3 << 11) | 20) & 0xFu; }
#define XB_SPIN(cond, bar) do { unsigned _sp = 0; while (cond) { __builtin_amdgcn_s_sleep(1); \
    if ((++_sp & 255u) == 0u) { if (xb_ld(&(bar)[XB_TMO])) break; if (_sp > XB_SPIN_CAP) { atomicAdd(&(bar)[XB_TMO], 1u); break; } } } } while (0)
struct XcdBarrier { unsigned* bar; unsigned x; volatile LAS unsigned* st; };
__device__ __forceinline__ XcdBarrier xcd_barrier_post(unsigned* bar, volatile LAS unsigned* st) {
    XcdBarrier b; b.bar = bar; b.x = xb_xcc_id(); b.st = st;
    if (threadIdx.x == 0) (void)xb_add(&bar[XB_XCNT(b.x)], 1u);
    return b;
}
__device__ __forceinline__ void xcd_barrier_complete(unsigned* bar, unsigned x, unsigned& nloc, unsigned& nx) {
    const unsigned G = gridDim.x * gridDim.y * gridDim.z;
    unsigned sum, cnt, mine, sp = 0u;
    for (;;) {
        sum = 0u; cnt = 0u; mine = 0u;
#pragma unroll
        for (unsigned j = 0; j < 16; ++j) { const unsigned c = xb_ld(&bar[XB_XCNT(j)]); sum += c; cnt += (c > 0u) ? 1u : 0u; mine = (j == x) ? c : mine; }
        if (sum == G) break;
        __builtin_amdgcn_s_sleep(1);
        if ((++sp & 255u) == 0u) { if (xb_ld(&bar[XB_TMO])) break; if (sp > XB_SPIN_CAP) { atomicAdd(&bar[XB_TMO], 1u); break; } }
    }
    nloc = mine > 0u ? mine : 1u; nx = cnt > 0u ? cnt : 1u;
}
__device__ __forceinline__ void xcd_barrier(const XcdBarrier& b) {
    asm volatile("s_waitcnt vmcnt(0)" ::: "memory");
    __syncthreads();
    if (threadIdx.x == 0) {
        unsigned* bar = b.bar;
        __builtin_amdgcn_s_waitcnt(0);
        unsigned nloc = b.st[0], nx = b.st[1];
        if (nloc == 0u) { xcd_barrier_complete(bar, b.x, nloc, nx); b.st[0] = nloc; b.st[1] = nx; }
        const unsigned old = xb_add(&bar[XB_XSUB(b.x)], 1u);
        const unsigned gen = old / nloc;
        if (old + 1u == (gen + 1u) * nloc) {
            __builtin_amdgcn_fence(__ATOMIC_RELEASE, "agent");
            asm volatile("s_waitcnt vmcnt(0)" ::: "memory");
            const unsigned og = xb_add(&bar[XB_TOP], 1u);
            const unsigned tg = og / nx;
            if (og + 1u == (tg + 1u) * nx) xb_add(&bar[XB_TOPGEN], 1u);
            else XB_SPIN(xb_ld(&bar[XB_TOPGEN]) == tg, bar);
            __builtin_amdgcn_fence(__ATOMIC_ACQUIRE, "agent");
            xb_add(&bar[XB_XGEN(b.x)], 1u);
            asm volatile("s_waitcnt vmcnt(0)" ::: "memory");
        } else {
            XB_SPIN(xb_ld(&bar[XB_XGEN(b.x)]) == gen, bar);
            __builtin_amdgcn_fence(__ATOMIC_ACQUIRE, "agent");
            asm volatile("s_waitcnt vmcnt(0)" ::: "memory");
        }
    }
    __syncthreads();
}

struct Frame {
    LAS unsigned char* lds;
    volatile LAS unsigned* MISC;
    int tid, lane, wave, vcu, G, bx;
};
#define CAS __attribute__((address_space(4)))
__device__ __forceinline__ const CAS char* kargs() { const CAS char* p = (const CAS char*)__builtin_amdgcn_kernarg_segment_ptr(); asm volatile("" : "+s"(p)); return p; }
__device__ __forceinline__ const float* gin(int k) { return *(const float* const CAS*)(kargs() + 8 * k); }
__device__ __forceinline__ float* gout() { return *(float* const CAS*)(kargs() + 160); }
__device__ __forceinline__ unsigned char* gws() { return *(unsigned char* const CAS*)(kargs() + 168); }
__device__ __forceinline__ gu32* gctl() { return (gu32*)gws(); }
__device__ __forceinline__ float wave_sum(float v, int lane) {
#pragma unroll
    for (int o = 1; o < 64; o <<= 1) v += __int_as_float(__builtin_amdgcn_ds_bpermute((lane ^ o) << 2, __float_as_int(v)));
    return v;
}

__device__ __forceinline__ void wmap(int kind, int aux, int n, int& drow, float& sc) {
    sc = 1.f; drow = n + aux;
    if (kind == 1) {
        if (n < 1536) { drow = n; if (n < 256) sc = 0.17677669529663687f * LOG2E; else if (n >= 768 && n < 1024) sc = 0.125f * LOG2E; }
        else if (n < 2048) drow = n + 512;
        else if (n < 2080) { const int j = n - 2048; drow = C_KPE + (j < 16 ? 2 * j : 2 * (j - 16) + 1); }
        else { drow = n - 544; if (n < 2336) sc = 0.125f * LOG2E; }
    } else if (kind == 2) {
        const int h = n / 96, dd = n % 96; sc = 0.10206207261596575f * LOG2E;
        drow = (dd < 64) ? n : h * 96 + 64 + ((dd - 64) < 16 ? 2 * (dd - 64) : 2 * (dd - 80) + 1);
    } else if (kind == 3) {
        drow = (n >> 7) * 256 + aux * 128 + (n & 127);
    }
}
__device__ __forceinline__ void tr_item(const float* W, int K, int N, bf16* WT, LAS float* scr, int item, int lane, int kind, int aux, const float* kscale = nullptr) {
    const int nblk = N / 32, kb = item / nblk, nb = item % nblk, k0 = 64 * kb, n0 = 32 * nb;
    float wv[32];
#pragma unroll
    for (int i = 0; i < 32; ++i) { const int kk = 2 * i + (lane >> 5); wv[i] = __builtin_nontemporal_load(W + (size_t)(k0 + kk) * N + n0 + (lane & 31)); }
#pragma unroll
    for (int i = 0; i < 32; ++i) { const int kk = 2 * i + (lane >> 5); scr[kk * 33 + (lane & 31)] = wv[i]; }
    LDS_WAIT(); asm volatile("" ::: "memory");
    const int c = lane & 7;
    float kg[8];
#pragma unroll
    for (int e = 0; e < 8; ++e) kg[e] = kscale ? kscale[k0 + 8 * c + e] : 1.0f;
#pragma unroll
    for (int j = 0; j < 4; ++j) { const int n = (lane >> 3) + 8 * j; const LAS float* s = scr + (8 * c) * 33 + n; int drow; float sc; wmap(kind, aux, n0 + n, drow, sc);
        float ks[8];
#pragma unroll
        for (int e = 0; e < 8; ++e) ks[e] = sc * kg[e];
        v4u o; o.x = pk2(s[0 * 33] * ks[0], s[1 * 33] * ks[1]); o.y = pk2(s[2 * 33] * ks[2], s[3 * 33] * ks[3]); o.z = pk2(s[4 * 33] * ks[4], s[5 * 33] * ks[5]); o.w = pk2(s[6 * 33] * ks[6], s[7 * 33] * ks[7]);
        *(GAS v4u*)(WT + (size_t)drow * K + k0 + 8 * c) = o; }
    LDS_WAIT(); asm volatile("" ::: "memory");
}
__device__ __forceinline__ void tr_item8(const float* W, int K, int N, unsigned char* WT, LAS float* scr, int item, int lane, int kind, int aux, float scale, const float* kscale = nullptr) {
    const int nblk = N / 32, kb = item / nblk, nb = item % nblk, k0 = 64 * kb, n0 = 32 * nb;
    float wv[32];
#pragma unroll
    for (int i = 0; i < 32; ++i) { const int kk = 2 * i + (lane >> 5); wv[i] = __builtin_nontemporal_load(W + (size_t)(k0 + kk) * N + n0 + (lane & 31)); }
#pragma unroll
    for (int i = 0; i < 32; ++i) { const int kk = 2 * i + (lane >> 5); scr[kk * 33 + (lane & 31)] = wv[i]; }
    LDS_WAIT(); asm volatile("" ::: "memory");
    const int c = lane & 7;
#pragma unroll
    for (int j = 0; j < 4; ++j) { const int n = (lane >> 3) + 8 * j; const LAS float* s = scr + (8 * c) * 33 + n; int drow; float sc; wmap(kind, aux, n0 + n, drow, sc); sc *= scale;
        float ks[8];
#pragma unroll
        for (int e = 0; e < 8; ++e) ks[e] = kscale ? sc * kscale[k0 + 8 * c + e] : sc;
        int w0 = __builtin_amdgcn_cvt_pk_fp8_f32(s[0 * 33] * ks[0], s[1 * 33] * ks[1], 0, false); w0 = __builtin_amdgcn_cvt_pk_fp8_f32(s[2 * 33] * ks[2], s[3 * 33] * ks[3], w0, true);
        int w1 = __builtin_amdgcn_cvt_pk_fp8_f32(s[4 * 33] * ks[4], s[5 * 33] * ks[5], 0, false); w1 = __builtin_amdgcn_cvt_pk_fp8_f32(s[6 * 33] * ks[6], s[7 * 33] * ks[7], w1, true);
        *(GAS v2u*)(WT + (size_t)drow * K + k0 + 8 * c) = (v2u){(unsigned)w0, (unsigned)w1}; }
    LDS_WAIT(); asm volatile("" ::: "memory");
}
__device__ __forceinline__ void row_load(const float* xrow, int lane, f32x4 (&v)[4]) {
    const GAS f32x4* xr = (const GAS f32x4*)xrow + lane;
#pragma unroll
    for (int j = 0; j < 4; ++j) v[j] = xr[64 * j];
}
__device__ __forceinline__ void rms_fin(const f32x4 (&gn)[4], bf16* orow, int lane, f32x4 (&v)[4]) {
    float s = 0.f;
#pragma unroll
    for (int j = 0; j < 4; ++j) s += (v[j].x * v[j].x + v[j].y * v[j].y) + (v[j].z * v[j].z + v[j].w * v[j].w);
    const float r = 1.0f / sqrtf(wave_sum(s, lane) * (1.f / D) + RMS_EPS);
    GAS unsigned long long* o8 = (GAS unsigned long long*)orow + lane;
#pragma unroll
    for (int j = 0; j < 4; ++j) { v[j] = v[j] * r * gn[j]; o8[64 * j] = (unsigned long long)pk2(v[j].x, v[j].y) | ((unsigned long long)pk2(v[j].z, v[j].w) << 32); }
}
__device__ __forceinline__ void rms_fin8(const f32x4 (&gn)[4], unsigned char* orow, int lane, f32x4 (&v)[4]) {
    float s = 0.f;
#pragma unroll
    for (int j = 0; j < 4; ++j) s += (v[j].x * v[j].x + v[j].y * v[j].y) + (v[j].z * v[j].z + v[j].w * v[j].w);
    const float r = 1.0f / sqrtf(wave_sum(s, lane) * (1.f / D) + RMS_EPS);
    GAS int* o4 = (GAS int*)orow + lane;
#pragma unroll
    for (int j = 0; j < 4; ++j) { v[j] = v[j] * r * gn[j]; int w = __builtin_amdgcn_cvt_pk_fp8_f32(v[j].x, v[j].y, 0, false); w = __builtin_amdgcn_cvt_pk_fp8_f32(v[j].z, v[j].w, w, true); o4[64 * j] = w; }
}
__device__ __forceinline__ void load_gain(const float* g, int lane, f32x4 (&gn)[4]) {
#pragma unroll
    for (int j = 0; j < 4; ++j) gn[j] = *((const GAS f32x4*)g + lane + 64 * j);
}
__device__ __forceinline__ void norm_rows(Frame& F, const float* x, const float* gain, bf16* out) {
    f32x4 gn[4]; load_gain(gain, F.lane, gn);
    const int r0 = F.bx * (T / 256) + F.wave * 16;
    f32x4 cur[4], nxt[4], nx2[4]; row_load(x + (size_t)r0 * D, F.lane, cur); row_load(x + (size_t)(r0 + 1) * D, F.lane, nxt);
    for (int i = 0; i < 16; ++i) { if (i + 2 < 16) row_load(x + (size_t)(r0 + i + 2) * D, F.lane, nx2);
        rms_fin(gn, out + (size_t)(r0 + i) * D, F.lane, cur);
#pragma unroll
        for (int j = 0; j < 4; ++j) { cur[j] = nxt[j]; nxt[j] = nx2[j]; } }
}

__device__ __forceinline__ void p0_prologue(Frame& F) {
    LAS float* scr = (LAS float*)(F.lds + RING_OFF + F.wave * 16384);
    const int gw = F.vcu * NWAVES + F.wave, NGW = F.G * NWAVES;
    constexpr int I_IN = 16 * 81, I_OUT = 16 * 32, I_UQ = 6 * 12, I_UKV = 2 * 16, I_L = I_IN + I_OUT + I_UQ + I_UKV, I_F = 16 * 88, I_F2 = 44 * 32;
    constexpr int NITEMS = 2 * I_L + 2 * I_F + I_F2;
    unsigned char* ws = gws();
    for (int it = gw; it < NITEMS; it += NGW) {
        int r = it;
        if (r < 2 * I_L) { const int l = r / I_L; r -= l * I_L;
            if (r < I_IN) { tr_item(gin(2) + (size_t)l * D * NQKV, D, NQKV, (bf16*)(ws + WS_WIN + l * WIN_L), scr, r, F.lane, 1, 0, l == 1 ? gin(1) + D : nullptr); continue; } r -= I_IN;
            if (r < I_OUT) { tr_item(gin(3) + (size_t)l * D * D, D, D, (bf16*)(ws + WS_WOUT + l * WOUT_L), scr, r, F.lane, 0, 0); continue; } r -= I_OUT;
            if (r < I_UQ) { tr_item(gin(7) + (size_t)l * 384 * 384, 384, 384, (bf16*)(ws + WS_WUQ + l * WUQ_L), scr, r, F.lane, 2, 0, gin(6) + l * 384); continue; } r -= I_UQ;
            tr_item(gin(9) + (size_t)l * 128 * 512, 128, 512, (bf16*)(ws + WS_WUKV + l * WUKV_L), scr, r, F.lane, 0, 0, gin(8) + l * 128); continue; }
        r -= 2 * I_L;
#if FFN8 == 1 || FFN8 == 2
        if (r < I_F) { tr_item8(gin(12), D, FF, ws + WS_W13, scr, r, F.lane, 3, 0, MOE_WSCALE, gin(11)); continue; } r -= I_F;
        if (r < I_F) { tr_item8(gin(13), D, FF, ws + WS_W13, scr, r, F.lane, 3, 1, MOE_WSCALE, gin(11)); continue; } r -= I_F;
#else
        if (r < I_F) { tr_item(gin(12), D, FF, (bf16*)(ws + WS_W13), scr, r, F.lane, 3, 0, gin(11)); continue; } r -= I_F;
        if (r < I_F) { tr_item(gin(13), D, FF, (bf16*)(ws + WS_W13), scr, r, F.lane, 3, 1, gin(11)); continue; } r -= I_F;
#endif
#if FFN8 == 1 || FFN8 == 3
        tr_item8(gin(14), FF, D, ws + WS_W2, scr, r, F.lane, 0, 0, MOE_WSCALE);
#else
        tr_item(gin(14), FF, D, (bf16*)(ws + WS_W2), scr, r, F.lane, 0, 0);
#endif
    }
    { const int gt = (F.vcu * NWAVES + F.wave) * 64 + F.lane, NGT = NGW * 64; const v4u z = {0u, 0u, 0u, 0u};
      for (int l = 0; l < 2; ++l) {
        GAS v4u* p = (GAS v4u*)(ws + WS_WIN + l * WIN_L + (size_t)NQKV * D * 2); const int n1 = (NQKVP - NQKV) * D * 2 / 16;
        for (int i = gt; i < n1; i += NGT) p[i] = z;
        GAS v4u* q = (GAS v4u*)(ws + WS_WUQ + l * WUQ_L + (size_t)384 * 384 * 2); const int n2 = 128 * 384 * 2 / 16;
        for (int i = gt; i < n2; i += NGT) q[i] = z; }
      const double invf[16] = {0.15915494309189535, 0.08949940160889101, 0.050329212104487035, 0.0283021958306234, 0.015915494309189534, 0.008949940160889102, 0.005032921210448704, 0.00283021958306234,
                               0.0015915494309189536, 0.0008949940160889102, 0.0005032921210448703, 0.00028302195830623395, 0.00015915494309189535, 8.949940160889102e-05, 5.0329212104487035e-05, 2.8302195830623396e-05};
      GAS f32x2* rt = (GAS f32x2*)(ws + WS_ROPE);
      for (int i = gt; i < S * 16; i += NGT) { const int pos = i >> 4, j = i & 15; double f = invf[0];
#pragma unroll
          for (int q = 1; q < 16; ++q) f = (j == q) ? invf[q] : f;
          const double rev = (double)pos * f; const float fr = (float)(rev - __builtin_floor(rev));
          rt[i] = (f32x2){__builtin_amdgcn_cosf(fr), __builtin_amdgcn_sinf(fr)}; } }
    norm_rows(F, gin(0), gin(1), (bf16*)(ws + WS_R1));
}
__device__ __forceinline__ void moe_weights(Frame& F) {
    LAS float* scr = (LAS float*)(F.lds + RING_OFF + F.wave * 16384);
    const int gw = F.vcu * NWAVES + F.wave, NGW = F.G * NWAVES;
    constexpr int I_U = 16 * 112, I_D = 56 * 32, I_E = 2 * I_U + I_D, NITEMS = NEXP * I_E;
    for (int it = gw; it < NITEMS; it += NGW) { const int e = it / I_E; int r = it - e * I_E;
        unsigned char* w13 = gws() + WS_MW13 + (size_t)e * 2 * FE * D; unsigned char* w2 = gws() + WS_MW2 + (size_t)e * D * FE;
        if (r < I_U) { tr_item8(gin(16) + (size_t)e * D * FE, D, FE, w13, scr, r, F.lane, 3, 0, MOE_WSCALE); continue; } r -= I_U;
        if (r < I_U) { tr_item8(gin(17) + (size_t)e * D * FE, D, FE, w13, scr, r, F.lane, 3, 1, MOE_WSCALE); continue; } r -= I_U;
        tr_item8(gin(18) + (size_t)e * FE * D, FE, D, w2, scr, r, F.lane, 0, 0, MOE_WSCALE); }
}

__device__ __forceinline__ void mla_prep(Frame& F, int layer) {
    bf16* qkv = (bf16*)(gws() + WS_QKV); const GAS f32x2* rope = (const GAS f32x2*)(gws() + WS_ROPE);
    const int lane = F.lane;
    const int r0 = F.bx * (T / 256) + F.wave * 16;
    float kpm = 0.f;
    float kmx = 0.f;
    for (int i0 = 0; i0 < 16; i0 += 4) { v2u kw4[4]; v4u kp4[4]; f32x2 cs4[4][4];
#pragma unroll
        for (int k = 0; k < 4; ++k) { const int row = r0 + i0 + k; kw4[k] = *((const GAS v2u*)(qkv + (size_t)row * NQKV + C_KA) + lane);
            if (lane < 4) { kp4[k] = *((const GAS v4u*)(qkv + (size_t)row * NQKV + C_KPE) + lane); const GAS f32x2* rt = rope + (size_t)(row & (S - 1)) * 16 + lane * 4; cs4[k][0] = rt[0]; cs4[k][1] = rt[1]; cs4[k][2] = rt[2]; cs4[k][3] = rt[3]; } }
#pragma unroll
        for (int k = 0; k < 4; ++k) { const int row = r0 + i0 + k;
            { const v2u kw = kw4[k]; const float k0 = bflo(kw.x), k1 = bfhi(kw.x), k2 = bflo(kw.y), k3 = bfhi(kw.y);
              float s2 = (k0 * k0 + k1 * k1) + (k2 * k2 + k3 * k3);
#pragma unroll
              for (int o_ = 1; o_ < 8; o_ <<= 1) s2 += __int_as_float(__builtin_amdgcn_ds_bpermute((lane ^ o_) << 2, __float_as_int(s2)));
              kmx = fmaxf(kmx, s2); }
            if (lane < 4) { GAS v4u* kp = (GAS v4u*)(qkv + (size_t)row * NQKV + C_KPE) + lane; const v4u k_ = kp4[k];
                const f32x2 c0 = cs4[k][0], c1 = cs4[k][1], c2 = cs4[k][2], c3 = cs4[k][3]; v4u ko;
                { const float a = bflo(k_.x), b = bfhi(k_.x); ko.x = pk2(a * c0.x - b * c0.y, b * c0.x + a * c0.y); }
                { const float a = bflo(k_.y), b = bfhi(k_.y); ko.y = pk2(a * c1.x - b * c1.y, b * c1.x + a * c1.y); }
                { const float a = bflo(k_.z), b = bfhi(k_.z); ko.z = pk2(a * c2.x - b * c2.y, b * c2.x + a * c2.y); }
                { const float a = bflo(k_.w), b = bfhi(k_.w); ko.w = pk2(a * c3.x - b * c3.y, b * c3.x + a * c3.y); }
                *kp = ko;
                float s2 = ((bflo(ko.x) * bflo(ko.x) + bfhi(ko.x) * bfhi(ko.x)) + (bflo(ko.y) * bflo(ko.y) + bfhi(ko.y) * bfhi(ko.y))) + ((bflo(ko.z) * bflo(ko.z) + bfhi(ko.z) * bfhi(ko.z)) + (bflo(ko.w) * bflo(ko.w) + bfhi(ko.w) * bfhi(ko.w)));
                s2 += __int_as_float(__builtin_amdgcn_ds_bpermute((lane ^ 1) << 2, __float_as_int(s2))); s2 += __int_as_float(__builtin_amdgcn_ds_bpermute((lane ^ 2) << 2, __float_as_int(s2)));
                kpm = fmaxf(kpm, s2); } } }
    if (lane == 0) __hip_atomic_fetch_max((unsigned*)gctl() + CW_KPE + layer * 4 + (r0 >> 13), __float_as_uint(kpm), __ATOMIC_RELAXED, __HIP_MEMORY_SCOPE_AGENT);
    if ((lane & 7) == 0) __hip_atomic_fetch_max((unsigned*)gctl() + CW_KMAX + layer * 32 + (r0 >> 13) * 8 + (lane >> 3), __float_as_uint(kmx), __ATOMIC_RELAXED, __HIP_MEMORY_SCOPE_AGENT);
}

__device__ __forceinline__ float xsum16(float v, int lane) {
#pragma unroll
    for (int o_ = 1; o_ < 16; o_ <<= 1) v += __int_as_float(__builtin_amdgcn_ds_bpermute((lane ^ o_) << 2, __float_as_int(v)));
    return v;
}
__device__ __forceinline__ void merge2(const bf16* pa, const bf16* pb, float la, float lb, bool two, int lane, float (&o)[4]) {
    const v2u a = *((const GAS v2u*)pa + lane); float w0 = 1.f, w1 = 0.f; v2u b = {0u, 0u};
    if (two) { b = *((const GAS v2u*)pb + lane); const float mx = fmaxf(la, lb); w0 = __builtin_amdgcn_exp2f(la - mx); w1 = __builtin_amdgcn_exp2f(lb - mx); const float inv = 1.0f / (w0 + w1); w0 *= inv; w1 *= inv; }
    o[0] = w0 * bflo(a.x) + w1 * bflo(b.x); o[1] = w0 * bfhi(a.x) + w1 * bfhi(b.x); o[2] = w0 * bflo(a.y) + w1 * bflo(b.y); o[3] = w0 * bfhi(a.y) + w1 * bfhi(b.y);
}
__device__ __forceinline__ void merge2r(const v2u a, const v2u b, float la, float lb, bool two, float (&o)[4]) {
    float w0 = 1.f, w1 = 0.f;
    if (two) { const float mx = fmaxf(la, lb); w0 = __builtin_amdgcn_exp2f(la - mx); w1 = __builtin_amdgcn_exp2f(lb - mx); const float inv = 1.0f / (w0 + w1); w0 *= inv; w1 *= inv; }
    o[0] = w0 * bflo(a.x) + w1 * bflo(b.x); o[1] = w0 * bfhi(a.x) + w1 * bfhi(b.x); o[2] = w0 * bflo(a.y) + w1 * bflo(b.y); o[3] = w0 * bfhi(a.y) + w1 * bfhi(b.y);
}
__device__ __forceinline__ void attn_combine(Frame& F, int layer) {
    const bf16* ob = (const bf16*)(gws() + WS_OB); const float* lse = (const float*)(gws() + WS_LSE); bf16* o = (bf16*)(gws() + WS_R1);
    const bf16* pa = (const bf16*)(gws() + WS_PA); const bf16* pc = (const bf16*)(gws() + WS_PC); const float* la = (const float*)(gws() + WS_LA); const float* lc = (const float*)(gws() + WS_LC);
    const int lane = F.lane, h = lane >> 4; const int r0 = F.bx * (T / 256) + F.wave * 16;
    float lam, osc;
    { const float* lp = gin(4) + layer * 128; float a = 0.f, b = 0.f;
      if (lane < 32) { a = lp[lane] * lp[32 + lane]; b = lp[64 + lane] * lp[96 + lane]; }
      a = wave_sum(a, lane); b = wave_sum(b, lane);
      const float lam_init = 0.8f - 0.6f * __expf(-0.3f * (float)layer); lam = __expf(a) - __expf(b) + lam_init; osc = 1.0f - lam_init; }
    const f32x4 sg = *((const GAS f32x4*)(gin(5) + layer * 64) + (lane & 15));
    const size_t TL = (size_t)T * 4, TO = (size_t)T * 256;
    const bool two = (r0 & (S - 1)) >= 4096;
    struct RowIn { float l[3]; v2u b[3]; float lcv[2]; v2u c[2]; float lav[4]; v2u a[4]; };
    for (int i0 = 0; i0 < 16; i0 += 4) { RowIn in[4];
#pragma unroll
        for (int k = 0; k < 4; ++k) { const int row = r0 + i0 + k; const size_t ro = (size_t)row * 256, rl = (size_t)row * 4 + h; RowIn& R = in[k];
            R.l[0] = lse[rl]; R.l[1] = lse[TL + rl]; R.l[2] = lse[2 * TL + rl];
            R.b[0] = *((const GAS v2u*)(ob + ro) + lane); R.b[1] = *((const GAS v2u*)(ob + TO + ro) + lane); R.b[2] = *((const GAS v2u*)(ob + 2 * TO + ro) + lane);
            R.lcv[0] = lc[rl]; R.c[0] = *((const GAS v2u*)(pc + ro) + lane); R.lav[0] = la[rl]; R.lav[2] = la[2 * TL + rl]; R.a[0] = *((const GAS v2u*)(pa + ro) + lane); R.a[2] = *((const GAS v2u*)(pa + 2 * TO + ro) + lane);
            R.lcv[1] = 0.f; R.lav[1] = 0.f; R.lav[3] = 0.f; R.c[1] = (v2u){0u, 0u}; R.a[1] = (v2u){0u, 0u}; R.a[3] = (v2u){0u, 0u};
            if (two) { R.lcv[1] = lc[TL + rl]; R.c[1] = *((const GAS v2u*)(pc + TO + ro) + lane); R.lav[1] = la[TL + rl]; R.lav[3] = la[3 * TL + rl]; R.a[1] = *((const GAS v2u*)(pa + TO + ro) + lane); R.a[3] = *((const GAS v2u*)(pa + 3 * TO + ro) + lane); } }
#pragma unroll
        for (int k = 0; k < 4; ++k) { const int row = r0 + i0 + k; const RowIn& R = in[k];
            { const float l0 = R.l[0], l1 = R.l[1], l2 = R.l[2];
              const float mx = fmaxf(l0, fmaxf(l1, l2)); float w0 = __builtin_amdgcn_exp2f(l0 - mx), w1 = __builtin_amdgcn_exp2f(l1 - mx), w2 = __builtin_amdgcn_exp2f(l2 - mx);
              const float inv = 1.0f / (w0 + w1 + w2); w0 *= inv; w1 *= inv; w2 *= inv;
              const v2u a = R.b[0], b = R.b[1], c = R.b[2];
              v2u r; r.x = pk2(w0 * bflo(a.x) + w1 * bflo(b.x) + w2 * bflo(c.x), w0 * bfhi(a.x) + w1 * bfhi(b.x) + w2 * bfhi(c.x));
              r.y = pk2(w0 * bflo(a.y) + w1 * bflo(b.y) + w2 * bflo(c.y), w0 * bfhi(a.y) + w1 * bfhi(b.y) + w2 * bfhi(c.y));
              *((GAS v2u*)(o + (size_t)row * D + 256) + lane) = r; }
            { float v[4]; merge2r(R.c[0], R.c[1], R.lcv[0], R.lcv[1], two, v);
              v2u r; r.x = pk2(v[0], v[1]); r.y = pk2(v[2], v[3]); *((GAS v2u*)(o + (size_t)row * D + 512) + lane) = r; }
            { float v0[4], v1[4]; merge2r(R.a[0], R.a[1], R.lav[0], R.lav[1], two, v0); merge2r(R.a[2], R.a[3], R.lav[2], R.lav[3], two, v1);
              float d[4], ss = 0.f;
#pragma unroll
              for (int e = 0; e < 4; ++e) { d[e] = v0[e] - lam * v1[e]; ss += d[e] * d[e]; }
              ss = xsum16(ss, lane); const float rs = (1.0f / sqrtf(ss * (1.0f / 64.0f) + RMS_EPS)) * osc;
              v2u r; r.x = pk2(d[0] * rs * sg.x, d[1] * rs * sg.y); r.y = pk2(d[2] * rs * sg.z, d[3] * rs * sg.w); *((GAS v2u*)(o + (size_t)row * D) + lane) = r; } } }
}

__device__ __forceinline__ void norm2_router(Frame& F, int layer, bool moe) {
    const float* x1 = gout(); bf16* h2 = (bf16*)(gws() + WS_R1); const int lane = F.lane;
    f32x4 gn[4]; load_gain(gin(11) + layer * D, lane, gn);
    const int r0 = F.bx * (T / 256) + F.wave * 16;
    f32x4 cur[4], nxt[4]; row_load(x1 + (size_t)r0 * D, lane, cur);
    if (!moe) {
        for (int i = 0; i < 16; ++i) { if (i + 1 < 16) row_load(x1 + (size_t)(r0 + i + 1) * D, lane, nxt);
            rms_fin(gn, h2 + (size_t)(r0 + i) * D, lane, cur);
#pragma unroll
            for (int j = 0; j < 4; ++j) cur[j] = nxt[j]; }
        return; }
    int* sel = (int*)(gws() + WS_RT + RT_SEL); float* gate = (float*)(gws() + WS_RT + RT_GATE);
    const float* rw = gin(15);
    volatile LAS unsigned* lh = F.MISC + 16;
    f32x4 wr[16][2];
#pragma unroll
    for (int j = 0; j < 4; ++j)
#pragma unroll
        for (int c = 0; c < 4; ++c) { const GAS f32x4* wp = (const GAS f32x4*)(rw + (size_t)(4 * lane + 256 * j + c) * 8); wr[j * 4 + c][0] = wp[0]; wr[j * 4 + c][1] = wp[1]; }
    f32x4 nx2[4]; row_load(x1 + (size_t)(r0 + 1) * D, lane, nxt);
    for (int i = 0; i < 16; ++i) { const int row = r0 + i; f32x4 v[4];
        if (i + 2 < 16) row_load(x1 + (size_t)(row + 2) * D, lane, nx2);
#pragma unroll
        for (int j = 0; j < 4; ++j) v[j] = cur[j];
        rms_fin8(gn, (unsigned char*)h2 + (size_t)row * D, lane, v);
#pragma unroll
        for (int j = 0; j < 4; ++j) { cur[j] = nxt[j]; nxt[j] = nx2[j]; }
        float lg[8];
#pragma unroll
        for (int e = 0; e < 8; ++e) lg[e] = 0.f;
#pragma unroll
        for (int j = 0; j < 4; ++j)
#pragma unroll
            for (int c = 0; c < 4; ++c) { const f32x4 wa = wr[j * 4 + c][0], wb = wr[j * 4 + c][1]; const float xv = v[j][c];
                lg[0] += xv * wa.x; lg[1] += xv * wa.y; lg[2] += xv * wa.z; lg[3] += xv * wa.w; lg[4] += xv * wb.x; lg[5] += xv * wb.y; lg[6] += xv * wb.z; lg[7] += xv * wb.w; }
#pragma unroll
        for (int e = 0; e < 8; ++e) lg[e] = wave_sum(lg[e], lane);
        int i1 = 0; float v1 = lg[0];
#pragma unroll
        for (int e = 1; e < 8; ++e) if (lg[e] > v1) { v1 = lg[e]; i1 = e; }
        int i2 = -1; float v2 = -3.0e38f;
#pragma unroll
        for (int e = 0; e < 8; ++e) if (e != i1 && lg[e] > v2) { v2 = lg[e]; i2 = e; }
        const float g1 = 1.0f / (1.0f + __expf(v2 - v1));
        if (lane == 0) { sel[row * 2] = i1; sel[row * 2 + 1] = i2; gate[row * 2] = g1; gate[row * 2 + 1] = 1.0f - g1;
            __hip_atomic_fetch_add((LAS unsigned*)lh + i1, 1u, __ATOMIC_RELAXED, __HIP_MEMORY_SCOPE_WORKGROUP); __hip_atomic_fetch_add((LAS unsigned*)lh + i2, 1u, __ATOMIC_RELAXED, __HIP_MEMORY_SCOPE_WORKGROUP); } }
    __syncthreads();
    if (F.tid < 8) __hip_atomic_store((unsigned*)gctl() + CW_HIST + F.bx * 8 + F.tid, (unsigned)lh[F.tid], RLX_AGENT);
    asm volatile("s_waitcnt vmcnt(0)" ::: "memory"); __syncthreads();
    if (F.tid == 0) { __builtin_amdgcn_fence(__ATOMIC_RELEASE, "agent"); (void)__hip_atomic_fetch_add((unsigned*)gctl() + CW_RDY, 1u, RLX_AGENT); }
}
__device__ __forceinline__ void hist_wait(Frame& F) {
    if (F.tid == 0) { unsigned sp_ = 0; while (__hip_atomic_load((unsigned*)gctl() + CW_RDY, RLX_AGENT) < (unsigned)F.G) { __builtin_amdgcn_s_sleep(2); if (++sp_ > (1u << 22)) break; }
        __builtin_amdgcn_fence(__ATOMIC_ACQUIRE, "agent"); }
    __syncthreads();
}

__device__ __forceinline__ void route_assign(Frame& F) {
    LAS int* L = (LAS int*)(F.lds + RING_OFF);
    const unsigned* hist = (const unsigned*)gctl() + CW_HIST;
    for (int i = F.tid; i < 2048; i += NWAVES * 64) L[i] = (int)__hip_atomic_load(hist + i, RLX_AGENT);
    __syncthreads();
    if (F.tid < 8) { int tot = 0, before = 0;
#pragma unroll 16
        for (int w = 0; w < 256; ++w) { const int c = L[w * 8 + F.tid]; tot += c; before += (w < F.bx) ? c : 0; } L[2048 + F.tid] = tot; L[2048 + 16 + F.tid] = before; }
    __syncthreads();
    if (F.tid == 0) { int ps = 0; for (int e = 0; e < 8; ++e) { const int c = L[2048 + e], pd = (c + 255) / 256 * 256; L[2048 + 8 + e] = ps; L[2048 + 16 + e] += ps; L[2048 + 24 + e] = pd; ps += pd; } L[2048 + 32] = ps / 256; }
    __syncthreads();
    const int* sel = (const int*)(gws() + WS_RT + RT_SEL); int* pos = (int*)(gws() + WS_RT + RT_POS); int* tokv = (int*)(gws() + WS_RT + RT_TOK); int* blk = (int*)(gws() + WS_RT + RT_BLK);
    if (F.wave == 0) {
        const int lane = F.lane; const unsigned long long lt = (1ull << lane) - 1ull;
        int run[8];
#pragma unroll
        for (int e = 0; e < 8; ++e) run[e] = L[2048 + 16 + e];
        int sl[2][2];
#pragma unroll
        for (int half = 0; half < 2; ++half) { const int row = F.bx * 128 + half * 64 + lane; sl[half][0] = sel[row * 2]; sl[half][1] = sel[row * 2 + 1]; }
#pragma unroll
        for (int half = 0; half < 2; ++half) { const int row = F.bx * 128 + half * 64 + lane; const int s0 = sl[half][0], s1 = sl[half][1]; int d0 = 0, d1 = 0;
#pragma unroll
            for (int e = 0; e < 8; ++e) { const unsigned long long m0 = __ballot(s0 == e), m1 = __ballot(s1 == e); const int rk = run[e] + __popcll(m0 & lt) + __popcll(m1 & lt);
                if (s0 == e) d0 = rk; if (s1 == e) d1 = rk; run[e] += __popcll(m0) + __popcll(m1); }
            pos[row * 2] = d0; pos[row * 2 + 1] = d1; tokv[d0] = row; tokv[d1] = row; }
    }
    if (F.bx == 0) {
        const int nblk = L[2048 + 32];
        for (int rb = F.tid; rb < 272; rb += NWAVES * 64) { int e = 0;
#pragma unroll
            for (int q = 0; q < 8; ++q) if (rb * 256 >= L[2048 + 8 + q] + L[2048 + 24 + q]) e = q + 1;
            blk[rb] = e > 7 ? 7 : e; }
        if (F.tid == 0) blk[272] = nblk;
        for (int e = 0; e < 8; ++e) { const int a = L[2048 + 8 + e] + L[2048 + e], b = L[2048 + 8 + e] + L[2048 + 24 + e]; for (int s = a + F.tid; s < b; s += NWAVES * 64) tokv[s] = 0; }
    }
}

__device__ __forceinline__ void final_combine(Frame& F, int mode, int w0) {
    const int lane = F.lane; f32x4 gn[4]; load_gain(gin(19), lane, gn);
    const int* pos = (const int*)(gws() + WS_RT + RT_POS); const float* gate = (const float*)(gws() + WS_RT + RT_GATE); const bf16* Y = (const bf16*)(gws() + WS_Y);
    const int gw = (F.bx - w0) * NWAVES + F.wave, NGW = (F.G - w0) * NWAVES; constexpr int MAINROWS = 256 * 256;
    if (gw < 0) return;
    f32x4 xc[4], xn[4]; v2u ac[4], bc[4], an[4], bn[4]; float g0c = 0.f, g1c = 0.f, g0n = 0.f, g1n = 0.f; int pmc = 0, pmn = 0;
#define FC_LOAD(row, X, A, B, G0, G1, PM) do { const int p0_ = pos[(row) * 2], p1_ = pos[(row) * 2 + 1]; PM = p0_ > p1_ ? p0_ : p1_; G0 = gate[(row) * 2]; G1 = gate[(row) * 2 + 1]; \
        const GAS f32x4* xr_ = (const GAS f32x4*)(gout() + (size_t)(row) * D) + lane; const GAS v2u* y0_ = (const GAS v2u*)(Y + (size_t)p0_ * D) + lane; const GAS v2u* y1_ = (const GAS v2u*)(Y + (size_t)p1_ * D) + lane; \
        _Pragma("unroll") for (int j = 0; j < 4; ++j) { X[j] = xr_[64 * j]; A[j] = y0_[64 * j]; B[j] = y1_[64 * j]; } } while (0)
#define FC_FINISH(row) do { f32x4 v[4]; float s = 0.f; \
        _Pragma("unroll") for (int j = 0; j < 4; ++j) { const v2u a = ac[j], b = bc[j]; f32x4 x = xc[j]; \
            x.x += g0c * bflo(a.x) + g1c * bflo(b.x); x.y += g0c * bfhi(a.x) + g1c * bfhi(b.x); x.z += g0c * bflo(a.y) + g1c * bflo(b.y); x.w += g0c * bfhi(a.y) + g1c * bfhi(b.y); \
            v[j] = x; s += (x.x * x.x + x.y * x.y) + (x.z * x.z + x.w * x.w); } \
        const float r = 1.0f / sqrtf(wave_sum(s, lane) * (1.f / D) + RMS_EPS); \
        GAS f32x4* xw = (GAS f32x4*)(gout() + (size_t)(row) * D) + lane; \
        _Pragma("unroll") for (int j = 0; j < 4; ++j) xw[64 * j] = v[j] * r * gn[j]; } while (0)
    if (mode == 0) {
        if (gw < T) FC_LOAD(gw, xc, ac, bc, g0c, g1c, pmc);
        for (int row = gw; row < T; row += NGW) {
            if (row + NGW < T) FC_LOAD(row + NGW, xn, an, bn, g0n, g1n, pmn);
            if (pmc < MAINROWS) FC_FINISH(row);
#pragma unroll
            for (int j = 0; j < 4; ++j) { xc[j] = xn[j]; ac[j] = an[j]; bc[j] = bn[j]; }
            g0c = g0n; g1c = g1n; pmc = pmn; }
    } else {
        int pm16[16];
#pragma unroll
        for (int k = 0; k < 16; ++k) { const int row = gw + k * NGW; int p0_ = 0, p1_ = 0; if (row < T) { p0_ = pos[row * 2]; p1_ = pos[row * 2 + 1]; } pm16[k] = p0_ > p1_ ? p0_ : p1_; }
#pragma unroll
        for (int k = 0; k < 16; ++k) { const int row = gw + k * NGW;
            if (pm16[k] >= MAINROWS) { FC_LOAD(row, xc, ac, bc, g0c, g1c, pmc); FC_FINISH(row); } }
        for (int row = gw + 16 * NGW; row < T; row += NGW) { const int p0_ = pos[row * 2], p1_ = pos[row * 2 + 1];
            if ((p0_ > p1_ ? p0_ : p1_) < MAINROWS) continue;
            FC_LOAD(row, xc, ac, bc, g0c, g1c, pmc); FC_FINISH(row); }
    }
#undef FC_LOAD
#undef FC_FINISH
}
__device__ __forceinline__ int q_first(Frame& F, gu32* head) {
    __syncthreads();
    if (F.tid == 0) F.MISC[24] = __hip_atomic_fetch_add(head, 1u, RLX_AGENT);
    __syncthreads(); const int u = __builtin_amdgcn_readfirstlane((int)F.MISC[24]); __syncthreads(); return u;
}
#define ATT_QARGS (unsigned*)qh_, (volatile LAS unsigned*)(F.MISC + 24), F.wave
#define ATT_LOOP(head, NUNITS, ...) do { gu32* qh_ = (head); int u_ = q_first(F, qh_); while (u_ < (NUNITS)) { bool ran_ = false; \
        { const int u = u_; __VA_ARGS__ } if (ran_) u_ = __builtin_amdgcn_readfirstlane((int)F.MISC[24]); else u_ = q_first(F, qh_); } } while (0)

#ifndef ATT_PIPE_C
#define ATT_PIPE_C 0
#endif
#ifndef ATT_PIPE_D
#define ATT_PIPE_D 0
#endif
#ifndef ATT_PIPE_B
#define ATT_PIPE_B 0
#endif
__device__ __forceinline__ void attn_phase(Frame& F, int layer, int rep = 0) {
    char* shm = (char*)F.lds + RING_OFF;
    const att::bf16_t* qkv = (const att::bf16_t*)(gws() + WS_QKV); const att::bf16_t* qm = (const att::bf16_t*)(gws() + WS_QM); const att::bf16_t* kvm = (const att::bf16_t*)(gws() + WS_KVM);
    att::bf16_t* o = (att::bf16_t*)(gws() + WS_R1); att::bf16_t* ob = (att::bf16_t*)(gws() + WS_OB); float* lse = (float*)(gws() + WS_LSE);
    att::bf16_t* pa = (att::bf16_t*)(gws() + WS_PA); att::bf16_t* pc = (att::bf16_t*)(gws() + WS_PC); float* la = (float*)(gws() + WS_LA); float* lc = (float*)(gws() + WS_LC);
    gu32* heads = gctl() + CW_Q + layer * 4 * 64 + rep * 512;
    const int BIG = 1 << 28;
    __syncthreads();
    if (F.tid < 68) { const unsigned* src = (const unsigned*)gctl() + (F.tid < 32 ? CW_KMAX + layer * 32 + F.tid : F.tid < 64 ? CW_KMAXC + layer * 32 + (F.tid - 32) : CW_KPE + layer * 4 + (F.tid - 64));
        F.MISC[32 + F.tid] = __hip_atomic_load(src, RLX_AGENT); }
#ifndef DBG_SKIP_C
#define DBG_SKIP_C 0
#endif
#ifndef PROBE_AC
#define PROBE_AC 0
#endif
  for (int pass = 0; pass < (PROBE_AC ? 2 : 1); ++pass)
    ATT_LOOP(heads + pass * 64, 1568, {
        const bool isC = (u >= 196 && u < 980);
        if (pass == 1 && (isC ? PROBE_AC != 2 : PROBE_AC != 1)) { }
        else if (isC) {
            const int i = u - 196; int qb, bh, ck;
            if (i < 272) { ck = 0; bh = i / 17; qb = 31 - (i % 17); }   else { const int j = i - 272, g = j >> 5, r = j & 31; if (r < 16) { ck = 1; qb = 31 - g; bh = r; } else { ck = 0; qb = 14 - g; bh = r - 16; } }
            if (qb >= 0 && !DBG_SKIP_C) {
                const int b_ = bh >> 2, h = bh & 3, nt = 4 * qb + 4; const long rb = (long)b_ * S;
                att::Job J; J.Q = qm + rb * 384 + h * 96; J.qs = 384; J.K0 = kvm + rb * 512 + h * 128; J.ks0 = 512; J.K1 = qkv + rb * NQKV + C_KPE; J.ks1 = NQKV;
                J.V = kvm + rb * 512 + h * 128 + 64; J.vs = 512; J.O = pc + (size_t)ck * T * 256 + rb * 256 + h * 64; J.os = 256; J.omap = 0; J.LSE = lc + (size_t)ck * T * 4 + rb * 4 + h; J.ls = 4; J.lmap = 0;
                J.q0 = qb * 256; J.t_lo = ck ? 0 : (nt > 64 ? nt - 64 : 0); J.t_hi = ck ? nt - 64 : nt; J.max_dist = BIG; J.slope2 = 0.f; J.sink2 = 0.f; J.rope = (const att::f32x2_t*)(gws() + WS_ROPE); J.kmax2[1] = 0.f;
                J.kmax2[0] = (__uint_as_float(__builtin_amdgcn_readfirstlane(F.MISC[64 + bh * 2])) + __uint_as_float(__builtin_amdgcn_readfirstlane(F.MISC[64 + bh * 2 + 1]))) + __uint_as_float(__builtin_amdgcn_readfirstlane(F.MISC[96 + b_]));
#ifndef PROBE_XP
#define PROBE_XP 0
#endif
#ifndef PROBE_STAG
#define PROBE_STAG 0
#endif
#ifndef ATT_SMAX_C
#define ATT_SMAX_C 1
#endif
#ifndef ATT_STAG_C
#define ATT_STAG_C 0
#endif
                if (pass == 1) { J.O = (att::bf16_t*)(gws() + (size_t)470 * MiB) + (size_t)ck * T * 256 + rb * 256 + h * 64; J.LSE = (float*)(gws() + (size_t)504 * MiB) + (size_t)ck * T * 4 + rb * 4 + h;
                    att::attn_unit<6, 1, false, 1, true, true, PROBE_XP, (PROBE_STAG != 0)>(J, shm, ATT_QARGS); }
                else if constexpr (ATT_PIPE_C) att::attn_unit2<6, false, 1, true>(J, shm, ATT_QARGS); else att::attn_unit<6, 1, false, 1, true, (ATT_SMAX_C != 0), 0, (ATT_STAG_C != 0)>(J, shm, ATT_QARGS);
                ran_ = true;
            }
        } else {
            const int i = u < 196 ? u : u - 784; const int h = 3 - i / 196, ii = i % 196; int qb, b_, ck;
            if (ii < 68) { ck = 0; qb = 31 - (ii >> 2); b_ = ii & 3; } else { const int j = ii - 68, g = j >> 3, r = j & 7; if (r < 4) { ck = 1; qb = 31 - g; b_ = r; } else { ck = 0; qb = 14 - g; b_ = r - 4; } }
            if (qb >= 0) {
                const int nt = 4 * qb + 4; const long rb = (long)b_ * S;
                att::Job J; J.Q = qkv + rb * NQKV + C_QA + h * 64; J.qs = NQKV; J.K0 = qkv + rb * NQKV + C_KA + h * 64; J.ks0 = NQKV; J.K1 = nullptr; J.ks1 = 0;
                J.V = qkv + rb * NQKV + C_VA + h * 64; J.vs = NQKV; J.O = pa + (size_t)ck * T * 256 + rb * 256 + h * 64; J.os = 256; J.omap = (long)2 * T * 256;
                J.LSE = la + (size_t)ck * T * 4 + rb * 4 + h; J.ls = 4; J.lmap = (long)2 * T * 4;
                J.q0 = qb * 256; J.t_lo = ck ? 0 : (nt > 64 ? nt - 64 : 0); J.t_hi = ck ? nt - 64 : nt; J.max_dist = BIG; J.slope2 = exp2f(-(2.f / 3.f) * (float)(3 * h + 1)) * LOG2E; J.sink2 = 0.f; J.rope = nullptr;
                J.kmax2[0] = __uint_as_float(__builtin_amdgcn_readfirstlane(F.MISC[32 + b_ * 8 + h * 2])); J.kmax2[1] = __uint_as_float(__builtin_amdgcn_readfirstlane(F.MISC[32 + b_ * 8 + h * 2 + 1]));
                att::attn_unit<2, 2, true, 1, false, true>(J, shm, ATT_QARGS); ran_ = true;
            }
        }
    });
    __syncthreads();
    {
        char* wl = shm + F.wave * att::BW_LDS; float* wsfb = (float*)((char*)F.lds + MISC_OFF + 1024) + F.wave * 64;
#ifndef PROBE_BAND
#define PROBE_BAND 1
#endif
      for (int pass = 0; pass < PROBE_BAND; ++pass) {
        gu32* bq = heads + (2 + pass) * 64;
        int u = q_first(F, bq); int par_ = 0;
        while (u < 2048) {
            unsigned un_ = 0; if (F.tid == 0) un_ = __hip_atomic_fetch_add(bq, 1u, RLX_AGENT);
            const int ws_ = F.wave;
            att::Job J; J.K1 = nullptr; J.ks1 = 0; J.omap = 0; J.lmap = 0; J.rope = nullptr; J.kmax2[0] = 0.f; J.kmax2[1] = 0.f; J.t_lo = 0; J.t_hi = 0;
            if (u < 512) {
                const int qb = u >> 4, bh = u & 15, b_ = bh >> 2, h = bh & 3, g = h >> 1; const long rb = (long)b_ * S;
                J.Q = qkv + rb * NQKV + C_QD + h * 64; J.qs = NQKV; J.K0 = qkv + rb * NQKV + C_KD + g * 64; J.ks0 = NQKV; J.V = qkv + rb * NQKV + C_VD + g * 64; J.vs = NQKV;
                J.O = o + rb * D + 768 + h * 64; J.os = D; J.LSE = nullptr; J.ls = 0; J.q0 = qb * 256; J.max_dist = 127; J.slope2 = exp2f(-2.f * (float)(h + 1)) * LOG2E;
                J.sink2 = __builtin_bit_cast(float, __builtin_amdgcn_readfirstlane(__builtin_bit_cast(int, gin(10)[layer * 4 + h]))) * LOG2E;
                att::band_wave<3>(J, wl, wsfb, ws_, un_, F.MISC + 26 + par_);
            } else {
                const int v = u - 512, pat = v >> 9, w2 = v & 511, bh = w2 & 15, b_ = bh >> 2, h = bh & 3, w = w2 >> 4;
                const int dsh = 2 * pat, d = 1 << dsh; const int nblk = 32 >> dsh, cls = w / nblk, qb = w % nblk; const long rb = (long)b_ * S + cls;
                J.Q = qkv + rb * NQKV + C_QB + h * 64; J.qs = NQKV * d; J.K0 = qkv + rb * NQKV + C_KB + h * 64; J.ks0 = NQKV * d; J.V = qkv + rb * NQKV + C_VB + h * 64; J.vs = NQKV * d;
                J.O = ob + (size_t)pat * T * 256 + rb * 256 + h * 64; J.os = 256 * d; J.LSE = lse + (size_t)pat * T * 4 + rb * 4 + h; J.ls = 4 * d;
                J.q0 = qb * 256; J.max_dist = 128; J.slope2 = exp2f(-(2.f / 3.f) * (float)(3 * h + 2)) * (float)d * LOG2E; J.sink2 = 0.f;
                att::band_wave<1>(J, wl, wsfb, ws_, un_, F.MISC + 26 + par_);
            }
            asm volatile("s_waitcnt lgkmcnt(0)\n\ts_barrier" ::: "memory"); u = __builtin_amdgcn_readfirstlane((int)F.MISC[26 + par_]); par_ ^= 1;
        }
      }
    }
}

constexpr int G1_DEFER = 5;
struct SkipColOrder { pg8::StaticOrder s;
    __device__ __forceinline__ bool next(int i, pg8::Unit& u) const { if (!s.next(i, u)) return false; if (u.pn >= G1_DEFER) ++u.pn; return true; } };
struct OneTileOrder { int pm, pn;
    __device__ __forceinline__ bool next(int i, pg8::Unit& u) const { if (pm < 0 || i >= 1) return false; u.pm = pm; u.pa = pm; u.pn = pn; return true; } };

struct MoeUpOrder { int rbl, e, pn0, cnt, step;
    __device__ __forceinline__ bool next(int i, pg8::Unit& u) const { if (rbl < 0 || i >= cnt) return false; u.pm = rbl; u.pa = 0; u.pn = e * 28 + pn0 + i * step; return true; } };
struct MoeDownOrder { int rbl, e, pn0;
    __device__ __forceinline__ bool next(int i, pg8::Unit& u) const { if (rbl < 0 || i >= 1) return false; u.pm = rbl; u.pa = rbl; u.pn = e * 4 + pn0; return true; } };

__device__ __forceinline__ Frame fresh(const Frame& F) { Frame P = F; int lane_; asm volatile("v_mbcnt_lo_u32_b32 %0, -1, 0\n\tv_mbcnt_hi_u32_b32 %0, -1, %0" : "=v"(lane_) :: "memory"); asm volatile("" : "+s"(P.wave), "+s"(P.bx), "+s"(P.G));
    P.lane = lane_; P.tid = P.wave * 64 + lane_; P.vcu = (P.bx % 8) * (P.G / 8) + P.bx / 8; return P; }
#ifndef WGM_G4
#define WGM_G4 6
#endif
#ifndef WGM_G1
#define WGM_G1 8
#endif
#ifndef MOE_ADJ
#define MOE_ADJ 1
#endif
#ifndef REP_P0
#define REP_P0 1
#endif
#ifndef REP_G1
#define REP_G1 1
#endif
#ifndef REP_G2
#define REP_G2 1
#endif
#ifndef REP_AT
#define REP_AT 1
#endif
#ifndef REP_CB
#define REP_CB 1
#endif
#ifndef REP_G4
#define REP_G4 1
#endif
#ifndef REP_N1
#define REP_N1 1
#endif
#ifndef REP_MW
#define REP_MW 1
#endif
#ifndef REP_G6
#define REP_G6 1
#endif
#ifndef REP_G7
#define REP_G7 1
#endif
#ifndef REP_R2
#define REP_R2 1
#endif
struct Args { const float* in[20]; float* out; unsigned char* ws; int ph_lo, ph_hi, li, pad; };
__global__ void __launch_bounds__(NWAVES * 64, 2) fwd(Args args) {
    extern __shared__ __attribute__((aligned(16))) unsigned char lds[];
    Frame F0;
    F0.lds = (LAS unsigned char*)lds;
    F0.MISC = (volatile LAS unsigned*)(F0.lds + MISC_OFF);
    F0.tid = 0; F0.lane = 0; F0.wave = __builtin_amdgcn_readfirstlane((int)threadIdx.x >> 6);
    F0.G = gridDim.x; F0.bx = blockIdx.x; F0.vcu = 0;
    for (int u = threadIdx.x; u < (LDS_BYTES - LDSCTL_OFF) / 4; u += NWAVES * 64) ((LAS unsigned*)(F0.lds + LDSCTL_OFF))[u] = 0u;
    __syncthreads();
#define KA_LO (*(const int CAS*)(kargs() + 176))
#define KA_HI (*(const int CAS*)(kargs() + 180))
#define KA_LI (*(const int CAS*)(kargs() + 184))
#define MK_BAR() XcdBarrier bar; bar.bar = (unsigned*)(gctl() + CW_BAR) + KA_LI * XCD_BAR_WORDS; bar.x = xb_xcc_id(); bar.st = (volatile LAS unsigned*)((LAS unsigned char*)lds + MISC_OFF) + 8
    if (!MK_PER_PHASE) { MK_BAR(); (void)xcd_barrier_post(bar.bar, bar.st); }
    int ph = 0;
#define PH_ON() (ph >= KA_LO && ph < KA_HI)
#define PH_END() do { if (PH_ON() && ph + 1 < KA_HI) { if (MK_PER_PHASE) { if (threadIdx.x == 0) __hip_atomic_store(gctl() + CW_TMO, 0xBADBA0u, RLX_AGENT); } else { MK_BAR(); xcd_barrier(bar); } } ++ph; } while (0)
#define ws gws()
#define R1 ((bf16*)(gws() + WS_R1))
#define QKV ((bf16*)(gws() + WS_QKV))

    if (PH_ON()) for (int rep = 0; rep < REP_P0; ++rep) { Frame F = fresh(F0); p0_prologue(F); }
    PH_END();
#ifndef PROBE_NBAR
#define PROBE_NBAR 0
#endif
    for (int xb_ = 0; xb_ < PROBE_NBAR; ++xb_) { MK_BAR(); xcd_barrier(bar); }
    for (int l = 0; l < 2; ++l) {
        if (PH_ON()) for (int rep = 0; rep < REP_G1; ++rep) { Frame F = fresh(F0); pg8::Gemm g{R1, (const bf16*)(ws + WS_WIN + l * WIN_L), D, D, nullptr}; SkipColOrder So; So.s.init(T, NQKVP - 256, F.G, F.bx, WGM_G1);
            pg8::EpiBf16Q E{QKV, NQKV, NQKV, l == 1 ? (const float*)(ws + WS_SSQ) : nullptr, (float*)(ws + WS_SSQ2)}; pg8::gemm_phase<pg8::EpiBf16Q, SkipColOrder>(F.lds + RING_OFF, g, So, E, F.wave); }
        PH_END();
        if (PH_ON()) for (int rep = 0; rep < REP_G2; ++rep) { Frame F = fresh(F0); const int half = F.G / 2;
            if (rep == 0) mla_prep(F, l);
            { pg8::Gemm g{QKV + C_CKV, (const bf16*)(ws + WS_WUKV + l * WUKV_L), 128, NQKV, nullptr}; pg8::StaticOrder So; So.init(T, 512, F.G, F.bx);
              pg8::EpiBf16K E{(bf16*)(ws + WS_KVM), (unsigned*)gctl() + CW_KMAXC + l * 32, (const float*)(ws + WS_SSQ2)}; pg8::gemm_phase<pg8::EpiBf16K, pg8::StaticOrder>(F.lds + RING_OFF, g, So, E, F.wave); }
            if (F.bx < half) {
              pg8::Gemm g{QKV + C_CQ, (const bf16*)(ws + WS_WUQ + l * WUQ_L), 384, NQKV, nullptr}; pg8::StaticOrder So; So.init(T, 512, half, F.bx);
              pg8::EpiBf16R E{(bf16*)(ws + WS_QM), (const float*)(ws + WS_SSQ2)}; pg8::gemm_phase<pg8::EpiBf16R, pg8::StaticOrder>(F.lds + RING_OFF, g, So, E, F.wave);
            } else {
              pg8::Gemm g{R1, (const bf16*)(ws + WS_WIN + l * WIN_L), D, D, nullptr}; OneTileOrder So; So.pm = F.bx - half < T / 256 ? F.bx - half : -1; So.pn = G1_DEFER;
              pg8::EpiBf16 E{QKV, NQKV, NQKV, 0, 1.0f, l == 1 ? (const float*)(ws + WS_SSQ) : nullptr}; pg8::gemm_phase<pg8::EpiBf16, OneTileOrder>(F.lds + RING_OFF, g, So, E, F.wave); }
        }
        PH_END();
        if (PH_ON()) for (int rep = 0; rep < REP_AT; ++rep) { Frame F = fresh(F0); attn_phase(F, l, rep); }
        PH_END();
        if (PH_ON()) for (int rep = 0; rep < REP_CB; ++rep) { Frame F = fresh(F0); attn_combine(F, l); }
        PH_END();
        if (PH_ON()) { Frame F = fresh(F0); pg8::Gemm g{R1, (const bf16*)(ws + WS_WOUT + l * WOUT_L), D, D, nullptr}; pg8::StaticOrder So; So.init(T, D, F.G, F.bx);
            pg8::EpiResid E{l == 0 ? gin(0) : (const float*)gout(), gout(), D, l == 0 ? (bf16*)(ws + WS_XB) : nullptr, l == 0 ? (float*)(ws + WS_SSQ) : nullptr, 1.0f, (FFN8 == 1 || FFN8 == 2)}; pg8::gemm_phase<pg8::EpiResid, pg8::StaticOrder>(F.lds + RING_OFF, g, So, E, F.wave); }
        PH_END();
        if (l == 1) {
        if (PH_ON()) { Frame F = fresh(F0); norm2_router(F, l, true); for (int rep = 0; rep < REP_MW; ++rep) moe_weights(F);
            __syncthreads(); hist_wait(F); route_assign(F); }
        PH_END();
        }
        if (l == 0) {
            if (PH_ON()) for (int rep = 0; rep < REP_G4; ++rep) { Frame F = fresh(F0); pg8::StaticOrder So; So.init(T, 2 * FF, F.G, F.bx, WGM_G4);
#if FFN8 == 1 || FFN8 == 2
                pg8::Gemm g{(const bf16*)(ws + WS_XB), (const bf16*)(ws + WS_W13), D / 2, D / 2, nullptr};
#if FFN8 == 1
                pg8::EpiSwiglu8 E{(void*)(ws + WS_G), FF, 22, 1.0f / MOE_WSCALE, (const float*)(ws + WS_SSQ)}; pg8::gemm_phase<pg8::EpiSwiglu8, pg8::StaticOrder, false, true>(F.lds + RING_OFF, g, So, E, F.wave); }
#else
                pg8::EpiSwiglu E{(void*)(ws + WS_G), FF, 22, 1.0f / MOE_WSCALE, (const float*)(ws + WS_SSQ)}; pg8::gemm_phase<pg8::EpiSwiglu, pg8::StaticOrder, false, true>(F.lds + RING_OFF, g, So, E, F.wave); }
#endif
#else
                pg8::Gemm g{(const bf16*)(ws + WS_XB), (const bf16*)(ws + WS_W13), D, D, nullptr};
#if FFN8 == 3
                pg8::EpiSwiglu8 E{(void*)(ws + WS_G), FF, 22, 1.0f, (const float*)(ws + WS_SSQ)}; pg8::gemm_phase<pg8::EpiSwiglu8, pg8::StaticOrder>(F.lds + RING_OFF, g, So, E, F.wave); }
#else
                pg8::EpiSwiglu E{(void*)(ws + WS_G), FF, 22, 1.0f, (const float*)(ws + WS_SSQ)}; pg8::gemm_phase<pg8::EpiSwiglu, pg8::StaticOrder>(F.lds + RING_OFF, g, So, E, F.wave); }
#endif
#endif
            PH_END();
            if (PH_ON()) { Frame F = fresh(F0); pg8::StaticOrder So; So.init(T, D, F.G, F.bx);
#if FFN8 == 1 || FFN8 == 3
                pg8::Gemm g{(const bf16*)(ws + WS_G), (const bf16*)(ws + WS_W2), FF / 2, FF / 2, nullptr};
                pg8::EpiResid E{(const float*)gout(), gout(), D, R1, (float*)(ws + WS_SSQ), 1.0f / MOE_WSCALE, false}; pg8::gemm_phase<pg8::EpiResid, pg8::StaticOrder, false, true>(F.lds + RING_OFF, g, So, E, F.wave); }
#else
                pg8::Gemm g{(const bf16*)(ws + WS_G), (const bf16*)(ws + WS_W2), FF, FF, nullptr};
                pg8::EpiResid E{(const float*)gout(), gout(), D, R1, (float*)(ws + WS_SSQ)}; pg8::gemm_phase<pg8::EpiResid, pg8::StaticOrder>(F.lds + RING_OFF, g, So, E, F.wave); }
#endif
            PH_END();
        } else {
            const int* blk = (const int*)(ws + WS_RT + RT_BLK); const int* tokv = (const int*)(ws + WS_RT + RT_TOK);
            for (int p = 0; p < 6; ++p) {
                if (PH_ON()) {
                    if (p >= 1) for (int rep = 0; rep < REP_G7; ++rep) { Frame F = fresh(F0); const int q = p - 1; const int nblk = __builtin_amdgcn_readfirstlane(blk[272]); const int nrem4 = nblk > 256 ? (nblk - 256) * 4 : 0;
                        const bool rem = (q == 4);
                        const int rb = rem ? 256 + (F.bx >> 2) : q * 64 + (F.vcu >> 2); MoeDownOrder So; So.rbl = rb < nblk ? (rem ? (F.bx >> 2) : (F.vcu >> 2)) : -1; So.e = rb < nblk ? __builtin_amdgcn_readfirstlane(blk[rb]) : 0; So.pn0 = rem ? (F.bx & 3) : (F.vcu & 3);
                        if (!rem || F.bx < nrem4) {
                            pg8::Gemm g{(const bf16*)(ws + WS_GM + (size_t)(q & 1) * GM_L), (const bf16*)(ws + WS_MW2), FE / 2, FE / 2, nullptr};
                            pg8::EpiBf16 E{(bf16*)(ws + WS_Y) + (size_t)q * 64 * 256 * D, D, D, 4, 1.0f / MOE_WSCALE}; pg8::gemm_phase<pg8::EpiBf16, MoeDownOrder, false, true>(F.lds + RING_OFF, g, So, E, F.wave); }
                        else final_combine(F, 0, nrem4); }
                    if (p <= 4) for (int rep = 0; rep < REP_G6; ++rep) { Frame F = fresh(F0); const int nblk = __builtin_amdgcn_readfirstlane(blk[272]);
                        const bool rem6 = (p == 4); const int lb = rem6 ? F.vcu / 28 : (F.vcu >> 2);
                        const int rb = p * 64 + lb; MoeUpOrder So; So.rbl = rb < nblk ? lb : -1; So.e = rb < nblk ? __builtin_amdgcn_readfirstlane(blk[rb]) : 0; So.pn0 = rem6 ? F.vcu % 28 : (MOE_ADJ ? (F.vcu & 3) : (F.vcu & 3) * 7); So.cnt = rem6 ? 1 : 7; So.step = (MOE_ADJ && !rem6) ? 4 : 1;
                        pg8::Gemm g{R1, (const bf16*)(ws + WS_MW13), D / 2, D / 2, tokv + (rb < nblk ? rb : 0) * 256};
                        pg8::EpiSwiglu8 E{(void*)(ws + WS_GM + (size_t)(p & 1) * GM_L), FE, 28, 1.0f / MOE_WSCALE}; pg8::gemm_phase<pg8::EpiSwiglu8, MoeUpOrder, true, true>(F.lds + RING_OFF, g, So, E, F.wave); }
                }
                PH_END();
            }
            if (PH_ON()) { Frame F = fresh(F0); final_combine(F, 1, 0); }
            PH_END();
        }
    }
#undef PH_ON
#undef PH_END
#undef ws
#undef R1
#undef QKV
}
static_assert(sizeof(Args) == 192 && offsetof(Args, out) == 160 && offsetof(Args, ws) == 168 && offsetof(Args, ph_lo) == 176 && offsetof(Args, ph_hi) == 180 && offsetof(Args, li) == 184, "kernarg offsets");
constexpr int N_PHASES = 1 + (5 + 2) + (5 + 1 + 6 + 1);

extern "C" void kernel_launch(void* const* d_in, const int* in_sizes, int n_in, void* d_out, int out_size, void* d_ws, size_t ws_size, hipStream_t stream) {
    static int grid = 0;
    if (grid == 0) {
        if (n_in != 20 || in_sizes[0] != T * D || out_size != T * D || ws_size < WS_END) { fprintf(stderr, "kernel_launch: unexpected shapes (n_in %d, in0 %d, out %d, ws %zu < %zu); nothing launched\n", n_in, n_in > 0 ? in_sizes[0] : -1, out_size, ws_size, (size_t)WS_END); grid = -1; return; }
        int dev = 0, cus = 0, per_cu = 0;
        if (hipGetDevice(&dev) != hipSuccess || hipDeviceGetAttribute(&cus, hipDeviceAttributeMultiprocessorCount, dev) != hipSuccess) { grid = -1; return; }
        if (hipFuncSetAttribute((const void*)fwd, hipFuncAttributeMaxDynamicSharedMemorySize, LDS_BYTES) != hipSuccess) { fprintf(stderr, "kernel_launch: hipFuncSetAttribute failed\n"); grid = -1; return; }
        if (hipOccupancyMaxActiveBlocksPerMultiprocessor(&per_cu, (const void*)fwd, NWAVES * 64, LDS_BYTES) != hipSuccess || per_cu < 1) { fprintf(stderr, "kernel_launch: occupancy query reports %d workgroups per CU\n", per_cu); }
        (void)hipGetLastError();
        if (cus < 256) { fprintf(stderr, "kernel_launch: %d CUs < 256: the 256-workgroup grid would not be resident; nothing launched\n", cus); grid = -1; return; }
        grid = 256;
    }
    if (grid < 0) return;
    if (hipMemsetAsync((char*)d_ws + WS_CTL, 0, CTL_ZERO_BYTES, stream) != hipSuccess) return;
    Args a{};
    for (int i = 0; i < 20; ++i) a.in[i] = (const float*)d_in[i];
    a.out = (float*)d_out; a.ws = (unsigned char*)d_ws; a.pad = 0;
#if MK_PER_PHASE
    for (int li = 0; li < N_PHASES; ++li) { a.ph_lo = li; a.ph_hi = li + 1; a.li = 0; hipLaunchKernelGGL(fwd, dim3(grid), dim3(NWAVES * 64), LDS_BYTES, stream, a); }
#else
#ifndef DBG_PH_HI
#define DBG_PH_HI N_PHASES
#endif
    a.ph_lo = 0; a.ph_hi = DBG_PH_HI; a.li = 0;
    hipLaunchKernelGGL(fwd, dim3(grid), dim3(NWAVES * 64), LDS_BYTES, stream, a);
#endif
    const hipError_t le = hipPeekAtLastError();
    if (le != hipSuccess) fprintf(stderr, "kernel_launch: launch failed: %s\n", hipGetErrorName(le));
}
```

```cpp
#define FFN8 2
#include <hip/hip_runtime.h>
#include <hip/hip_bf16.h>
#include <cstdio>
#include <cstdint>
#include <cstddef>
#include <cmath>

namespace pg8 {
#define PG8_LAS __attribute__((address_space(3)))
typedef unsigned short bf16_t;
typedef short bf16x8 __attribute__((ext_vector_type(8)));
typedef float f32x4 __attribute__((ext_vector_type(4)));
typedef float f32x2 __attribute__((ext_vector_type(2)));
typedef unsigned u32x4 __attribute__((ext_vector_type(4)));
constexpr int BM = 256, BK = 64, HALF = 128, HTB = HALF * BK * 2  , STAGE_BYTES = 8 * HTB, NXCD = 8, WGM = 8;

__host__ __device__ __forceinline__ int lds_byte(int r, int c) { const int st = (r >> 4) * 2 + (c >> 5), rr = r & 15, cc = c & 31, ob = rr * 64 + cc * 2; return st * 1024 + (ob ^ (((ob >> 9) & 1) << 5)); }
__host__ __device__ __forceinline__ void stage_rc(int b, int& R, int& C) { const int st = b / 1024, sb = b % 1024, swz = sb ^ (((sb >> 9) & 1) << 5); R = (st >> 1) * 16 + swz / 64; C = (st & 1) * 32 + (swz % 64) / 2; }
__host__ __device__ __forceinline__ int perm32(int rho) { const int n = rho >> 4, i = rho & 15; return 8 * (i >> 2) + 4 * n + (i & 3); }

struct Unit { int pm, pn, pa; };
struct Gemm { const bf16_t* A; const bf16_t* Bt; int K, lda; const int* gidx; };

struct StaticOrder {
    int nM, nN, nwg, G, c, wgm;
    __host__ __device__ void init(int M, int N, int G_, int c_, int wgm_ = WGM) { nM = M / BM; nN = N / BM; nwg = nM * nN; G = G_; c = c_; wgm = wgm_; }
    __host__ __device__ bool next(int i, Unit& u) const {
        const long L = (long)i * G + c; if (L >= nwg) return false;
        int wgid = (int)L; { const int q = nwg / NXCD, r = nwg % NXCD, xcd = wgid % NXCD, off = wgid / NXCD; wgid = (xcd < r ? xcd * (q + 1) : r * (q + 1) + (xcd - r) * q) + off; }
        const int nig = wgm * nN, gid = wgid / nig, fm = gid * wgm, gsz = (nM - fm) < wgm ? (nM - fm) : wgm;
        u.pm = fm + ((wgid % nig) % gsz); u.pn = (wgid % nig) / gsz; u.pa = u.pm; return true;
    }
};

__device__ __forceinline__ unsigned cvt_pk_bf16(float lo, float hi) { unsigned r; asm volatile("v_cvt_pk_bf16_f32 %0, %1, %2" : "=v"(r) : "v"(lo), "v"(hi)); return r; }

__device__ __forceinline__ float rms_scale16(const float* ssq, int row) { const f32x4* p = (const f32x4*)(ssq + (size_t)row * 16); const f32x4 a = p[0], b = p[1], c = p[2], d = p[3];
    const float s = ((a[0] + a[1]) + (a[2] + a[3])) + ((b[0] + b[1]) + (b[2] + b[3])) + ((c[0] + c[1]) + (c[2] + c[3])) + ((d[0] + d[1]) + (d[2] + d[3])); return 1.0f / sqrtf(s * (1.0f / 1024.0f) + 1e-6f); }
struct RowScale { float r0, r1;
    __device__ __forceinline__ void init(const float* ssq, int unit_row0, int wr, int lane) { r0 = rms_scale16(ssq, unit_row0 + wr * 64 + lane); r1 = rms_scale16(ssq, unit_row0 + HALF + wr * 64 + lane); }
    __device__ __forceinline__ float get(int ai, int m, int fr) const { return __int_as_float(__builtin_amdgcn_ds_bpermute((m * 16 + fr) << 2, __float_as_int(ai ? r1 : r0))); } };
template <int OFF, int CNT> __device__ __forceinline__ float rms_part(const float* ssq, int row) { const float* p = ssq + (size_t)row * 16 + OFF; float s = 0.f;
#pragma unroll
    for (int i = 0; i < CNT; i += 4) { const f32x4 a = *(const f32x4*)(p + i); s += (a[0] + a[1]) + (a[2] + a[3]); }
    return 1.0f / sqrtf(s * (1.0f / (32.0f * CNT)) + 1e-6f); }
template <int OFF, int CNT> struct RowScaleP { float r0, r1;
    __device__ __forceinline__ void init(const float* ssq, int unit_row0, int wr, int lane) { r0 = rms_part<OFF, CNT>(ssq, unit_row0 + wr * 64 + lane); r1 = rms_part<OFF, CNT>(ssq, unit_row0 + HALF + wr * 64 + lane); }
    __device__ __forceinline__ float get(int ai, int m, int fr) const { return __int_as_float(__builtin_amdgcn_ds_bpermute((m * 16 + fr) << 2, __float_as_int(ai ? r1 : r0))); } };
struct EpiBf16Q {
    static constexpr bool PERM = true;
    bf16_t* O; int ldc; int ncols; const float* ssq; float* ssq2;
    __device__ __forceinline__ void operator()(const f32x4 (&acc)[2][2][4][2], const Unit& u, int wr, int wc, int fr, int fq) const {
        const int row0 = u.pm * BM + wr * 64 + fr; const int col0 = u.pn * BM + wc * 32 + 8 * fq; const int ln = fq * 16 + fr;
        const bool lat = (u.pn == 8 || u.pn == 9);
        RowScale R; if (ssq) R.init(ssq, u.pm * BM, wr, fq * 16 + fr);
#pragma unroll
        for (int ai = 0; ai < 2; ++ai)
#pragma unroll
            for (int m = 0; m < 4; ++m) { const int row = row0 + ai * HALF + m * 16; bf16_t* rowp = O + (size_t)row * ldc + col0; const float rs = ssq ? R.get(ai, m, fr) : 1.0f;
#pragma unroll
                for (int bj = 0; bj < 2; ++bj) { const f32x4 v0 = acc[ai][bj][m][0] * rs, v1 = acc[ai][bj][m][1] * rs;
                    u32x4 w; w.x = cvt_pk_bf16(v0[0], v0[1]); w.y = cvt_pk_bf16(v0[2], v0[3]); w.z = cvt_pk_bf16(v1[0], v1[1]); w.w = cvt_pk_bf16(v1[2], v1[3]);
                    if (col0 + bj * HALF < ncols) *(u32x4*)(rowp + bj * HALF) = w;
                    if (lat) { float ss = ((v0[0] * v0[0] + v0[1] * v0[1]) + (v0[2] * v0[2] + v0[3] * v0[3])) + ((v1[0] * v1[0] + v1[1] * v1[1]) + (v1[2] * v1[2] + v1[3] * v1[3]));
                        ss += __int_as_float(__builtin_amdgcn_ds_bpermute((ln ^ 16) << 2, __float_as_int(ss))); ss += __int_as_float(__builtin_amdgcn_ds_bpermute((ln ^ 32) << 2, __float_as_int(ss)));
                        if (fq == 0) ssq2[(size_t)row * 16 + (u.pn - 8) * 8 + bj * 4 + wc] = ss; } } }
    }
};
struct EpiBf16R {
    static constexpr bool PERM = true;
    bf16_t* O; const float* ssq2;
    __device__ __forceinline__ void operator()(const f32x4 (&acc)[2][2][4][2], const Unit& u, int wr, int wc, int fr, int fq) const {
        const int row0 = u.pm * BM + wr * 64 + fr; const int col0 = u.pn * BM + wc * 32 + 8 * fq;
        RowScaleP<0, 12> R; R.init(ssq2, u.pm * BM, wr, fq * 16 + fr);
#pragma unroll
        for (int ai = 0; ai < 2; ++ai)
#pragma unroll
            for (int m = 0; m < 4; ++m) { const int row = row0 + ai * HALF + m * 16; bf16_t* rowp = O + (size_t)row * 384 + col0; const float rs = R.get(ai, m, fr);
#pragma unroll
                for (int bj = 0; bj < 2; ++bj) { const f32x4 v0 = acc[ai][bj][m][0] * rs, v1 = acc[ai][bj][m][1] * rs;
                    u32x4 w; w.x = cvt_pk_bf16(v0[0], v0[1]); w.y = cvt_pk_bf16(v0[2], v0[3]); w.z = cvt_pk_bf16(v1[0], v1[1]); w.w = cvt_pk_bf16(v1[2], v1[3]);
                    if (col0 + bj * HALF < 384) *(u32x4*)(rowp + bj * HALF) = w; } }
    }
};
struct EpiBf16 {
    static constexpr bool PERM = true;
    bf16_t* O; int ldc; int ncols; int nt; float sc = 1.0f; const float* ssq = nullptr;
    __device__ __forceinline__ void operator()(const f32x4 (&acc)[2][2][4][2], const Unit& u, int wr, int wc, int fr, int fq) const {
        const int row0 = u.pm * BM + wr * 64 + fr; const int col0 = (nt ? u.pn % nt : u.pn) * BM + wc * 32 + 8 * fq;
        RowScale R; if (ssq) R.init(ssq, u.pm * BM, wr, fq * 16 + fr);
#pragma unroll
        for (int ai = 0; ai < 2; ++ai)
#pragma unroll
            for (int m = 0; m < 4; ++m) { const int row = row0 + ai * HALF + m * 16; bf16_t* rowp = O + (size_t)row * ldc + col0; const float rs = ssq ? sc * R.get(ai, m, fr) : sc;
#pragma unroll
                for (int bj = 0; bj < 2; ++bj) { const f32x4 v0 = acc[ai][bj][m][0] * rs, v1 = acc[ai][bj][m][1] * rs;
                    u32x4 w; w.x = cvt_pk_bf16(v0[0], v0[1]); w.y = cvt_pk_bf16(v0[2], v0[3]); w.z = cvt_pk_bf16(v1[0], v1[1]); w.w = cvt_pk_bf16(v1[2], v1[3]);
                    if (col0 + bj * HALF < ncols) *(u32x4*)(rowp + bj * HALF) = w; } }
    }
};
struct EpiBf16K {
    static constexpr bool PERM = true;
    bf16_t* O; unsigned* kmax; const float* ssq2;
    __device__ __forceinline__ void operator()(const f32x4 (&acc)[2][2][4][2], const Unit& u, int wr, int wc, int fr, int fq) const {
        const int row0 = u.pm * BM + wr * 64 + fr; const int col0 = u.pn * BM + wc * 32 + 8 * fq; const int ln = fq * 16 + fr;
        float mx0 = 0.f, mx1 = 0.f;
        RowScaleP<12, 4> R; R.init(ssq2, u.pm * BM, wr, ln);
#pragma unroll
        for (int ai = 0; ai < 2; ++ai)
#pragma unroll
            for (int m = 0; m < 4; ++m) { const int row = row0 + ai * HALF + m * 16; bf16_t* rowp = O + (size_t)row * 512 + col0; const float rs = R.get(ai, m, fr);
#pragma unroll
                for (int bj = 0; bj < 2; ++bj) { const f32x4 v0 = acc[ai][bj][m][0] * rs, v1 = acc[ai][bj][m][1] * rs;
                    u32x4 w; w.x = cvt_pk_bf16(v0[0], v0[1]); w.y = cvt_pk_bf16(v0[2], v0[3]); w.z = cvt_pk_bf16(v1[0], v1[1]); w.w = cvt_pk_bf16(v1[2], v1[3]);
                    *(u32x4*)(rowp + bj * HALF) = w;
                    if (wc < 2) { float ss = ((v0[0] * v0[0] + v0[1] * v0[1]) + (v0[2] * v0[2] + v0[3] * v0[3])) + ((v1[0] * v1[0] + v1[1] * v1[1]) + (v1[2] * v1[2] + v1[3] * v1[3]));
                        ss += __int_as_float(__builtin_amdgcn_ds_bpermute((ln ^ 16) << 2, __float_as_int(ss))); ss += __int_as_float(__builtin_amdgcn_ds_bpermute((ln ^ 32) << 2, __float_as_int(ss)));
                        if (bj == 0) mx0 = __builtin_fmaxf(mx0, ss); else mx1 = __builtin_fmaxf(mx1, ss); } } }
        if (wc < 2) {
#pragma unroll
            for (int o_ = 1; o_ < 16; o_ <<= 1) { mx0 = __builtin_fmaxf(mx0, __int_as_float(__builtin_amdgcn_ds_bpermute((ln ^ o_) << 2, __float_as_int(mx0)))); mx1 = __builtin_fmaxf(mx1, __int_as_float(__builtin_amdgcn_ds_bpermute((ln ^ o_) << 2, __float_as_int(mx1)))); }
            if (ln == 0) { unsigned* kp = kmax + (((u.pm * BM) >> 13) * 4 + 2 * u.pn) * 2 + wc;
                __hip_atomic_fetch_max(kp, __float_as_uint(mx0), __ATOMIC_RELAXED, __HIP_MEMORY_SCOPE_AGENT); __hip_atomic_fetch_max(kp + 2, __float_as_uint(mx1), __ATOMIC_RELAXED, __HIP_MEMORY_SCOPE_AGENT); } }
    }
};
struct EpiRope {
    static constexpr bool PERM = true;
    bf16_t* O; const f32x2* rope;
    __device__ __forceinline__ void operator()(const f32x4 (&acc)[2][2][4][2], const Unit& u, int wr, int wc, int fr, int fq) const {
        const int row0 = u.pm * BM + wr * 64 + fr; const int col0 = u.pn * BM + wc * 32 + 8 * fq;
#pragma unroll
        for (int bj = 0; bj < 2; ++bj) { const int col = col0 + bj * HALF; if (col >= 384) continue;
            const int dd = col % 96; const bool rp = dd >= 64; const int j0 = rp ? ((dd - 64) >> 1) : 0;
            const f32x2* rt0 = rope + (size_t)(row0 & 8191) * 16 + j0; bf16_t* op0 = O + (size_t)row0 * 384 + col;
#pragma unroll
            for (int ai = 0; ai < 2; ++ai)
#pragma unroll
                for (int m = 0; m < 4; ++m) { const int dr = ai * HALF + m * 16; f32x4 v0 = acc[ai][bj][m][0], v1 = acc[ai][bj][m][1];
                    { const f32x2* rt = rt0 + dr * 16; f32x2 c0 = rt[0], c1 = rt[1], c2 = rt[2], c3 = rt[3];
                        if (!rp) { c0 = (f32x2){1.f, 0.f}; c1 = c0; c2 = c0; c3 = c0; }
                        f32x4 a, b; a[0] = v0[0] * c0.x - v0[1] * c0.y; a[1] = v0[1] * c0.x + v0[0] * c0.y; a[2] = v0[2] * c1.x - v0[3] * c1.y; a[3] = v0[3] * c1.x + v0[2] * c1.y;
                        b[0] = v1[0] * c2.x - v1[1] * c2.y; b[1] = v1[1] * c2.x + v1[0] * c2.y; b[2] = v1[2] * c3.x - v1[3] * c3.y; b[3] = v1[3] * c3.x + v1[2] * c3.y; v0 = a; v1 = b; }
                    u32x4 w; w.x = cvt_pk_bf16(v0[0], v0[1]); w.y = cvt_pk_bf16(v0[2], v0[3]); w.z = cvt_pk_bf16(v1[0], v1[1]); w.w = cvt_pk_bf16(v1[2], v1[3]);
                    *(u32x4*)(op0 + (size_t)dr * 384) = w; asm volatile("" ::: "memory"); } }
    }
};
struct EpiResid {
    static constexpr bool PERM = true;
    const float* base; float* out; int ldc; bf16_t* xb = nullptr; float* ssq = nullptr; float sc = 1.0f; bool xb8 = false;
    __device__ __forceinline__ void operator()(const f32x4 (&acc)[2][2][4][2], const Unit& u, int wr, int wc, int fr, int fq) const {
        const int row0 = u.pm * BM + wr * 64 + fr; const int col0 = u.pn * BM + wc * 32 + 8 * fq;
#pragma unroll
        for (int ai = 0; ai < 2; ++ai)
#pragma unroll
            for (int mp = 0; mp < 4; mp += 2) {
                f32x4 bb[2][2][2];
#pragma unroll
                for (int mi = 0; mi < 2; ++mi) { const size_t off = (size_t)(row0 + ai * HALF + (mp + mi) * 16) * ldc + col0;
                    bb[mi][0][0] = *(const f32x4*)(base + off); bb[mi][0][1] = *(const f32x4*)(base + off + 4); bb[mi][1][0] = *(const f32x4*)(base + off + HALF); bb[mi][1][1] = *(const f32x4*)(base + off + HALF + 4); }
#pragma unroll
                for (int mi = 0; mi < 2; ++mi) { const int m = mp + mi; const int row = row0 + ai * HALF + m * 16; const size_t off = (size_t)row * ldc + col0; float ss = 0.f;
#pragma unroll
                    for (int bj = 0; bj < 2; ++bj) { const f32x4 b0 = bb[mi][bj][0], b1 = bb[mi][bj][1];
                        const f32x4 x0 = b0 + acc[ai][bj][m][0] * sc, x1 = b1 + acc[ai][bj][m][1] * sc;
                        *(f32x4*)(out + off + bj * HALF) = x0; *(f32x4*)(out + off + bj * HALF + 4) = x1;
                        if (xb) { if (xb8) { int w0 = __builtin_amdgcn_cvt_pk_fp8_f32(x0[0], x0[1], 0, false); w0 = __builtin_amdgcn_cvt_pk_fp8_f32(x0[2], x0[3], w0, true);
                                int w1 = __builtin_amdgcn_cvt_pk_fp8_f32(x1[0], x1[1], 0, false); w1 = __builtin_amdgcn_cvt_pk_fp8_f32(x1[2], x1[3], w1, true);
                                typedef int i32x2 __attribute__((ext_vector_type(2))); *(i32x2*)((char*)xb + off + bj * HALF) = (i32x2){w0, w1}; }
                            else { u32x4 w; w.x = cvt_pk_bf16(x0[0], x0[1]); w.y = cvt_pk_bf16(x0[2], x0[3]); w.z = cvt_pk_bf16(x1[0], x1[1]); w.w = cvt_pk_bf16(x1[2], x1[3]); *(u32x4*)(xb + off + bj * HALF) = w; }
                            ss += ((x0[0] * x0[0] + x0[1] * x0[1]) + (x0[2] * x0[2] + x0[3] * x0[3])) + ((x1[0] * x1[0] + x1[1] * x1[1]) + (x1[2] * x1[2] + x1[3] * x1[3])); } }
                    if (xb) { const int ln = fq * 16 + fr;
                        ss += __int_as_float(__builtin_amdgcn_ds_bpermute((ln ^ 16) << 2, __float_as_int(ss))); ss += __int_as_float(__builtin_amdgcn_ds_bpermute((ln ^ 32) << 2, __float_as_int(ss)));
                        if (fq == 0) ssq[(size_t)row * 16 + u.pn * 4 + wc] = ss; } }
                asm volatile("" ::: "memory"); }
    }
};
template <bool F8OUT> struct EpiSwigluT {
    static constexpr bool PERM = true;
    void* G; int ldc; int ntile; float sc; const float* ssq = nullptr;
    __device__ __forceinline__ void operator()(const f32x4 (&acc)[2][2][4][2], const Unit& u, int wr, int wc, int fr, int fq) const {
        const int row0 = u.pm * BM + wr * 64 + fr; const int col0 = (u.pn % ntile) * HALF + wc * 32 + 8 * fq;
        RowScale R; if (ssq) R.init(ssq, u.pm * BM, wr, fq * 16 + fr);
#pragma unroll
        for (int ai = 0; ai < 2; ++ai)
#pragma unroll
            for (int m = 0; m < 4; ++m) { float g[8]; const float rs = ssq ? sc * R.get(ai, m, fr) : sc;
#pragma unroll
                for (int n = 0; n < 2; ++n)
#pragma unroll
                    for (int e = 0; e < 4; ++e) { const float a = acc[ai][0][m][n][e] * rs, b = acc[ai][1][m][n][e] * rs;
                        const float s = __builtin_amdgcn_rcpf(1.0f + __builtin_amdgcn_exp2f(-1.4426950408889634f * a)); g[n * 4 + e] = a * s * b; }
                if constexpr (F8OUT) { int w0 = __builtin_amdgcn_cvt_pk_fp8_f32(g[0], g[1], 0, false); w0 = __builtin_amdgcn_cvt_pk_fp8_f32(g[2], g[3], w0, true);
                    int w1 = __builtin_amdgcn_cvt_pk_fp8_f32(g[4], g[5], 0, false); w1 = __builtin_amdgcn_cvt_pk_fp8_f32(g[6], g[7], w1, true);
                    typedef int i32x2 __attribute__((ext_vector_type(2)));
                    *(i32x2*)((char*)G + (size_t)(row0 + ai * HALF + m * 16) * ldc + col0) = (i32x2){w0, w1}; }
                else { u32x4 w; w.x = cvt_pk_bf16(g[0], g[1]); w.y = cvt_pk_bf16(g[2], g[3]); w.z = cvt_pk_bf16(g[4], g[5]); w.w = cvt_pk_bf16(g[6], g[7]);
                    *(u32x4*)((bf16_t*)G + (size_t)(row0 + ai * HALF + m * 16) * ldc + col0) = w; } }
    }
};
typedef EpiSwigluT<false> EpiSwiglu;
typedef EpiSwigluT<true> EpiSwiglu8;

__device__ __forceinline__ void glds_s(unsigned voff, const char* sbase, unsigned lds_dst) { unsigned keep;
    asm volatile("s_mov_b32 %0, m0\n\ts_mov_b32 m0, %3\n\ts_nop 0\n\tglobal_load_lds_dwordx4 %1, %2\n\ts_mov_b32 m0, %0" : "=&s"(keep) : "v"(voff), "s"(sbase), "s"(lds_dst) : "memory"); }
template <class Epi, class Sched, bool GATHER = false, bool FP8 = false>
__device__ __forceinline__ void gemm_phase(PG8_LAS unsigned char* lds, const Gemm g, const Sched& S, const Epi& E, const int wave_id) {
    int lane_; asm volatile("v_mbcnt_lo_u32_b32 %0, -1, 0\n\tv_mbcnt_hi_u32_b32 %0, -1, %0" : "=v"(lane_));
    const int wid = wave_id, lane = lane_, tid = wid * 64 + lane, wr = wid >> 2, wc = wid & 3, fr = lane & 15, fq = lane >> 4;
    const int K = g.K, nt = K / BK;
    Unit cur, nxt; int ui = 0;
    if (!S.next(0, cur)) return;
    unsigned offA[2][2], voffB[2];
#pragma unroll
    for (int i = 0; i < 2; ++i) { int R, C; stage_rc(tid * 16 + i * 8192, R, C); const int Rb = Epi::PERM ? ((R & ~31) + perm32(R & 31)) : R;
        voffB[i] = (unsigned)(Rb * K + C) * 2u;
#pragma unroll
        for (int h = 0; h < 2; ++h) {
            if constexpr (GATHER) { const int tok = g.gidx[h * HALF + R]; offA[h][i] = (unsigned)tok * (unsigned)(g.lda * 2) + (unsigned)C * 2u; }
            else offA[h][i] = (unsigned)((h * HALF + R) * g.lda + C) * 2u; } }
    if constexpr (GATHER) asm volatile("s_waitcnt vmcnt(0)" ::: "memory");
    const size_t kstep = (size_t)(BK * 2);
    const size_t hstep = (size_t)HALF * K * 2;
    const size_t tstepB = 2 * hstep, tstepA = (size_t)BM * g.lda * 2;
    const unsigned ldsw = (unsigned)wid * 1024u; const unsigned lds0 = (unsigned)(uintptr_t)lds;
    int scl1 = 0x7f7f7f7f; asm volatile("" : "+v"(scl1));
    const int aoff = lds_byte(wr * 64 + fr, fq * 8), boff = lds_byte(wc * 32 + fr, fq * 8);
#define PG8_SA(b, h) (((b) * 2 + (h)) * HTB)
#define PG8_SB(b, h) ((4 + (b) * 2 + (h)) * HTB)
#define PG8_STAGE(bufoff, gbase, voff) do { _Pragma("unroll") for (int _i = 0; _i < 2; ++_i) \
        glds_s((voff)[_i], (const char*)(gbase), lds0 + (unsigned)(bufoff) + ldsw + _i * 8192u); } while (0)
#define PG8_LDA(dst, b, h) do { if constexpr (FP8) { _Pragma("unroll") for (int m = 0; m < 4; ++m) { const i32x4 lo_ = *(const PG8_LAS i32x4*)(lds + PG8_SA(b, h) + aoff + m * 2048), hi_ = *(const PG8_LAS i32x4*)(lds + PG8_SA(b, h) + aoff + m * 2048 + 1024); \
        dst##8[m] = (i32x8){lo_[0], lo_[1], lo_[2], lo_[3], hi_[0], hi_[1], hi_[2], hi_[3]}; } } \
    else { _Pragma("unroll") for (int m = 0; m < 4; ++m) _Pragma("unroll") for (int k = 0; k < 2; ++k) dst[m][k] = *(const PG8_LAS bf16x8*)(lds + PG8_SA(b, h) + aoff + m * 2048 + k * 1024); } } while (0)
#define PG8_LDB(dst, b, h) do { if constexpr (FP8) { _Pragma("unroll") for (int n = 0; n < 2; ++n) { const i32x4 lo_ = *(const PG8_LAS i32x4*)(lds + PG8_SB(b, h) + boff + n * 2048), hi_ = *(const PG8_LAS i32x4*)(lds + PG8_SB(b, h) + boff + n * 2048 + 1024); \
        dst##8[n] = (i32x8){lo_[0], lo_[1], lo_[2], lo_[3], hi_[0], hi_[1], hi_[2], hi_[3]}; } } \
    else { _Pragma("unroll") for (int n = 0; n < 2; ++n) _Pragma("unroll") for (int k = 0; k < 2; ++k) dst[n][k] = *(const PG8_LAS bf16x8*)(lds + PG8_SB(b, h) + boff + n * 2048 + k * 1024); } } while (0)
#define PG8_MMA(ai, bj, At, Bt) do { __builtin_amdgcn_s_setprio(1); _Pragma("unroll") for (int m = 0; m < 4; ++m) _Pragma("unroll") for (int n = 0; n < 2; ++n) { \
        if constexpr (FP8) asm volatile("v_mfma_scale_f32_16x16x128_f8f6f4 %0, %1, %2, %0, %3, %3 op_sel_hi:[0,0,0]" : "+v"(acc[ai][bj][m][n]) : "v"(Bt##8[n]), "v"(At##8[m]), "v"(scl1));   \
        else { _Pragma("unroll") for (int k = 0; k < 2; ++k) acc[ai][bj][m][n] = __builtin_amdgcn_mfma_f32_16x16x32_bf16(Bt[n][k], At[m][k], acc[ai][bj][m][n], 0, 0, 0); } } \
        __builtin_amdgcn_s_setprio(0); } while (0)
#define PG8_WAIT_V(n) asm volatile("s_waitcnt vmcnt(" #n ")" ::: "memory")
#define PG8_WAIT_L(n) asm volatile("s_waitcnt lgkmcnt(" #n ")" ::: "memory")
#define PG8_BAR __builtin_amdgcn_s_barrier()
#define PG8_SCHED __builtin_amdgcn_sched_barrier(0)
    f32x4 acc[2][2][4][2];
#pragma unroll
    for (int a = 0; a < 2; ++a)
#pragma unroll
        for (int b = 0; b < 2; ++b)
#pragma unroll
            for (int m = 0; m < 4; ++m)
#pragma unroll
                for (int n = 0; n < 2; ++n) acc[a][b][m][n] = (f32x4){0.f, 0.f, 0.f, 0.f};
    typedef int i32x8 __attribute__((ext_vector_type(8))); typedef int i32x4 __attribute__((ext_vector_type(4)));
    const char* cA = (const char*)g.A + (size_t)cur.pa * tstepA; const char* cB = (const char*)g.Bt + (size_t)cur.pn * tstepB;
    PG8_STAGE(PG8_SB(0, 0), cB, voffB); PG8_STAGE(PG8_SB(0, 1), cB + hstep, voffB); PG8_STAGE(PG8_SA(0, 0), cA, offA[0]); PG8_STAGE(PG8_SA(0, 1), cA, offA[1]);
    if (wr == 1) PG8_BAR;
    PG8_WAIT_V(2); PG8_BAR;
    PG8_STAGE(PG8_SB(1, 0), cB + kstep, voffB); PG8_STAGE(PG8_SA(1, 0), cA + kstep, offA[0]); PG8_STAGE(PG8_SB(1, 1), cB + hstep + kstep, voffB);
    PG8_WAIT_V(6); PG8_BAR;
    for (;;) {
        const bool has_next = S.next(ui + 1, nxt);
        const char* nA = has_next ? (const char*)g.A + (size_t)nxt.pa * tstepA : cA; const char* nB = has_next ? (const char*)g.Bt + (size_t)nxt.pn * tstepB : cB;
#pragma unroll 1
        for (int t = 0; t < nt; t += 2) {
            const bool last = (t == nt - 2);
            bf16x8 At[4][2], B0[2][2], B1[2][2]; i32x8 At8[4], B08[2], B18[2];
            const char* a1 = cA + (size_t)(t + 1) * kstep;
            const char* a2 = last ? nA : cA + (size_t)(t + 2) * kstep; const char* b2 = last ? nB : cB + (size_t)(t + 2) * kstep;
            const char* a3 = a2 + kstep; const char* b3 = b2 + kstep;
            PG8_LDB(B0, 0, 0); PG8_LDB(B1, 0, 1); PG8_SCHED; PG8_LDA(At, 0, 0); PG8_STAGE(PG8_SA(1, 1), a1, offA[1]);
            PG8_WAIT_V(8); PG8_WAIT_L(0); PG8_BAR; PG8_MMA(0, 0, At, B0); PG8_MMA(0, 1, At, B1); PG8_BAR; PG8_SCHED;
            PG8_LDA(At, 0, 1); PG8_STAGE(PG8_SB(0, 0), b2, voffB); PG8_STAGE(PG8_SB(0, 1), b2 + hstep, voffB); PG8_STAGE(PG8_SA(0, 0), a2, offA[0]);
            PG8_WAIT_V(8); PG8_WAIT_L(0); PG8_BAR; PG8_MMA(1, 0, At, B0); PG8_MMA(1, 1, At, B1); PG8_BAR; PG8_SCHED;
            PG8_LDB(B0, 1, 0); PG8_LDB(B1, 1, 1); PG8_SCHED; PG8_LDA(At, 1, 0); PG8_STAGE(PG8_SA(0, 1), a2, offA[1]);
            PG8_WAIT_V(8); PG8_WAIT_L(0); PG8_BAR; PG8_MMA(0, 0, At, B0); PG8_MMA(0, 1, At, B1); PG8_BAR; PG8_SCHED;
            PG8_LDA(At, 1, 1); PG8_STAGE(PG8_SB(1, 0), b3, voffB); PG8_STAGE(PG8_SB(1, 1), b3 + hstep, voffB); PG8_STAGE(PG8_SA(1, 0), a3, offA[0]);
            PG8_WAIT_V(8); PG8_WAIT_L(0); PG8_BAR; PG8_MMA(1, 0, At, B0); PG8_MMA(1, 1, At, B1); PG8_BAR; PG8_SCHED;
        }
        if (wr == 0) PG8_BAR;
        if constexpr (FP8) asm volatile("s_nop 15\n\ts_nop 15\n\ts_nop 15\n\ts_nop 15" ::: "memory");
        { int l2_; asm volatile("v_mbcnt_lo_u32_b32 %0, -1, 0\n\tv_mbcnt_hi_u32_b32 %0, -1, %0" : "=v"(l2_)); E(acc, cur, wr, wc, l2_ & 15, l2_ >> 4); }
        if (!has_next) break;
#pragma unroll
        for (int a = 0; a < 2; ++a)
#pragma unroll
            for (int b = 0; b < 2; ++b)
#pragma unroll
                for (int m = 0; m < 4; ++m)
#pragma unroll
                    for (int n = 0; n < 2; ++n) acc[a][b][m][n] = (f32x4){0.f, 0.f, 0.f, 0.f};
        cur = nxt; cA = nA; cB = nB; ++ui;
        if (wr == 1) PG8_BAR;
    }
    PG8_WAIT_V(0);
    PG8_BAR;
#undef PG8_SA
#undef PG8_SB
#undef PG8_STAGE
#undef PG8_LDA
#undef PG8_LDB
#undef PG8_MMA
#undef PG8_WAIT_V
#undef PG8_WAIT_L
#undef PG8_BAR
#undef PG8_SCHED
}
}
namespace att {
using bf16_t = unsigned short;
using bf16x8 = __attribute__((ext_vector_type(8))) short;
using s16x4 = __attribute__((ext_vector_type(4))) short;
using f32x16 = __attribute__((ext_vector_type(16))) float;
using u32x4 = __attribute__((ext_vector_type(4))) unsigned;
typedef short v4i16_t __attribute__((ext_vector_type(4)));
typedef __attribute__((address_space(3))) const char* lds_cptr;
typedef float f32x2_t __attribute__((ext_vector_type(2))); typedef __bf16 bf16x2_t __attribute__((ext_vector_type(2)));
constexpr int NW = 8, QBLK = 32, QB = 256, KVBLK = 64;
constexpr int NSLOT = 3, KSLOT = 12288, VSLOT = 8192;
constexpr int LDS_K = 0, LDS_V = NSLOT * KSLOT, LDS_WS = LDS_V + NSLOT * VSLOT, LDS_OST = LDS_WS + NW * 64 * 4, LDS_BYTES = LDS_OST + NW * 4096;
constexpr float NEGBIG = -1.0e30f;
constexpr float THR = 8.0f;

__device__ __forceinline__ int crow(int r, int hi) { return (r & 3) + 8 * (r >> 2) + 4 * hi; }
__device__ __forceinline__ void glds16(const void* gsrc, unsigned lds_dst) { unsigned keep;
    asm volatile("s_mov_b32 %0, m0\n\ts_mov_b32 m0, %2\n\ts_nop 0\n\tglobal_load_lds_dwordx4 %1, off\n\ts_mov_b32 m0, %0" : "=&s"(keep) : "v"(gsrc), "s"(lds_dst) : "memory"); }
__device__ __forceinline__ unsigned cvtpk(float lo, float hi) { f32x2_t v = {lo, hi}; bf16x2_t b = __builtin_convertvector(v, bf16x2_t); return __builtin_bit_cast(unsigned, b); }
__device__ __forceinline__ s16x4 vtr(lds_cptr p) { return __builtin_bit_cast(s16x4, __builtin_amdgcn_ds_read_tr16_b64_v4i16((__attribute__((address_space(3))) v4i16_t*)p)); }
__device__ __forceinline__ float swapmax(float m) { auto rr = __builtin_amdgcn_permlane32_swap(__float_as_uint(m), __float_as_uint(m), false, false); return __builtin_fmaxf(__uint_as_float(rr[0]), __uint_as_float(rr[1])); }
__device__ __forceinline__ float swapadd(float m) { auto rr = __builtin_amdgcn_permlane32_swap(__float_as_uint(m), __float_as_uint(m), false, false); return __uint_as_float(rr[0]) + __uint_as_float(rr[1]); }
__device__ __forceinline__ float fadd_s(float a, float b) { float r; asm("v_add_f32_e32 %0, %1, %2" : "=v"(r) : "v"(a), "v"(b)); return r; }
__device__ __forceinline__ int lane_now() { int l; asm volatile("v_mbcnt_lo_u32_b32 %0, -1, 0\n\tv_mbcnt_hi_u32_b32 %0, -1, %0" : "=v"(l)); return l; }
#ifndef ATT_SBM1
#define ATT_SBM1 0
#endif
#ifndef ATT_SHV
#define ATT_SHV 1
#endif
#ifndef ATT_DEEP
#define ATT_DEEP 1
#endif
#ifndef ATT_SMAX
#define ATT_SMAX 1
#endif
#define ATT_WAIT_BAR(N) asm volatile("s_waitcnt vmcnt(" #N ") lgkmcnt(0)\n\ts_barrier" ::: "memory")

struct Job {
    const bf16_t* Q; int qs;
    const bf16_t* K0; int ks0;
    const bf16_t* K1; int ks1;
    const bf16_t* V; int vs;
    bf16_t* O; int os; long omap;
    float* LSE; int ls; long lmap;
    int q0, t_lo, t_hi, max_dist;
    float slope2, sink2;
    const f32x2_t* rope;
    float kmax2[2];
};

template <int NCH, int NMAP, bool ALIBI, int EPI, bool QROPE = false, bool TRUNC = false, int XP = 0, bool STAG = false>
__device__ __forceinline__ void attn_unit(const Job& J, char* shm, unsigned* qhead, volatile __attribute__((address_space(3))) unsigned* qslot, const int wave_id) {
    constexpr int NPK = 2 * NCH * NMAP;
    static_assert(!STAG || NMAP == 1, "STAG: single map");
    constexpr bool DEEP = (ATT_DEEP != 0) && !STAG;
    constexpr int AHEAD = DEEP ? 3 : 2;
    constexpr int NS = (STAG || DEEP) ? 4 : 3, LDS_K = 0, LDS_V = NS * KSLOT, LDS_WS = LDS_V + NS * VSLOT, LDS_OST = LDS_WS + NW * 64 * 4;
    int lane_; asm volatile("v_mbcnt_lo_u32_b32 %0, -1, 0\n\tv_mbcnt_hi_u32_b32 %0, -1, %0" : "=v"(lane_));
    const int wid = wave_id, lane = lane_, tid = wid * 64 + lane, r32 = lane & 31, hi = lane >> 5;
    unsigned q_next = 0; if (tid == 0) q_next = __hip_atomic_fetch_add(qhead, 1u, __ATOMIC_RELAXED, __HIP_MEMORY_SCOPE_AGENT);
    const unsigned lds0 = (unsigned)(uintptr_t)shm;
    float* wsf = (float*)(shm + LDS_WS) + wid * 64;
    const unsigned koffA = (unsigned)(lane * J.ks0 + wid * 8) * 2u, koffB = (NPK > 8) ? (unsigned)(lane * J.ks1 + wid * 8) * 2u : 0u;
    const unsigned voff = (unsigned)((16 * (wid & 3) + (lane >> 2)) * J.vs + (wid >> 2) * 32 + (lane & 3) * 8) * 2u;
    const long kstepA = (long)KVBLK * J.ks0 * 2, kstepB = (NPK > 8) ? (long)KVBLK * J.ks1 * 2 : 0, vstep = (long)KVBLK * J.vs * 2;
    const unsigned kdst = lds0 + LDS_K + wid * 1024, vdst = lds0 + LDS_V + wid * 1024;
    const bool extraK = (NPK > 8) && (wid < NPK - 8);
#define ATT_DMA(t, slot) do { if (XP == 4) break; pg8::glds_s(koffA, (const char*)J.K0 + (long)(t) * kstepA, kdst + (slot) * KSLOT); \
        if (extraK) pg8::glds_s(koffB, (const char*)J.K1 + (long)(t) * kstepB, kdst + (slot) * KSLOT + 8192); \
        pg8::glds_s(voff, (const char*)J.V + (long)(t) * vstep, vdst + (slot) * VSLOT); } while (0)
    const int qw = J.q0 + wid * QBLK;
    const int nq = qw + r32;
    if constexpr (!ALIBI) { if (J.t_lo < J.t_hi) ATT_DMA(J.t_lo, 0); if (J.t_lo + 1 < J.t_hi) ATT_DMA(J.t_lo + 1, 1); if (DEEP && J.t_lo + 2 < J.t_hi) ATT_DMA(J.t_lo + 2, 2); }
    bf16x8 qr[NMAP][NCH];
    { const bf16_t* qp = J.Q + (long)nq * J.qs + hi * 8;
#pragma unroll
      for (int m = 0; m < NMAP; ++m)
#pragma unroll
        for (int c = 0; c < NCH; ++c) qr[m][c] = *reinterpret_cast<const bf16x8*>(qp + (m * NCH + c) * 16); }
    if constexpr (QROPE) {
        const f32x2_t* rt = J.rope + (size_t)nq * 16 + hi * 4;
#pragma unroll
        for (int c = 0; c < 2; ++c) { bf16x8 q = qr[0][NCH - 2 + c]; bf16x8 r;
#pragma unroll
            for (int i = 0; i < 4; ++i) { const f32x2_t cs = rt[c * 8 + i]; const float a = __uint_as_float((unsigned)(unsigned short)q[2 * i] << 16), b = __uint_as_float((unsigned)(unsigned short)q[2 * i + 1] << 16);
                const unsigned w = cvtpk(a * cs.x - b * cs.y, b * cs.x + a * cs.y); r[2 * i] = (short)(w & 0xffffu); r[2 * i + 1] = (short)(w >> 16); }
            qr[0][NCH - 2 + c] = r; }
    }
    int t_lo = J.t_lo; const int t_hi = J.t_hi; int soft_dist = 1 << 28; float qk2row[NMAP]; bool stat = false;
    if constexpr (TRUNC) {
        float b2 = 0.f;
#pragma unroll
        for (int m = 0; m < NMAP; ++m) { float q2 = 0.f;
#pragma unroll
            for (int c = 0; c < NCH; ++c)
#pragma unroll
                for (int e = 0; e < 8; ++e) { const float x = __uint_as_float((unsigned)(unsigned short)qr[m][c][e] << 16); q2 += x * x; }
            q2 = swapadd(q2); qk2row[m] = q2 * J.kmax2[m];
#pragma unroll
            for (int o_ = 1; o_ < 32; o_ <<= 1) q2 = fmaxf(q2, __int_as_float(__builtin_amdgcn_ds_bpermute((lane ^ o_) << 2, __float_as_int(q2))));
            b2 = fmaxf(b2, q2 * J.kmax2[m]); }
        float* xq = (float*)(shm + LDS_OST);
        if (lane == 0) xq[wid] = b2;
        asm volatile("s_waitcnt lgkmcnt(0)\n\ts_barrier" ::: "memory");
        float bm = xq[0];
#pragma unroll
        for (int w_ = 1; w_ < NW; ++w_) bm = fmaxf(bm, xq[w_]);
        if constexpr (ALIBI) {
        const float bound = 2.02f * __builtin_sqrtf(bm) + 80.f;
        const float dmin = bound / J.slope2;
        soft_dist = __builtin_amdgcn_readfirstlane(dmin < 1.0e8f ? (int)dmin + 1 : (1 << 28));
        const int tl = (J.q0 - soft_dist) >> 6; t_lo = tl > t_lo ? tl : t_lo;
        }
        stat = ATT_SMAX && (1.01f * __builtin_sqrtf(bm) <= 50.f);
    }
    if constexpr (ALIBI) { if (t_lo < t_hi) ATT_DMA(t_lo, 0); if (t_lo + 1 < t_hi) ATT_DMA(t_lo + 1, 1); if (DEEP && t_lo + 2 < t_hi) ATT_DMA(t_lo + 2, 2); }
    if (!(t_lo < t_hi)) { __builtin_amdgcn_s_barrier(); if (tid == 0) *qslot = q_next; }
#ifndef ATT_SB
#define ATT_SB 1
#endif
#ifndef ATT_ONES
#define ATT_ONES 0
#endif
#ifndef ATT_HALF
#define ATT_HALF 0
#endif
    constexpr bool ONES = (NMAP == 1) && ATT_ONES;
    float mhat[NMAP], lsum[NMAP]; f32x16 o[NMAP][2]; f32x16 osum, negm;
    float zero_ = 0.f; asm volatile("" : "+v"(zero_));
#pragma unroll
    for (int m = 0; m < NMAP; ++m) { mhat[m] = -1000.f; lsum[m] = 0.f;
#pragma unroll
        for (int r = 0; r < 16; ++r) { o[m][0][r] = zero_; o[m][1][r] = zero_; } }
#pragma unroll
    for (int r = 0; r < 16; ++r) { osum[r] = zero_; negm[r] = 1000.f + zero_; }
    if constexpr (TRUNC) { if (stat) {
#pragma unroll
        for (int m = 0; m < NMAP; ++m) mhat[m] = 1.01f * __builtin_sqrtf(qk2row[m]);
        if (!ALIBI) {
#pragma unroll
            for (int r = 0; r < 16; ++r) negm[r] = -mhat[0]; } } }
    const bf16x8 ones = (bf16x8){0x3f80, 0x3f80, 0x3f80, 0x3f80, 0x3f80, 0x3f80, 0x3f80, 0x3f80};
    const lds_cptr shm3 = (lds_cptr)shm;
    const lds_cptr kp0 = shm3 + LDS_K + hi * 1024 + r32 * 16;
    const lds_cptr vp0 = shm3 + LDS_V + ((lane >> 4) & 1) * 32 + (lane & 3) * 8 + (4 * hi + ((lane & 15) >> 2)) * 64;
    int slot = 0; u32x4 ppw[4]; bool pend = false; const bool late = STAG && ((wid & 1) != 0);
    for (int t = t_lo; t < t_hi; ++t) {
        if (XP == 5) { asm volatile("s_waitcnt vmcnt(3) lgkmcnt(0)" ::: "memory"); } else
        if (DEEP && t + 2 < t_hi) { if (extraK) ATT_WAIT_BAR(6); else ATT_WAIT_BAR(4); } else
        if (t + 1 < t_hi) { if (extraK) ATT_WAIT_BAR(3); else ATT_WAIT_BAR(2); } else ATT_WAIT_BAR(0);
        if (t == t_lo && tid == 0) *qslot = q_next;
        if (t + AHEAD < t_hi) { const int s2 = (slot + AHEAD >= NS) ? slot + AHEAD - NS : slot + AHEAD; ATT_DMA(t + AHEAD, s2); }
        if constexpr (STAG) { if (pend) { const lds_cptr vq = vp0 + ((slot == 0) ? NS - 1 : slot - 1) * VSLOT;
#pragma unroll
            for (int d0 = 0; d0 < 2; ++d0) {
#pragma unroll
                for (int ks = 0; ks < 4; ++ks) { const s16x4 vl = vtr(vq + d0 * 4096 + ks * 1024), vh = vtr(vq + d0 * 4096 + ks * 1024 + 512);
                    const bf16x8 vf = (bf16x8){vl[0], vl[1], vl[2], vl[3], vh[0], vh[1], vh[2], vh[3]};
                    o[0][d0] = __builtin_amdgcn_mfma_f32_32x32x16_bf16(__builtin_bit_cast(bf16x8, ppw[ks]), vf, o[0][d0], 0, 0, 0); }
                __builtin_amdgcn_sched_barrier(0); }
            pend = false; } }
        const int k_lo = t * KVBLK;
        const int e0 = qw - (k_lo + 31), e1 = qw - (k_lo + 63);
        bool act0 = (k_lo <= qw + QBLK - 1) && (e0 <= J.max_dist) && (!TRUNC || e0 <= soft_dist);
        bool act1 = (k_lo + 32 <= qw + QBLK - 1) && (e1 <= J.max_dist) && (!TRUNC || e1 <= soft_dist);
        if (XP != 8 && (act0 || act1)) {
            bool clean0 = (e0 >= 0) && (qw + QBLK - 1 - k_lo <= J.max_dist), clean1 = (e1 >= 0) && (qw + QBLK - 1 - (k_lo + 32) <= J.max_dist);
            if (!ATT_HALF) { clean0 = clean0 && act0; clean1 = clean1 && act1; act0 = true; act1 = true; }
            const int dq = nq - k_lo;
            const lds_cptr kp = kp0 + slot * KSLOT; const lds_cptr vp = vp0 + slot * VSLOT;
            u32x4 pwk[4];
#pragma unroll
            for (int m = 0; m < NMAP; ++m) {
                if (ATT_SB && (m == 0 || ATT_SBM1 == 1)) __builtin_amdgcn_sched_barrier(0);
                u32x4 pw[4]; f32x16 p0, p1;
                if (ALIBI) { const float L = -mhat[m] - J.slope2 * (float)(dq - 4 * hi), L1 = L + 32.f * J.slope2;
#pragma unroll
                    for (int r = 0; r < 16; ++r) { float a_ = __builtin_fmaf(J.slope2, (float)crow(r, 0), L), b_ = __builtin_fmaf(J.slope2, (float)crow(r, 0), L1); asm("" : "+v"(a_)); asm("" : "+v"(b_)); p0[r] = a_; p1[r] = b_; } }
                else if (!(act0 && act1)) { p0 = negm; p1 = negm; }
                if (XP == 3) { } else if (act0 && act1) {
#pragma unroll
                    for (int c = 0; c < NCH; ++c) {
                        const bf16x8 b0 = XP == 6 ? qr[m][(c + 1) % NCH] : *(const __attribute__((address_space(3))) bf16x8*)(kp + (m * NCH + c) * 2048);
                        const bf16x8 b1 = XP == 6 ? qr[m][(c + 2) % NCH] : *(const __attribute__((address_space(3))) bf16x8*)(kp + (m * NCH + c) * 2048 + 512);
                        if (!ALIBI && c == 0) { p0 = __builtin_amdgcn_mfma_f32_32x32x16_bf16(b0, qr[m][c], negm, 0, 0, 0); p1 = __builtin_amdgcn_mfma_f32_32x32x16_bf16(b1, qr[m][c], negm, 0, 0, 0); }
                        else { p0 = __builtin_amdgcn_mfma_f32_32x32x16_bf16(b0, qr[m][c], p0, 0, 0, 0);
                               p1 = __builtin_amdgcn_mfma_f32_32x32x16_bf16(b1, qr[m][c], p1, 0, 0, 0); } }
                } else if (act0) {
#pragma unroll
                    for (int c = 0; c < NCH; ++c) p0 = __builtin_amdgcn_mfma_f32_32x32x16_bf16(*(const __attribute__((address_space(3))) bf16x8*)(kp + (m * NCH + c) * 2048), qr[m][c], p0, 0, 0, 0);
                } else {
#pragma unroll
                    for (int c = 0; c < NCH; ++c) p1 = __builtin_amdgcn_mfma_f32_32x32x16_bf16(*(const __attribute__((address_space(3))) bf16x8*)(kp + (m * NCH + c) * 2048 + 512), qr[m][c], p1, 0, 0, 0);
                }
                const int lo = dq - J.max_dist;
                if (!act0) {
#pragma unroll
                    for (int r = 0; r < 16; ++r) p0[r] = NEGBIG;
                } else if (!clean0) {
#pragma unroll
                    for (int r = 0; r < 16; ++r) { const int kl = crow(r, hi); if (kl > dq || kl < lo) p0[r] = NEGBIG; }
                }
                if (!act1) {
#pragma unroll
                    for (int r = 0; r < 16; ++r) p1[r] = NEGBIG;
                } else if (!clean1) {
#pragma unroll
                    for (int r = 0; r < 16; ++r) { const int kl = crow(r, hi) + 32; if (kl > dq || kl < lo) p1[r] = NEGBIG; }
                }
                float rm = 0.f;
                if (XP != 1 && !stat) { float a = __builtin_fmaxf(__builtin_fmaxf(p0[0], p0[1]), p1[0]), b = __builtin_fmaxf(__builtin_fmaxf(p0[2], p0[3]), p1[1]); a = __builtin_fmaxf(__builtin_fmaxf(a, p1[2]), p1[3]);
#pragma unroll
                  for (int r = 4; r < 16; r += 4) { a = __builtin_fmaxf(__builtin_fmaxf(a, p0[r]), p0[r + 1]); b = __builtin_fmaxf(__builtin_fmaxf(b, p0[r + 2]), p0[r + 3]);
                      a = __builtin_fmaxf(__builtin_fmaxf(a, p1[r]), p1[r + 1]); b = __builtin_fmaxf(__builtin_fmaxf(b, p1[r + 2]), p1[r + 3]); }
                  rm = swapmax(__builtin_fmaxf(a, b)); }
                if (__any(rm > THR)) {
                    const float dl = __builtin_fmaxf(rm, 0.f); mhat[m] += dl;
#pragma unroll
                    for (int r = 0; r < 16; ++r) { p0[r] -= dl; p1[r] -= dl; }
                    if (!ALIBI) {
#pragma unroll
                        for (int r = 0; r < 16; ++r) negm[r] = -mhat[m];
                    }
                    const float f = __builtin_amdgcn_exp2f(-dl); lsum[m] *= f;
                    if (hi == 0) wsf[m * 32 + r32] = f;
                    asm volatile("s_waitcnt lgkmcnt(0)" ::: "memory");
#pragma unroll
                    for (int r = 0; r < 16; ++r) { const float fr_ = wsf[m * 32 + crow(r, hi)]; o[m][0][r] *= fr_; o[m][1][r] *= fr_; if (ONES) osum[r] *= fr_; }
                }
                if (act0) { float sacc = 0.f;
#pragma unroll
                    for (int r = 0; r < 16; ++r) { if (XP != 1) { float x_ = __builtin_amdgcn_exp2f(p0[r]); asm("" : "+v"(x_)); p0[r] = x_; if (!ONES) sacc += x_; } }
                    if (!ONES) lsum[m] += sacc;
                    pw[0] = (u32x4){cvtpk(p0[0], p0[1]), cvtpk(p0[2], p0[3]), cvtpk(p0[4], p0[5]), cvtpk(p0[6], p0[7])};
                    pw[1] = (u32x4){cvtpk(p0[8], p0[9]), cvtpk(p0[10], p0[11]), cvtpk(p0[12], p0[13]), cvtpk(p0[14], p0[15])}; }
                if (act1) { float sacc = 0.f;
#pragma unroll
                    for (int r = 0; r < 16; ++r) { if (XP != 1) { float x_ = __builtin_amdgcn_exp2f(p1[r]); asm("" : "+v"(x_)); p1[r] = x_; if (!ONES) sacc += x_; } }
                    if (!ONES) lsum[m] += sacc;
                    pw[2] = (u32x4){cvtpk(p1[0], p1[1]), cvtpk(p1[2], p1[3]), cvtpk(p1[4], p1[5]), cvtpk(p1[6], p1[7])};
                    pw[3] = (u32x4){cvtpk(p1[8], p1[9]), cvtpk(p1[10], p1[11]), cvtpk(p1[12], p1[13]), cvtpk(p1[14], p1[15])}; }
                if (ATT_SB && !((NMAP == 2) && (ATT_SHV != 0) && (XP == 0) && !STAG && m == 0 && ATT_SBM1 == 2)) __builtin_amdgcn_sched_barrier(0);
#define ATT_PV(KS0, KS1) do { _Pragma("unroll") for (int d0 = 0; d0 < 2; ++d0) { _Pragma("unroll") for (int ks = (KS0); ks < (KS1); ++ks) { \
                        bf16x8 vf; if (XP == 7) vf = qr[m][(d0 * 4 + ks) % NCH]; else { const s16x4 vl = vtr(vp + d0 * 4096 + ks * 1024), vh = vtr(vp + d0 * 4096 + ks * 1024 + 512); \
                        vf = (bf16x8){vl[0], vl[1], vl[2], vl[3], vh[0], vh[1], vh[2], vh[3]}; } \
                        o[m][d0] = __builtin_amdgcn_mfma_f32_32x32x16_bf16(__builtin_bit_cast(bf16x8, pw[ks]), vf, o[m][d0], 0, 0, 0); \
                        if (ONES && d0 == 0) osum = __builtin_amdgcn_mfma_f32_32x32x16_bf16(__builtin_bit_cast(bf16x8, pw[ks]), ones, osum, 0, 0, 0); } \
                    if (ATT_SB) __builtin_amdgcn_sched_barrier(0); } } while (0)
#define ATT_PV2(KS0, KS1) do { _Pragma("unroll") for (int d0 = 0; d0 < 2; ++d0) { _Pragma("unroll") for (int ks = (KS0); ks < (KS1); ++ks) { \
                        const s16x4 vl = vtr(vp + d0 * 4096 + ks * 1024), vh = vtr(vp + d0 * 4096 + ks * 1024 + 512); const bf16x8 vf = (bf16x8){vl[0], vl[1], vl[2], vl[3], vh[0], vh[1], vh[2], vh[3]}; \
                        o[0][d0] = __builtin_amdgcn_mfma_f32_32x32x16_bf16(__builtin_bit_cast(bf16x8, pwk[ks]), vf, o[0][d0], 0, 0, 0); \
                        o[NMAP - 1][d0] = __builtin_amdgcn_mfma_f32_32x32x16_bf16(__builtin_bit_cast(bf16x8, pw[ks]), vf, o[NMAP - 1][d0], 0, 0, 0); } \
                    if (ATT_SB) __builtin_amdgcn_sched_barrier(0); } } while (0)
                constexpr bool SHV = (NMAP == 2) && (ATT_SHV != 0) && (XP == 0) && !STAG;
                if (SHV && m == 0) { pwk[0] = pw[0]; pwk[1] = pw[1]; pwk[2] = pw[2]; pwk[3] = pw[3]; }
                else if (SHV) { if (act0 && act1) ATT_PV2(0, 4); else if (act0) ATT_PV2(0, 2); else ATT_PV2(2, 4); }
                else if (XP == 2) { o[m][0][0] += __uint_as_float(pw[0][0] ^ pw[1][1] ^ pw[2][2] ^ pw[3][3]); }
                else if (STAG && late) { ppw[0] = pw[0]; ppw[1] = pw[1]; ppw[2] = pw[2]; ppw[3] = pw[3]; pend = true; }
                else if (act0 && act1) ATT_PV(0, 4); else if (act0) ATT_PV(0, 2); else ATT_PV(2, 4);
#undef ATT_PV
#undef ATT_PV2
            }
        }
        slot = (slot == NS - 1) ? 0 : slot + 1;
    }
    if constexpr (STAG) { if (pend) { const lds_cptr vq = vp0 + ((slot == 0) ? NS - 1 : slot - 1) * VSLOT;
#pragma unroll
        for (int d0 = 0; d0 < 2; ++d0)
#pragma unroll
            for (int ks = 0; ks < 4; ++ks) { const s16x4 vl = vtr(vq + d0 * 4096 + ks * 1024), vh = vtr(vq + d0 * 4096 + ks * 1024 + 512);
                const bf16x8 vf = (bf16x8){vl[0], vl[1], vl[2], vl[3], vh[0], vh[1], vh[2], vh[3]};
                o[0][d0] = __builtin_amdgcn_mfma_f32_32x32x16_bf16(__builtin_bit_cast(bf16x8, ppw[ks]), vf, o[0][d0], 0, 0, 0); } } }
#pragma unroll
    for (int m = 0; m < NMAP; ++m) {
        float l;
        if (ONES) {
            if (r32 == 0) {
#pragma unroll
                for (int r = 0; r < 16; ++r) wsf[crow(r, hi)] = osum[r]; }
            asm volatile("s_waitcnt lgkmcnt(0)" ::: "memory");
            l = wsf[r32];
            asm volatile("s_waitcnt lgkmcnt(0)" ::: "memory");
        } else l = swapadd(lsum[m]);
        if (EPI == 3) l += __builtin_amdgcn_exp2f(J.sink2 - mhat[m]);
        if (EPI == 1) { if (hi == 0) J.LSE[m * J.lmap + (long)nq * J.ls] = mhat[m] + __builtin_amdgcn_logf(l); }
        if (hi == 0) wsf[m * 32 + r32] = l > 0.f ? __builtin_amdgcn_rcpf(l) : 0.f;
    }
    asm volatile("s_waitcnt lgkmcnt(0)" ::: "memory");
#pragma unroll
    for (int m = 0; m < NMAP; ++m) {
        __hip_bfloat16* stg = (__hip_bfloat16*)(shm + LDS_OST) + wid * 2048;
#pragma unroll
        for (int r = 0; r < 16; ++r) { const int orow = crow(r, hi); const float rl = wsf[m * 32 + orow];
#pragma unroll
            for (int d0 = 0; d0 < 2; ++d0) stg[orow * 64 + d0 * 32 + r32] = __float2bfloat16(o[m][d0][r] * rl); }
        asm volatile("s_waitcnt lgkmcnt(0)" ::: "memory");
        bf16_t* Ow = J.O + m * J.omap + (long)qw * J.os;
#pragma unroll
        for (int i = 0; i < 4; ++i) { const int row = i * 8 + (lane >> 3), ch = lane & 7; const u32x4 v = *(const u32x4*)((const bf16_t*)stg + row * 64 + ch * 8);
            *(u32x4*)(Ow + (long)row * J.os + ch * 8) = v; }
        asm volatile("s_waitcnt lgkmcnt(0)" ::: "memory");
    }
    asm volatile("s_waitcnt lgkmcnt(0)\n\ts_barrier" ::: "memory");
#undef ATT_DMA
}
}

namespace att {
constexpr int P_NSLOT = 4, P_LDS_K = 0, P_LDS_V = P_NSLOT * KSLOT, P_LDS_WS = P_LDS_V + P_NSLOT * VSLOT, P_LDS_OST = P_LDS_WS + NW * 64 * 4, P_LDS_BYTES = P_LDS_OST + NW * 4096;
template <int NCH, bool ALIBI, int EPI, bool QROPE = false>
__device__ __forceinline__ void attn_unit2(const Job& J, char* shm, unsigned* qhead, volatile __attribute__((address_space(3))) unsigned* qslot, const int wave_id) {
    constexpr int NQK = 2 * NCH;
    int lane_; asm volatile("v_mbcnt_lo_u32_b32 %0, -1, 0\n\tv_mbcnt_hi_u32_b32 %0, -1, %0" : "=v"(lane_));
    const int wid = wave_id, lane = lane_, tid = wid * 64 + lane, r32 = lane & 31, hi = lane >> 5;
    unsigned q_next = 0; if (tid == 0) q_next = __hip_atomic_fetch_add(qhead, 1u, __ATOMIC_RELAXED, __HIP_MEMORY_SCOPE_AGENT);
    const unsigned lds0 = (unsigned)(uintptr_t)shm;
    float* wsf = (float*)(shm + P_LDS_WS) + wid * 64;
    const unsigned koffA = (unsigned)(lane * J.ks0 + wid * 8) * 2u, koffB = (NQK > 8) ? (unsigned)(lane * J.ks1 + wid * 8) * 2u : 0u;
    const unsigned voff = (unsigned)((16 * (wid & 3) + (lane >> 2)) * J.vs + (wid >> 2) * 32 + (lane & 3) * 8) * 2u;
    const long kstepA = (long)KVBLK * J.ks0 * 2, kstepB = (NQK > 8) ? (long)KVBLK * J.ks1 * 2 : 0, vstep = (long)KVBLK * J.vs * 2;
    const unsigned kdst = lds0 + P_LDS_K + wid * 1024, vdst = lds0 + P_LDS_V + wid * 1024;
    const bool extraK = (NQK > 8) && (wid < NQK - 8);
#define ATT2_DMA(t, slot) do { pg8::glds_s(koffA, (const char*)J.K0 + (long)(t) * kstepA, kdst + (slot) * KSLOT); \
        if (extraK) pg8::glds_s(koffB, (const char*)J.K1 + (long)(t) * kstepB, kdst + (slot) * KSLOT + 8192); \
        pg8::glds_s(voff, (const char*)J.V + (long)(t) * vstep, vdst + (slot) * VSLOT); } while (0)
    const int qw = J.q0 + wid * QBLK, nq = qw + r32;
    bf16x8 qr[NCH];
    { const bf16_t* qp = J.Q + (long)nq * J.qs + hi * 8;
#pragma unroll
      for (int c = 0; c < NCH; ++c) qr[c] = *reinterpret_cast<const bf16x8*>(qp + c * 16); }
    if constexpr (QROPE) {
        const f32x2_t* rt = J.rope + (size_t)nq * 16 + hi * 4;
#pragma unroll
        for (int c = 0; c < 2; ++c) { bf16x8 q = qr[NCH - 2 + c]; bf16x8 r;
#pragma unroll
            for (int i = 0; i < 4; ++i) { const f32x2_t cs = rt[c * 8 + i]; const float a = __uint_as_float((unsigned)(unsigned short)q[2 * i] << 16), b = __uint_as_float((unsigned)(unsigned short)q[2 * i + 1] << 16);
                const unsigned w = cvtpk(a * cs.x - b * cs.y, b * cs.x + a * cs.y); r[2 * i] = (short)(w & 0xffffu); r[2 * i + 1] = (short)(w >> 16); }
            qr[NCH - 2 + c] = r; __builtin_amdgcn_sched_barrier(0); }
    }
    __builtin_amdgcn_sched_barrier(0);
    const int t_lo = J.t_lo, t_hi = J.t_hi;
    int tw_lo = t_lo; if (J.max_dist < (1 << 27)) { const int a = (qw - J.max_dist) >> 6; tw_lo = a > tw_lo ? a : tw_lo; }
    int tw_hi = ((qw + QBLK - 1) >> 6) + 1; tw_hi = tw_hi < t_hi ? tw_hi : t_hi;
    ATT2_DMA(t_lo, 0); if (t_lo + 1 < t_hi) ATT2_DMA(t_lo + 1, 1);
    float mhat = -1000.f, lsum = 0.f; f32x16 o[2], negm, pc0, pc1, pn0, pn1;
    float zero_ = 0.f; asm volatile("" : "+v"(zero_));
#pragma unroll
    for (int r = 0; r < 16; ++r) { o[0][r] = zero_; o[1][r] = zero_; negm[r] = 1000.f + zero_; pc0[r] = zero_; pc1[r] = zero_; }
    const lds_cptr shm3 = (lds_cptr)shm;
    const lds_cptr kp0 = shm3 + P_LDS_K + hi * 1024 + r32 * 16;
    const lds_cptr vp0 = shm3 + P_LDS_V + ((lane >> 4) & 1) * 32 + (lane & 3) * 8 + (4 * hi + ((lane & 15) >> 2)) * 64;
    bool have_cur = false;
#define ATT2_PC(e) ((e) < 16 ? pc0[(e) & 15] : pc1[(e) & 15])
    for (int i = t_lo - 1; i < t_hi; ++i) {
        if (i + 2 < t_hi) { if (extraK) ATT_WAIT_BAR(3); else ATT_WAIT_BAR(2); } else ATT_WAIT_BAR(0);
        if (i == t_lo - 1 && tid == 0) *qslot = q_next;
        if (i + 3 < t_hi) ATT2_DMA(i + 3, (i + 3 - t_lo) & 3);
        const bool do_next = (i + 1 >= tw_lo) && (i + 1 < tw_hi), do_cur = have_cur;
        const lds_cptr kp = kp0 + ((i + 1 - t_lo) & 3) * KSLOT; const lds_cptr vp = vp0 + ((i - t_lo) & 3) * VSLOT;
        const int k_lo = (i + 1) * KVBLK, dq = nq - k_lo;
        u32x4 pw[4]; float sacc = 0.f;
#define ATT2_INIT() do { if (ALIBI) { const float L = -mhat - J.slope2 * (float)(dq - 4 * hi), L1 = L + 32.f * J.slope2; \
                _Pragma("unroll") for (int r = 0; r < 16; ++r) { pn0[r] = __builtin_fmaf(J.slope2, (float)crow(r, 0), L); pn1[r] = __builtin_fmaf(J.slope2, (float)crow(r, 0), L1); } } \
            else { const float L = -mhat; _Pragma("unroll") for (int r = 0; r < 16; ++r) { pn0[r] = L; pn1[r] = L; } } } while (0)
#define ATT2_KLD(j) (*(const __attribute__((address_space(3))) bf16x8*)(kp + ((j) >> 1) * 2048 + ((j) & 1) * 512))
        if (do_next && do_cur) {
            ATT2_INIT();
            bf16x8 kf[NQK]; kf[0] = ATT2_KLD(0); kf[1] = ATT2_KLD(1);
            __builtin_amdgcn_sched_barrier(0);
#pragma unroll
            for (int j = 0; j < NQK; ++j) {
                if (j + 2 < NQK) kf[j + 2] = ATT2_KLD(j + 2);
                if ((j & 1) == 0) pn0 = __builtin_amdgcn_mfma_f32_32x32x16_bf16(kf[j], qr[j >> 1], pn0, 0, 0, 0);
                else pn1 = __builtin_amdgcn_mfma_f32_32x32x16_bf16(kf[j], qr[j >> 1], pn1, 0, 0, 0);
                const int e0 = j * 32 / NQK, e1 = (j + 1) * 32 / NQK;
#pragma unroll
                for (int e = e0; e < e1; ++e) { const float x = __builtin_amdgcn_exp2f(ATT2_PC(e)); if (e < 16) pc0[e & 15] = x; else pc1[e & 15] = x; sacc += x; }
#pragma unroll
                for (int k = e0 / 2; k < e1 / 2; ++k) pw[k >> 2][k & 3] = cvtpk(ATT2_PC(2 * k), ATT2_PC(2 * k + 1));
                asm volatile("" : "+v"(sacc));
                __builtin_amdgcn_sched_barrier(0);
            }
        } else if (do_next) {
            ATT2_INIT();
#pragma unroll
            for (int j = 0; j < NQK; ++j) { const bf16x8 kfj = ATT2_KLD(j);
                if ((j & 1) == 0) pn0 = __builtin_amdgcn_mfma_f32_32x32x16_bf16(kfj, qr[j >> 1], pn0, 0, 0, 0);
                else pn1 = __builtin_amdgcn_mfma_f32_32x32x16_bf16(kfj, qr[j >> 1], pn1, 0, 0, 0); }
        } else if (do_cur) {
#pragma unroll
            for (int e = 0; e < 32; ++e) { const float x = __builtin_amdgcn_exp2f(ATT2_PC(e)); if (e < 16) pc0[e & 15] = x; else pc1[e & 15] = x; sacc += x; }
#pragma unroll
            for (int k = 0; k < 16; ++k) pw[k >> 2][k & 3] = cvtpk(ATT2_PC(2 * k), ATT2_PC(2 * k + 1));
        }
#undef ATT2_INIT
#undef ATT2_KLD
        lsum += sacc;
        if (do_next) { const bool clean = (k_lo + KVBLK - 1 <= qw) && (qw + QBLK - 1 - k_lo <= J.max_dist);
            if (!clean) { const int lo = dq - J.max_dist;
#pragma unroll
                for (int r = 0; r < 16; ++r) { const int kl = crow(r, hi); if (kl > dq || kl < lo) pn0[r] = NEGBIG; if (kl + 32 > dq || kl + 32 < lo) pn1[r] = NEGBIG; } } }
        __builtin_amdgcn_sched_barrier(0);
        float ma = NEGBIG, mb = NEGBIG;
#define ATT2_VLD(g, VL, VH) do { VL = vtr(vp + ((g) >> 2) * 4096 + ((g) & 3) * 1024); VH = vtr(vp + ((g) >> 2) * 4096 + ((g) & 3) * 1024 + 512); } while (0)
        if (do_cur && do_next) {
            s16x4 vl[8], vh[8]; ATT2_VLD(0, vl[0], vh[0]);
            __builtin_amdgcn_sched_barrier(0);
#pragma unroll
            for (int g = 0; g < 8; ++g) {
                if (g + 1 < 8) ATT2_VLD(g + 1, vl[g + 1], vh[g + 1]);
                const bf16x8 vf = (bf16x8){vl[g][0], vl[g][1], vl[g][2], vl[g][3], vh[g][0], vh[g][1], vh[g][2], vh[g][3]};
                o[g >> 2] = __builtin_amdgcn_mfma_f32_32x32x16_bf16(__builtin_bit_cast(bf16x8, pw[g & 3]), vf, o[g >> 2], 0, 0, 0);
                if (g < 4) { ma = __builtin_fmaxf(__builtin_fmaxf(ma, pn0[4 * g]), pn0[4 * g + 1]); mb = __builtin_fmaxf(__builtin_fmaxf(mb, pn0[4 * g + 2]), pn0[4 * g + 3]); }
                else { ma = __builtin_fmaxf(__builtin_fmaxf(ma, pn1[4 * g - 16]), pn1[4 * g - 15]); mb = __builtin_fmaxf(__builtin_fmaxf(mb, pn1[4 * g - 14]), pn1[4 * g - 13]); }
                asm volatile("" : "+v"(ma), "+v"(mb));
                __builtin_amdgcn_sched_barrier(0);
            }
        } else if (do_cur) {
#pragma unroll
            for (int g = 0; g < 8; ++g) { s16x4 vl_, vh_; ATT2_VLD(g, vl_, vh_);
                const bf16x8 vf = (bf16x8){vl_[0], vl_[1], vl_[2], vl_[3], vh_[0], vh_[1], vh_[2], vh_[3]};
                o[g >> 2] = __builtin_amdgcn_mfma_f32_32x32x16_bf16(__builtin_bit_cast(bf16x8, pw[g & 3]), vf, o[g >> 2], 0, 0, 0); }
        } else if (do_next) {
#pragma unroll
            for (int r = 0; r < 16; r += 2) { ma = __builtin_fmaxf(__builtin_fmaxf(ma, pn0[r]), pn0[r + 1]); mb = __builtin_fmaxf(__builtin_fmaxf(mb, pn1[r]), pn1[r + 1]); }
        }
#undef ATT2_VLD
        if (do_next) {
            const float rm = swapmax(__builtin_fmaxf(ma, mb));
            if (__any(rm > THR)) {
                const float dl = __builtin_fmaxf(rm, 0.f); mhat += dl;
#pragma unroll
                for (int r = 0; r < 16; ++r) { pn0[r] -= dl; pn1[r] -= dl; }
                if (!ALIBI) {
#pragma unroll
                    for (int r = 0; r < 16; ++r) negm[r] = -mhat;
                }
                const float f = __builtin_amdgcn_exp2f(-dl); lsum *= f;
                { const int l_ = lane_now(); if (l_ < 32) wsf[l_] = f; }
                asm volatile("s_waitcnt lgkmcnt(0)" ::: "memory");
#pragma unroll
                for (int r = 0; r < 16; ++r) { const float fr_ = wsf[crow(r, hi)]; o[0][r] *= fr_; o[1][r] *= fr_; }
            }
            pc0 = pn0; pc1 = pn1;
        }
        have_cur = do_next;
    }
#undef ATT2_PC
    { float l = swapadd(lsum);
      if (EPI == 3) l += __builtin_amdgcn_exp2f(J.sink2 - mhat);
      if (EPI == 1) { if (hi == 0) J.LSE[(long)nq * J.ls] = mhat + __builtin_amdgcn_logf(l); }
      { const int l_ = lane_now(); if (l_ < 32) wsf[l_] = l > 0.f ? __builtin_amdgcn_rcpf(l) : 0.f; } }
    asm volatile("s_waitcnt lgkmcnt(0)" ::: "memory");
    { __hip_bfloat16* stg = (__hip_bfloat16*)(shm + P_LDS_OST) + wid * 2048;
#pragma unroll
      for (int r = 0; r < 16; ++r) { const int orow = crow(r, hi); const float rl = wsf[orow];
#pragma unroll
          for (int d0 = 0; d0 < 2; ++d0) stg[orow * 64 + d0 * 32 + r32] = __float2bfloat16(o[d0][r] * rl); }
      asm volatile("s_waitcnt lgkmcnt(0)" ::: "memory");
      bf16_t* Ow = J.O + (long)qw * J.os;
#pragma unroll
      for (int i = 0; i < 4; ++i) { const int row = i * 8 + (lane >> 3), ch = lane & 7; const u32x4 v = *(const u32x4*)((const bf16_t*)stg + row * 64 + ch * 8);
          *(u32x4*)(Ow + (long)row * J.os + ch * 8) = v; } }
    asm volatile("s_waitcnt lgkmcnt(0)\n\ts_barrier" ::: "memory");
#undef ATT2_DMA
}
}

namespace att {
constexpr int BW_LDS = 16384;
template <int EPI>
__device__ __forceinline__ void band_wave(const Job& J, char* wl, float* wsf, const int wid, const unsigned q_next, volatile __attribute__((address_space(3))) unsigned* qslot) {
    int lane_; asm volatile("v_mbcnt_lo_u32_b32 %0, -1, 0\n\tv_mbcnt_hi_u32_b32 %0, -1, %0" : "=v"(lane_));
    const int lane = lane_, r32 = lane & 31, hi = lane >> 5;
    const unsigned wl0 = (unsigned)(uintptr_t)wl;
    const int qw = J.q0 + wid * QBLK, nq = qw + r32;
    bf16x8 qr[4];
    { const bf16_t* qp = J.Q + (long)nq * J.qs + hi * 8;
#pragma unroll
      for (int c = 0; c < 4; ++c) qr[c] = *reinterpret_cast<const bf16x8*>(qp + c * 16); }
    const unsigned vlo = (unsigned)((lane >> 2) * J.vs * 2 + (lane & 3) * 16);
    const long klo = (long)r32 * J.ks0 + hi * 8;
    float mhat = -1000.f, lsum = 0.f; f32x16 o[2];
    float zero_ = 0.f; asm volatile("" : "+v"(zero_));
#pragma unroll
    for (int r = 0; r < 16; ++r) { o[0][r] = zero_; o[1][r] = zero_; }
    const lds_cptr wl3 = (lds_cptr)wl;
    const lds_cptr vp0 = wl3 + ((lane >> 4) & 1) * 32 + (lane & 3) * 8 + (4 * hi + ((lane & 15) >> 2)) * 64;
    bf16x8 kA[2][4], kB[2][4], kC[1][4];
#define BW_KB(s, jb) (qw - 128 + 64 * (s) + 32 * (jb))
#define BW_LOADK(dst, s, jb) do { const int kb_ = BW_KB(s, jb) > 0 ? BW_KB(s, jb) : 0; const bf16_t* kp_ = J.K0 + (long)kb_ * J.ks0 + klo; \
        _Pragma("unroll") for (int c = 0; c < 4; ++c) dst[jb][c] = *reinterpret_cast<const bf16x8*>(kp_ + c * 16); } while (0)
#define BW_DMAV(s, jb) do { const int kb_ = BW_KB(s, jb) > 0 ? BW_KB(s, jb) : 0; \
        _Pragma("unroll") for (int i = 0; i < 4; ++i) pg8::glds_s(vlo, (const char*)(J.V + (long)(kb_ + (i & 1) * 16) * J.vs + (i >> 1) * 32), wl0 + ((s) & 1) * 8192 + (jb) * 4096 + (i >> 1) * 2048 + (i & 1) * 1024); } while (0)
    BW_DMAV(0, 0); BW_DMAV(0, 1); BW_DMAV(1, 0); BW_DMAV(1, 1);
    BW_LOADK(kA, 0, 0); BW_LOADK(kA, 0, 1); BW_LOADK(kB, 1, 0); BW_LOADK(kB, 1, 1); BW_LOADK(kC, 2, 0);
#define BW_STEP(s, KF, NB) do { \
        if ((s) != 1) asm volatile("s_waitcnt vmcnt(0)" ::: "memory"); \
        if ((s) == 0 && wid == 0 && lane == 0) *qslot = q_next;       \
        const int kb0 = BW_KB(s, 0), dq = nq - kb0; \
        f32x16 p0, p1; \
        { const float L = -mhat - J.slope2 * (float)(dq - 4 * hi), L1 = L + 32.f * J.slope2; \
          _Pragma("unroll") for (int r = 0; r < 16; ++r) { float a_ = __builtin_fmaf(J.slope2, (float)crow(r, 0), L), b_ = __builtin_fmaf(J.slope2, (float)crow(r, 0), L1); asm("" : "+v"(a_)); asm("" : "+v"(b_)); p0[r] = a_; p1[r] = b_; } } \
        _Pragma("unroll") for (int c = 0; c < 4; ++c) { p0 = __builtin_amdgcn_mfma_f32_32x32x16_bf16(KF[0][c], qr[c], p0, 0, 0, 0); \
            if ((NB) == 2) p1 = __builtin_amdgcn_mfma_f32_32x32x16_bf16(KF[1][c], qr[c], p1, 0, 0, 0); } \
          \
        { const int lo = dq - J.max_dist; const bool v0 = kb0 >= 0, v1 = kb0 + 32 >= 0; \
          if ((s) == 0) { _Pragma("unroll") for (int r = 0; r < 16; ++r) { const int kl = crow(r, hi); if (kl < lo) p0[r] = NEGBIG; } \
              if ((NB) == 2 && J.max_dist < 97) { _Pragma("unroll") for (int r = 0; r < 16; ++r) { const int kl = crow(r, hi) + 32; if (kl < lo) p1[r] = NEGBIG; } } } \
          if ((s) == 2) { _Pragma("unroll") for (int r = 0; r < 16; ++r) { const int kl = crow(r, hi); if (kl > dq) p0[r] = NEGBIG; } } \
          if (!v0) { _Pragma("unroll") for (int r = 0; r < 16; ++r) p0[r] = NEGBIG; } \
          if ((NB) == 2 && !v1) { _Pragma("unroll") for (int r = 0; r < 16; ++r) p1[r] = NEGBIG; } } \
        float rm; \
        { float a = NEGBIG, b = NEGBIG; \
          _Pragma("unroll") for (int r = 0; r < 16; r += 2) { a = __builtin_fmaxf(__builtin_fmaxf(a, p0[r]), p0[r + 1]); if ((NB) == 2) b = __builtin_fmaxf(__builtin_fmaxf(b, p1[r]), p1[r + 1]); } \
          rm = swapmax(__builtin_fmaxf(a, b)); } \
        if (__any(rm > THR)) { const float dl = __builtin_fmaxf(rm, 0.f); mhat += dl; \
            _Pragma("unroll") for (int r = 0; r < 16; ++r) { p0[r] -= dl; p1[r] -= dl; } \
            const float f = __builtin_amdgcn_exp2f(-dl); lsum *= f; \
            if (hi == 0) wsf[r32] = f; \
            asm volatile("s_waitcnt lgkmcnt(0)" ::: "memory"); \
            _Pragma("unroll") for (int r = 0; r < 16; ++r) { const float fr_ = wsf[crow(r, hi)]; o[0][r] *= fr_; o[1][r] *= fr_; } } \
        u32x4 pw[4]; float sacc = 0.f; \
        _Pragma("unroll") for (int r = 0; r < 16; ++r) { float x_ = __builtin_amdgcn_exp2f(p0[r]); asm("" : "+v"(x_)); p0[r] = x_; sacc += x_; if ((NB) == 2) { float y_ = __builtin_amdgcn_exp2f(p1[r]); asm("" : "+v"(y_)); p1[r] = y_; sacc += y_; } } \
        lsum += sacc; \
        pw[0] = (u32x4){cvtpk(p0[0], p0[1]), cvtpk(p0[2], p0[3]), cvtpk(p0[4], p0[5]), cvtpk(p0[6], p0[7])}; \
        pw[1] = (u32x4){cvtpk(p0[8], p0[9]), cvtpk(p0[10], p0[11]), cvtpk(p0[12], p0[13]), cvtpk(p0[14], p0[15])}; \
        if ((NB) == 2) { pw[2] = (u32x4){cvtpk(p1[0], p1[1]), cvtpk(p1[2], p1[3]), cvtpk(p1[4], p1[5]), cvtpk(p1[6], p1[7])}; \
            pw[3] = (u32x4){cvtpk(p1[8], p1[9]), cvtpk(p1[10], p1[11]), cvtpk(p1[12], p1[13]), cvtpk(p1[14], p1[15])}; } \
        const lds_cptr vp = vp0 + ((s) & 1) * 8192; \
        _Pragma("unroll") for (int d0 = 0; d0 < 2; ++d0) _Pragma("unroll") for (int g = 0; g < 2 * (NB); ++g) { \
            const s16x4 vl = vtr(vp + (g >> 1) * 4096 + d0 * 2048 + (g & 1) * 1024), vh = vtr(vp + (g >> 1) * 4096 + d0 * 2048 + (g & 1) * 1024 + 512); \
            const bf16x8 vf = (bf16x8){vl[0], vl[1], vl[2], vl[3], vh[0], vh[1], vh[2], vh[3]}; \
            o[d0] = __builtin_amdgcn_mfma_f32_32x32x16_bf16(__builtin_bit_cast(bf16x8, pw[g]), vf, o[d0], 0, 0, 0); } \
        if ((s) == 0) { asm volatile("s_waitcnt lgkmcnt(0)" ::: "memory"); BW_DMAV(2, 0); } \
    } while (0)
    BW_STEP(0, kA, 2);
    BW_STEP(1, kB, 2);
    BW_STEP(2, kC, 1);
#undef BW_STEP
#undef BW_LOADK
#undef BW_DMAV
#undef BW_KB
    { float l = swapadd(lsum);
      if (EPI == 3) l += __builtin_amdgcn_exp2f(J.sink2 - mhat);
      if (EPI == 1) { if (hi == 0) J.LSE[(long)nq * J.ls] = mhat + __builtin_amdgcn_logf(l); }
      if (hi == 0) wsf[r32] = l > 0.f ? __builtin_amdgcn_rcpf(l) : 0.f; }
    asm volatile("s_waitcnt lgkmcnt(0)" ::: "memory");
    { __hip_bfloat16* stg = (__hip_bfloat16*)(wl + 8192);
#pragma unroll
      for (int r = 0; r < 16; ++r) { const int orow = crow(r, hi); const float rl = wsf[orow];
#pragma unroll
          for (int d0 = 0; d0 < 2; ++d0) stg[orow * 64 + d0 * 32 + r32] = __float2bfloat16(o[d0][r] * rl); }
      asm volatile("s_waitcnt lgkmcnt(0)" ::: "memory");
      bf16_t* Ow = J.O + (long)qw * J.os;
#pragma unroll
      for (int i = 0; i < 4; ++i) { const int row = i * 8 + (lane >> 3), ch = lane & 7; const u32x4 v = *(const u32x4*)((const bf16_t*)stg + row * 64 + ch * 8);
          *(u32x4*)(Ow + (long)row * J.os + ch * 8) = v; } }
    asm volatile("s_waitcnt lgkmcnt(0)" ::: "memory");
}
template <int EPI>
__device__ __forceinline__ void band_unit(const Job& J, char* shm, float* wsf, const int wid, unsigned& q_pend, unsigned* qhead, volatile __attribute__((address_space(3))) unsigned* qslot) {
    int lane_; asm volatile("v_mbcnt_lo_u32_b32 %0, -1, 0\n\tv_mbcnt_hi_u32_b32 %0, -1, %0" : "=v"(lane_));
    const int lane = lane_, r32 = lane & 31, hi = lane >> 5;
    constexpr int BK = 0, BV = 49152, BST = 98304;
    const unsigned lds0 = (unsigned)(uintptr_t)shm; const lds_cptr shm3 = (lds_cptr)shm;
    const int qw = J.q0 + wid * QBLK, nq = qw + r32;
    { const unsigned koff = (unsigned)(lane * J.ks0 + wid * 8) * 2u;
      const unsigned voff = (unsigned)((16 * (wid & 3) + (lane >> 2)) * J.vs + (wid >> 2) * 32 + (lane & 3) * 8) * 2u;
#pragma unroll
      for (int T_ = 0; T_ < 6; ++T_) { const int key0 = J.q0 - 128 + 64 * T_;
          if (key0 >= 0) { pg8::glds_s(koff, (const char*)(J.K0 + (long)key0 * J.ks0), lds0 + BK + T_ * 8192 + wid * 1024); pg8::glds_s(voff, (const char*)(J.V + (long)key0 * J.vs), lds0 + BV + T_ * 8192 + wid * 1024); } } }
    bf16x8 qr[4];
    { const bf16_t* qp = J.Q + (long)nq * J.qs + hi * 8;
#pragma unroll
      for (int c = 0; c < 4; ++c) qr[c] = *reinterpret_cast<const bf16x8*>(qp + c * 16); }
    float mhat = -1000.f, lsum = 0.f; f32x16 o[2];
    float zero_ = 0.f; asm volatile("" : "+v"(zero_));
#pragma unroll
    for (int r = 0; r < 16; ++r) { o[0][r] = zero_; o[1][r] = zero_; }
    const lds_cptr kp0 = shm3 + BK + hi * 1024 + r32 * 16;
    const lds_cptr vp0 = shm3 + BV + ((lane >> 4) & 1) * 32 + (lane & 3) * 8 + (4 * hi + ((lane & 15) >> 2)) * 64;
    asm volatile("s_waitcnt vmcnt(0)\n\ts_barrier" ::: "memory");
    if (wid == 0 && lane == 0) { *qslot = q_pend; q_pend = __hip_atomic_fetch_add(qhead, 1u, __ATOMIC_RELAXED, __HIP_MEMORY_SCOPE_AGENT); }
#define BW_KB(s, jb) (qw - 128 + 64 * (s) + 32 * (jb))
#define BU_KF(B_, c) (*(const __attribute__((address_space(3))) bf16x8*)(kp0 + ((B_) >> 1) * 8192 + (c) * 2048 + ((B_) & 1) * 512))
#define BU_STEP(s, NB) do { \
        const int kb0 = BW_KB(s, 0), dq = nq - kb0; const int B0 = wid + 2 * (s);        \
        f32x16 p0, p1; \
        { const float L = -mhat - J.slope2 * (float)(dq - 4 * hi), L1 = L + 32.f * J.slope2; \
          _Pragma("unroll") for (int r = 0; r < 16; ++r) { float a_ = __builtin_fmaf(J.slope2, (float)crow(r, 0), L), b_ = __builtin_fmaf(J.slope2, (float)crow(r, 0), L1); asm("" : "+v"(a_)); asm("" : "+v"(b_)); p0[r] = a_; p1[r] = b_; } } \
        _Pragma("unroll") for (int c = 0; c < 4; ++c) { p0 = __builtin_amdgcn_mfma_f32_32x32x16_bf16(BU_KF(B0, c), qr[c], p0, 0, 0, 0); \
            if ((NB) == 2) p1 = __builtin_amdgcn_mfma_f32_32x32x16_bf16(BU_KF(B0 + 1, c), qr[c], p1, 0, 0, 0); } \
        { const int lo = dq - J.max_dist; const bool v0 = kb0 >= 0, v1 = kb0 + 32 >= 0; \
          if ((s) == 0) { _Pragma("unroll") for (int r = 0; r < 16; ++r) { const int kl = crow(r, hi); if (kl < lo) p0[r] = NEGBIG; } \
              if ((NB) == 2 && J.max_dist < 97) { _Pragma("unroll") for (int r = 0; r < 16; ++r) { const int kl = crow(r, hi) + 32; if (kl < lo) p1[r] = NEGBIG; } } } \
          if ((s) == 2) { _Pragma("unroll") for (int r = 0; r < 16; ++r) { const int kl = crow(r, hi); if (kl > dq) p0[r] = NEGBIG; } } \
          if (!v0) { _Pragma("unroll") for (int r = 0; r < 16; ++r) p0[r] = NEGBIG; } \
          if ((NB) == 2 && !v1) { _Pragma("unroll") for (int r = 0; r < 16; ++r) p1[r] = NEGBIG; } } \
        float rm; \
        { float a = NEGBIG, b = NEGBIG; \
          _Pragma("unroll") for (int r = 0; r < 16; r += 2) { a = __builtin_fmaxf(__builtin_fmaxf(a, p0[r]), p0[r + 1]); if ((NB) == 2) b = __builtin_fmaxf(__builtin_fmaxf(b, p1[r]), p1[r + 1]); } \
          rm = swapmax(__builtin_fmaxf(a, b)); } \
        if (__any(rm > THR)) { const float dl = __builtin_fmaxf(rm, 0.f); mhat += dl; \
            _Pragma("unroll") for (int r = 0; r < 16; ++r) { p0[r] -= dl; p1[r] -= dl; } \
            const float f = __builtin_amdgcn_exp2f(-dl); lsum *= f; \
            if (hi == 0) wsf[r32] = f; \
            asm volatile("s_waitcnt lgkmcnt(0)" ::: "memory"); \
            _Pragma("unroll") for (int r = 0; r < 16; ++r) { const float fr_ = wsf[crow(r, hi)]; o[0][r] *= fr_; o[1][r] *= fr_; } } \
        u32x4 pw[4]; float sacc = 0.f; \
        _Pragma("unroll") for (int r = 0; r < 16; ++r) { float x_ = __builtin_amdgcn_exp2f(p0[r]); asm("" : "+v"(x_)); p0[r] = x_; sacc += x_; if ((NB) == 2) { float y_ = __builtin_amdgcn_exp2f(p1[r]); asm("" : "+v"(y_)); p1[r] = y_; sacc += y_; } } \
        lsum += sacc; \
        pw[0] = (u32x4){cvtpk(p0[0], p0[1]), cvtpk(p0[2], p0[3]), cvtpk(p0[4], p0[5]), cvtpk(p0[6], p0[7])}; \
        pw[1] = (u32x4){cvtpk(p0[8], p0[9]), cvtpk(p0[10], p0[11]), cvtpk(p0[12], p0[13]), cvtpk(p0[14], p0[15])}; \
        if ((NB) == 2) { pw[2] = (u32x4){cvtpk(p1[0], p1[1]), cvtpk(p1[2], p1[3]), cvtpk(p1[4], p1[5]), cvtpk(p1[6], p1[7])}; \
            pw[3] = (u32x4){cvtpk(p1[8], p1[9]), cvtpk(p1[10], p1[11]), cvtpk(p1[12], p1[13]), cvtpk(p1[14], p1[15])}; } \
        _Pragma("unroll") for (int d0 = 0; d0 < 2; ++d0) _Pragma("unroll") for (int g = 0; g < 2 * (NB); ++g) { const int Bv = B0 + (g >> 1); \
            const lds_cptr va = vp0 + (Bv >> 1) * 8192 + d0 * 4096 + (2 * (Bv & 1) + (g & 1)) * 1024; \
            const s16x4 vl = vtr(va), vh = vtr(va + 512); \
            const bf16x8 vf = (bf16x8){vl[0], vl[1], vl[2], vl[3], vh[0], vh[1], vh[2], vh[3]}; \
            o[d0] = __builtin_amdgcn_mfma_f32_32x32x16_bf16(__builtin_bit_cast(bf16x8, pw[g]), vf, o[d0], 0, 0, 0); } \
    } while (0)
    BU_STEP(0, 2);
    BU_STEP(1, 2);
    BU_STEP(2, 1);
#undef BU_STEP
#undef BU_KF
#undef BW_KB
    { float l = swapadd(lsum);
      if (EPI == 3) l += __builtin_amdgcn_exp2f(J.sink2 - mhat);
      if (EPI == 1) { if (hi == 0) J.LSE[(long)nq * J.ls] = mhat + __builtin_amdgcn_logf(l); }
      if (hi == 0) wsf[r32] = l > 0.f ? __builtin_amdgcn_rcpf(l) : 0.f; }
    asm volatile("s_waitcnt lgkmcnt(0)" ::: "memory");
    { __hip_bfloat16* stg = (__hip_bfloat16*)(shm + BST + wid * 4096);
#pragma unroll
      for (int r = 0; r < 16; ++r) { const int orow = crow(r, hi); const float rl = wsf[orow];
#pragma unroll
          for (int d0 = 0; d0 < 2; ++d0) stg[orow * 64 + d0 * 32 + r32] = __float2bfloat16(o[d0][r] * rl); }
      asm volatile("s_waitcnt lgkmcnt(0)" ::: "memory");
      bf16_t* Ow = J.O + (long)qw * J.os;
#pragma unroll
      for (int i = 0; i < 4; ++i) { const int row = i * 8 + (lane >> 3), ch = lane & 7; const u32x4 v = *(const u32x4*)((const bf16_t*)stg + row * 64 + ch * 8);
          *(u32x4*)(Ow + (long)row * J.os + ch * 8) = v; } }
    asm volatile("s_waitcnt lgkmcnt(0)" ::: "memory");
}
}
#ifndef MK_PER_PHASE
#define MK_PER_PHASE 0
#endif
constexpr int NWAVES = 8;
constexpr int NB = 4, S = 8192, T = NB * S, D = 1024;
constexpr int NQKV = 2592, NQKVP = 2816;
constexpr int FF = 2816, FE = 3584, NEXP = 8;
constexpr float RMS_EPS = 1e-6f;
#ifndef FFN8
#define FFN8 3
#endif
constexpr float LOG2E = 1.4426950408889634f;
constexpr float MOE_WSCALE = 64.0f;
constexpr int C_QA = 0, C_KA = 256, C_VA = 512, C_QB = 768, C_KB = 1024, C_VB = 1280, C_QD = 1536, C_KD = 1792, C_VD = 1920, C_CQ = 2048, C_CKV = 2432, C_KPE = 2560;

constexpr size_t MiB = 1u << 20;
constexpr size_t WS_CTL = 0, CTL_ZERO_BYTES = 1 * MiB;
constexpr size_t WS_ROPE = 1 * MiB;
constexpr size_t WS_WIN = 2 * MiB, WIN_L = (size_t)NQKVP * D * 2;
constexpr size_t WS_WOUT = 13 * MiB, WOUT_L = (size_t)D * D * 2;
constexpr size_t WS_WUQ = 17 * MiB, WUQ_L = (size_t)512 * 384 * 2;
constexpr size_t WS_WUKV = 17 * MiB + 768 * 1024, WUKV_L = (size_t)512 * 128 * 2;
constexpr size_t WS_W13 = 18 * MiB, WS_W2 = 29 * MiB;
constexpr size_t WS_R1 = 35 * MiB;
constexpr size_t WS_QKV = 99 * MiB, WS_QM = 261 * MiB, WS_KVM = 285 * MiB, WS_OB = 317 * MiB, OB_L = (size_t)T * 256 * 2, WS_LSE = 365 * MiB, LSE_L = (size_t)T * 4 * 4;
constexpr size_t WS_PA = 367 * MiB, WS_PC = 431 * MiB, WS_LA = 463 * MiB, WS_LC = 465 * MiB;
constexpr size_t WS_XB = 440 * MiB, WS_SSQ = 505 * MiB;
constexpr size_t WS_G = 99 * MiB;
constexpr size_t WS_MW13 = 99 * MiB, WS_MW2 = 211 * MiB, WS_GM = 267 * MiB, GM_L = (size_t)64 * 256 * FE  , WS_Y = 379 * MiB;
constexpr size_t WS_RT = 511 * MiB, RT_SEL = 0, RT_GATE = 256 * 1024, RT_POS = 512 * 1024, RT_TOK = 768 * 1024, RT_BLK = 1280 * 1024;
constexpr size_t WS_SSQ2 = 513 * MiB;
constexpr size_t WS_END = 515 * MiB;
static_assert(WS_WIN + 2 * WIN_L <= WS_WOUT && WS_WOUT + 2 * WOUT_L <= WS_WUQ && WS_WUQ + 2 * WUQ_L <= WS_WUKV && WS_WUKV + 2 * WUKV_L <= WS_W13, "ws map 1");
static_assert(WS_W13 + (size_t)2 * FF * D * 2 <= WS_W2 && WS_W2 + (size_t)D * FF * 2 <= WS_R1 && WS_R1 + (size_t)T * D * 2 <= WS_QKV, "ws map 2");
static_assert(WS_QKV + (size_t)T * NQKV * 2 <= WS_QM && WS_QM + (size_t)T * 384 * 2 <= WS_KVM && WS_KVM + (size_t)T * 512 * 2 <= WS_OB && WS_OB + 3 * OB_L <= WS_LSE && WS_LSE + 3 * LSE_L <= WS_RT, "ws map 3");
static_assert(WS_G + (size_t)T * FF * 2 <= WS_XB && WS_XB + (size_t)T * D * 2 <= WS_SSQ && WS_SSQ + (size_t)T * 16 * 4 <= WS_RT, "ws map 4");
static_assert(WS_LSE + 3 * LSE_L <= WS_PA && WS_PA + 4 * OB_L <= WS_PC && WS_PC + 2 * OB_L <= WS_LA && WS_LA + 4 * LSE_L <= WS_LC && WS_LC + 2 * LSE_L <= WS_RT, "ws map 6");
static_assert(WS_MW13 + (size_t)NEXP * 2 * FE * D <= WS_MW2 && WS_MW2 + (size_t)NEXP * D * FE <= WS_GM && WS_GM + 2 * GM_L <= WS_Y && WS_Y + (size_t)264 * 256 * D * 2 <= WS_RT, "ws map 5");
constexpr int CW_TMO = 0, CW_CODE = 1;
constexpr int CW_BAR = 4096;
constexpr int CW_Q = 120000;
constexpr int CW_HIST = 122000;
constexpr int CW_KMAX = 124160;
constexpr int CW_KMAXC = CW_KMAX + 64;
constexpr int CW_RDY = CW_KMAX + 140;
constexpr int CW_KPE = CW_KMAX + 128;
static_assert(CW_HIST + 256 * 8 <= CW_KMAX && (CW_KMAX + 144) * 4 <= (int)CTL_ZERO_BYTES, "CTL words inside the memset region");

constexpr int RING_OFF = 0, RING_BYTES = 131072;
constexpr int LDSCTL_OFF = RING_BYTES, MISC_OFF = LDSCTL_OFF + 320;
constexpr int LDS_BYTES = 147456;

#define GAS __attribute__((address_space(1)))
#define LAS __attribute__((address_space(3)))
typedef unsigned short bf16;
typedef unsigned v4u __attribute__((ext_vector_type(4)));
typedef unsigned v2u __attribute__((ext_vector_type(2)));
typedef float f32x4 __attribute__((ext_vector_type(4)));
typedef float f32x2 __attribute__((ext_vector_type(2)));
typedef GAS unsigned gu32;
#define RLX_AGENT __ATOMIC_RELAXED, __HIP_MEMORY_SCOPE_AGENT
#define LDS_WAIT() asm volatile("s_waitcnt lgkmcnt(0)" ::: "memory")
#define VM_WAIT() asm volatile("s_waitcnt vmcnt(0)" ::: "memory")
__device__ __forceinline__ unsigned f2bf(float f) { unsigned u = __builtin_bit_cast(unsigned, f); return (u + 0x7fffu + ((u >> 16) & 1u)) >> 16; }
__device__ __forceinline__ unsigned pk2(float lo, float hi) { return f2bf(lo) | (f2bf(hi) << 16); }
__device__ __forceinline__ float bflo(unsigned w) { return __uint_as_float(w << 16); }
__device__ __forceinline__ float bfhi(unsigned w) { return __uint_as_float(w & 0xffff0000u); }

#define XB_TMO      128
#define XB_XCNT(j)  (256  + 64 * (j))
#define XB_XSUB(j)  (1280 + 64 * (j))
#define XB_XGEN(j)  (2304 + 64 * (j))
#define XB_TOP      3328
#define XB_TOPGEN   3392
#define XCD_BAR_WORDS 3456
#define XB_SPIN_CAP (1u << 18)
__device__ __forceinline__ unsigned xb_ld(unsigned* p)              { return __hip_atomic_load(p, __ATOMIC_RELAXED, __HIP_MEMORY_SCOPE_AGENT); }
__device__ __forceinline__ unsigned xb_add(unsigned* p, unsigned v) { return __hip_atomic_fetch_add(p, v, __ATOMIC_RELAXED, __HIP_MEMORY_SCOPE_AGENT); }
__device__ __forceinline__ unsigned xb_xcc_id() { return (unsigned)__builtin_amdgcn_s_getreg((3 << 11) | 20) & 0xFu; }
#define XB_SPIN(cond, bar) do { unsigned _sp = 0; while (cond) { __builtin_amdgcn_s_sleep(1); \
    if ((++_sp & 255u) == 0u) { if (xb_ld(&(bar)[XB_TMO])) break; if (_sp > XB_SPIN_CAP) { atomicAdd(&(bar)[XB_TMO], 1u); break; } } } } while (0)
struct XcdBarrier { unsigned* bar; unsigned x; volatile LAS unsigned* st; };
__device__ __forceinline__ XcdBarrier xcd_barrier_post(unsigned* bar, volatile LAS unsigned* st) {
    XcdBarrier b; b.bar = bar; b.x = xb_xcc_id(); b.st = st;
    if (threadIdx.x == 0) (void)xb_add(&bar[XB_XCNT(b.x)], 1u);
    return b;
}
__device__ __forceinline__ void xcd_barrier_complete(unsigned* bar, unsigned x, unsigned& nloc, unsigned& nx) {
    const unsigned G = gridDim.x * gridDim.y * gridDim.z;
    unsigned sum, cnt, mine, sp = 0u;
    for (;;) {
        sum = 0u; cnt = 0u; mine = 0u;
#pragma unroll
        for (unsigned j = 0; j < 16; ++j) { const unsigned c = xb_ld(&bar[XB_XCNT(j)]); sum += c; cnt += (c > 0u) ? 1u : 0u; mine = (j == x) ? c : mine; }
        if (sum == G) break;
        __builtin_amdgcn_s_sleep(1);
        if ((++sp & 255u) == 0u) { if (xb_ld(&bar[XB_TMO])) break; if (sp > XB_SPIN_CAP) { atomicAdd(&bar[XB_TMO], 1u); break; } }
    }
    nloc = mine > 0u ? mine : 1u; nx = cnt > 0u ? cnt : 1u;
}
__device__ __forceinline__ void xcd_barrier(const XcdBarrier& b) {
    asm volatile("s_waitcnt vmcnt(0)" ::: "memory");
    __syncthreads();
    if (threadIdx.x == 0) {
        unsigned* bar = b.bar;
        __builtin_amdgcn_s_waitcnt(0);
        unsigned nloc = b.st[0], nx = b.st[1];
        if (nloc == 0u) { xcd_barrier_complete(bar, b.x, nloc, nx); b.st[0] = nloc; b.st[1] = nx; }
        const unsigned old = xb_add(&bar[XB_XSUB(b.x)], 1u);
        const unsigned gen = old / nloc;
        if (old + 1u == (gen + 1u) * nloc) {
            __builtin_amdgcn_fence(__ATOMIC_RELEASE, "agent");
            asm volatile("s_waitcnt vmcnt(0)" ::: "memory");
            const unsigned og = xb_add(&bar[XB_TOP], 1u);
            const unsigned tg = og / nx;
            if (og + 1u == (tg + 1u) * nx) xb_add(&bar[XB_TOPGEN], 1u);
            else XB_SPIN(xb_ld(&bar[XB_TOPGEN]) == tg, bar);
            __builtin_amdgcn_fence(__ATOMIC_ACQUIRE, "agent");
            xb_add(&bar[XB_XGEN(b.x)], 1u);
            asm volatile("s_waitcnt vmcnt(0)" ::: "memory");
        } else {
            XB_SPIN(xb_ld(&bar[XB_XGEN(b.x)]) == gen, bar);
            __builtin_amdgcn_fence(__ATOMIC_ACQUIRE, "agent");
            asm volatile("s_waitcnt vmcnt(0)" ::: "memory");
        }
    }
    __syncthreads();
}

struct Frame {
    LAS unsigned char* lds;
    volatile LAS unsigned* MISC;
    int tid, lane, wave, vcu, G, bx;
};
#define CAS __attribute__((address_space(4)))
__device__ __forceinline__ const CAS char* kargs() { const CAS char* p = (const CAS char*)__builtin_amdgcn_kernarg_segment_ptr(); asm volatile("" : "+s"(p)); return p; }
__device__ __forceinline__ const float* gin(int k) { return *(const float* const CAS*)(kargs() + 8 * k); }
__device__ __forceinline__ float* gout() { return *(float* const CAS*)(kargs() + 160); }
__device__ __forceinline__ unsigned char* gws() { return *(unsigned char* const CAS*)(kargs() + 168); }
__device__ __forceinline__ gu32* gctl() { return (gu32*)gws(); }
__device__ __forceinline__ float wave_sum(float v, int lane) {
#pragma unroll
    for (int o = 1; o < 64; o <<= 1) v += __int_as_float(__builtin_amdgcn_ds_bpermute((lane ^ o) << 2, __float_as_int(v)));
    return v;
}

__device__ __forceinline__ void wmap(int kind, int aux, int n, int& drow, float& sc) {
    sc = 1.f; drow = n + aux;
    if (kind == 1) {
        if (n < 1536) { drow = n; if (n < 256) sc = 0.17677669529663687f * LOG2E; else if (n >= 768 && n < 1024) sc = 0.125f * LOG2E; }
        else if (n < 2048) drow = n + 512;
        else if (n < 2080) { const int j = n - 2048; drow = C_KPE + (j < 16 ? 2 * j : 2 * (j - 16) + 1); }
        else { drow = n - 544; if (n < 2336) sc = 0.125f * LOG2E; }
    } else if (kind == 2) {
        const int h = n / 96, dd = n % 96; sc = 0.10206207261596575f * LOG2E;
        drow = (dd < 64) ? n : h * 96 + 64 + ((dd - 64) < 16 ? 2 * (dd - 64) : 2 * (dd - 80) + 1);
    } else if (kind == 3) {
        drow = (n >> 7) * 256 + aux * 128 + (n & 127);
    }
}
__device__ __forceinline__ void tr_item(const float* W, int K, int N, bf16* WT, LAS float* scr, int item, int lane, int kind, int aux, const float* kscale = nullptr) {
    const int nblk = N / 32, kb = item / nblk, nb = item % nblk, k0 = 64 * kb, n0 = 32 * nb;
    float wv[32];
#pragma unroll
    for (int i = 0; i < 32; ++i) { const int kk = 2 * i + (lane >> 5); wv[i] = __builtin_nontemporal_load(W + (size_t)(k0 + kk) * N + n0 + (lane & 31)); }
#pragma unroll
    for (int i = 0; i < 32; ++i) { const int kk = 2 * i + (lane >> 5); scr[kk * 33 + (lane & 31)] = wv[i]; }
    LDS_WAIT(); asm volatile("" ::: "memory");
    const int c = lane & 7;
    float kg[8];
#pragma unroll
    for (int e = 0; e < 8; ++e) kg[e] = kscale ? kscale[k0 + 8 * c + e] : 1.0f;
#pragma unroll
    for (int j = 0; j < 4; ++j) { const int n = (lane >> 3) + 8 * j; const LAS float* s = scr + (8 * c) * 33 + n; int drow; float sc; wmap(kind, aux, n0 + n, drow, sc);
        float ks[8];
#pragma unroll
        for (int e = 0; e < 8; ++e) ks[e] = sc * kg[e];
        v4u o; o.x = pk2(s[0 * 33] * ks[0], s[1 * 33] * ks[1]); o.y = pk2(s[2 * 33] * ks[2], s[3 * 33] * ks[3]); o.z = pk2(s[4 * 33] * ks[4], s[5 * 33] * ks[5]); o.w = pk2(s[6 * 33] * ks[6], s[7 * 33] * ks[7]);
        *(GAS v4u*)(WT + (size_t)drow * K + k0 + 8 * c) = o; }
    LDS_WAIT(); asm volatile("" ::: "memory");
}
__device__ __forceinline__ void tr_item8(const float* W, int K, int N, unsigned char* WT, LAS float* scr, int item, int lane, int kind, int aux, float scale, const float* kscale = nullptr) {
    const int nblk = N / 32, kb = item / nblk, nb = item % nblk, k0 = 64 * kb, n0 = 32 * nb;
    float wv[32];
#pragma unroll
    for (int i = 0; i < 32; ++i) { const int kk = 2 * i + (lane >> 5); wv[i] = __builtin_nontemporal_load(W + (size_t)(k0 + kk) * N + n0 + (lane & 31)); }
#pragma unroll
    for (int i = 0; i < 32; ++i) { const int kk = 2 * i + (lane >> 5); scr[kk * 33 + (lane & 31)] = wv[i]; }
    LDS_WAIT(); asm volatile("" ::: "memory");
    const int c = lane & 7;
#pragma unroll
    for (int j = 0; j < 4; ++j) { const int n = (lane >> 3) + 8 * j; const LAS float* s = scr + (8 * c) * 33 + n; int drow; float sc; wmap(kind, aux, n0 + n, drow, sc); sc *= scale;
        float ks[8];
#pragma unroll
        for (int e = 0; e < 8; ++e) ks[e] = kscale ? sc * kscale[k0 + 8 * c + e] : sc;
        int w0 = __builtin_amdgcn_cvt_pk_fp8_f32(s[0 * 33] * ks[0], s[1 * 33] * ks[1], 0, false); w0 = __builtin_amdgcn_cvt_pk_fp8_f32(s[2 * 33] * ks[2], s[3 * 33] * ks[3], w0, true);
        int w1 = __builtin_amdgcn_cvt_pk_fp8_f32(s[4 * 33] * ks[4], s[5 * 33] * ks[5], 0, false); w1 = __builtin_amdgcn_cvt_pk_fp8_f32(s[6 * 33] * ks[6], s[7 * 33] * ks[7], w1, true);
        *(GAS v2u*)(WT + (size_t)drow * K + k0 + 8 * c) = (v2u){(unsigned)w0, (unsigned)w1}; }
    LDS_WAIT(); asm volatile("" ::: "memory");
}
__device__ __forceinline__ void row_load(const float* xrow, int lane, f32x4 (&v)[4]) {
    const GAS f32x4* xr = (const GAS f32x4*)xrow + lane;
#pragma unroll
    for (int j = 0; j < 4; ++j) v[j] = xr[64 * j];
}
__device__ __forceinline__ void rms_fin(const f32x4 (&gn)[4], bf16* orow, int lane, f32x4 (&v)[4]) {
    float s = 0.f;
#pragma unroll
    for (int j = 0; j < 4; ++j) s += (v[j].x * v[j].x + v[j].y * v[j].y) + (v[j].z * v[j].z + v[j].w * v[j].w);
    const float r = 1.0f / sqrtf(wave_sum(s, lane) * (1.f / D) + RMS_EPS);
    GAS unsigned long long* o8 = (GAS unsigned long long*)orow + lane;
#pragma unroll
    for (int j = 0; j < 4; ++j) { v[j] = v[j] * r * gn[j]; o8[64 * j] = (unsigned long long)pk2(v[j].x, v[j].y) | ((unsigned long long)pk2(v[j].z, v[j].w) << 32); }
}
__device__ __forceinline__ void rms_fin8(const f32x4 (&gn)[4], unsigned char* orow, int lane, f32x4 (&v)[4]) {
    float s = 0.f;
#pragma unroll
    for (int j = 0; j < 4; ++j) s += (v[j].x * v[j].x + v[j].y * v[j].y) + (v[j].z * v[j].z + v[j].w * v[j].w);
    const float r = 1.0f / sqrtf(wave_sum(s, lane) * (1.f / D) + RMS_EPS);
    GAS int* o4 = (GAS int*)orow + lane;
#pragma unroll
    for (int j = 0; j < 4; ++j) { v[j] = v[j] * r * gn[j]; int w = __builtin_amdgcn_cvt_pk_fp8_f32(v[j].x, v[j].y, 0, false); w = __builtin_amdgcn_cvt_pk_fp8_f32(v[j].z, v[j].w, w, true); o4[64 * j] = w; }
}
__device__ __forceinline__ void load_gain(const float* g, int lane, f32x4 (&gn)[4]) {
#pragma unroll
    for (int j = 0; j < 4; ++j) gn[j] = *((const GAS f32x4*)g + lane + 64 * j);
}
__device__ __forceinline__ void norm_rows(Frame& F, const float* x, const float* gain, bf16* out) {
    f32x4 gn[4]; load_gain(gain, F.lane, gn);
    const int r0 = F.bx * (T / 256) + F.wave * 16;
    f32x4 cur[4], nxt[4], nx2[4]; row_load(x + (size_t)r0 * D, F.lane, cur); row_load(x + (size_t)(r0 + 1) * D, F.lane, nxt);
    for (int i = 0; i < 16; ++i) { if (i + 2 < 16) row_load(x + (size_t)(r0 + i + 2) * D, F.lane, nx2);
        rms_fin(gn, out + (size_t)(r0 + i) * D, F.lane, cur);
#pragma unroll
        for (int j = 0; j < 4; ++j) { cur[j] = nxt[j]; nxt[j] = nx2[j]; } }
}

__device__ __forceinline__ void p0_prologue(Frame& F) {
    LAS float* scr = (LAS float*)(F.lds + RING_OFF + F.wave * 16384);
    const int gw = F.vcu * NWAVES + F.wave, NGW = F.G * NWAVES;
    constexpr int I_IN = 16 * 81, I_OUT = 16 * 32, I_UQ = 6 * 12, I_UKV = 2 * 16, I_L = I_IN + I_OUT + I_UQ + I_UKV, I_F = 16 * 88, I_F2 = 44 * 32;
    constexpr int NITEMS = 2 * I_L + 2 * I_F + I_F2;
    unsigned char* ws = gws();
    for (int it = gw; it < NITEMS; it += NGW) {
        int r = it;
        if (r < 2 * I_L) { const int l = r / I_L; r -= l * I_L;
            if (r < I_IN) { tr_item(gin(2) + (size_t)l * D * NQKV, D, NQKV, (bf16*)(ws + WS_WIN + l * WIN_L), scr, r, F.lane, 1, 0, l == 1 ? gin(1) + D : nullptr); continue; } r -= I_IN;
            if (r < I_OUT) { tr_item(gin(3) + (size_t)l * D * D, D, D, (bf16*)(ws + WS_WOUT + l * WOUT_L), scr, r, F.lane, 0, 0); continue; } r -= I_OUT;
            if (r < I_UQ) { tr_item(gin(7) + (size_t)l * 384 * 384, 384, 384, (bf16*)(ws + WS_WUQ + l * WUQ_L), scr, r, F.lane, 2, 0, gin(6) + l * 384); continue; } r -= I_UQ;
            tr_item(gin(9) + (size_t)l * 128 * 512, 128, 512, (bf16*)(ws + WS_WUKV + l * WUKV_L), scr, r, F.lane, 0, 0, gin(8) + l * 128); continue; }
        r -= 2 * I_L;
#if FFN8 == 1 || FFN8 == 2
        if (r < I_F) { tr_item8(gin(12), D, FF, ws + WS_W13, scr, r, F.lane, 3, 0, MOE_WSCALE, gin(11)); continue; } r -= I_F;
        if (r < I_F) { tr_item8(gin(13), D, FF, ws + WS_W13, scr, r, F.lane, 3, 1, MOE_WSCALE, gin(11)); continue; } r -= I_F;
#else
        if (r < I_F) { tr_item(gin(12), D, FF, (bf16*)(ws + WS_W13), scr, r, F.lane, 3, 0, gin(11)); continue; } r -= I_F;
        if (r < I_F) { tr_item(gin(13), D, FF, (bf16*)(ws + WS_W13), scr, r, F.lane, 3, 1, gin(11)); continue; } r -= I_F;
#endif
#if FFN8 == 1 || FFN8 == 3
        tr_item8(gin(14), FF, D, ws + WS_W2, scr, r, F.lane, 0, 0, MOE_WSCALE);
#else
        tr_item(gin(14), FF, D, (bf16*)(ws + WS_W2), scr, r, F.lane, 0, 0);
#endif
    }
    { const int gt = (F.vcu * NWAVES + F.wave) * 64 + F.lane, NGT = NGW * 64; const v4u z = {0u, 0u, 0u, 0u};
      for (int l = 0; l < 2; ++l) {
        GAS v4u* p = (GAS v4u*)(ws + WS_WIN + l * WIN_L + (size_t)NQKV * D * 2); const int n1 = (NQKVP - NQKV) * D * 2 / 16;
        for (int i = gt; i < n1; i += NGT) p[i] = z;
        GAS v4u* q = (GAS v4u*)(ws + WS_WUQ + l * WUQ_L + (size_t)384 * 384 * 2); const int n2 = 128 * 384 * 2 / 16;
        for (int i = gt; i < n2; i += NGT) q[i] = z; }
      const double invf[16] = {0.15915494309189535, 0.08949940160889101, 0.050329212104487035, 0.0283021958306234, 0.015915494309189534, 0.008949940160889102, 0.005032921210448704, 0.00283021958306234,
                               0.0015915494309189536, 0.0008949940160889102, 0.0005032921210448703, 0.00028302195830623395, 0.00015915494309189535, 8.949940160889102e-05, 5.0329212104487035e-05, 2.8302195830623396e-05};
      GAS f32x2* rt = (GAS f32x2*)(ws + WS_ROPE);
      for (int i = gt; i < S * 16; i += NGT) { const int pos = i >> 4, j = i & 15; double f = invf[0];
#pragma unroll
          for (int q = 1; q < 16; ++q) f = (j == q) ? invf[q] : f;
          const double rev = (double)pos * f; const float fr = (float)(rev - __builtin_floor(rev));
          rt[i] = (f32x2){__builtin_amdgcn_cosf(fr), __builtin_amdgcn_sinf(fr)}; } }
    norm_rows(F, gin(0), gin(1), (bf16*)(ws + WS_R1));
}
__device__ __forceinline__ void moe_weights(Frame& F) {
    LAS float* scr = (LAS float*)(F.lds + RING_OFF + F.wave * 16384);
    const int gw = F.vcu * NWAVES + F.wave, NGW = F.G * NWAVES;
    constexpr int I_U = 16 * 112, I_D = 56 * 32, I_E = 2 * I_U + I_D, NITEMS = NEXP * I_E;
    for (int it = gw; it < NITEMS; it += NGW) { const int e = it / I_E; int r = it - e * I_E;
        unsigned char* w13 = gws() + WS_MW13 + (size_t)e * 2 * FE * D; unsigned char* w2 = gws() + WS_MW2 + (size_t)e * D * FE;
        if (r < I_U) { tr_item8(gin(16) + (size_t)e * D * FE, D, FE, w13, scr, r, F.lane, 3, 0, MOE_WSCALE); continue; } r -= I_U;
        if (r < I_U) { tr_item8(gin(17) + (size_t)e * D * FE, D, FE, w13, scr, r, F.lane, 3, 1, MOE_WSCALE); continue; } r -= I_U;
        tr_item8(gin(18) + (size_t)e * FE * D, FE, D, w2, scr, r, F.lane, 0, 0, MOE_WSCALE); }
}

__device__ __forceinline__ void mla_prep(Frame& F, int layer) {
    bf16* qkv = (bf16*)(gws() + WS_QKV); const GAS f32x2* rope = (const GAS f32x2*)(gws() + WS_ROPE);
    const int lane = F.lane;
    const int r0 = F.bx * (T / 256) + F.wave * 16;
    float kpm = 0.f;
    float kmx = 0.f;
    for (int i0 = 0; i0 < 16; i0 += 4) { v2u kw4[4]; v4u kp4[4]; f32x2 cs4[4][4];
#pragma unroll
        for (int k = 0; k < 4; ++k) { const int row = r0 + i0 + k; kw4[k] = *((const GAS v2u*)(qkv + (size_t)row * NQKV + C_KA) + lane);
            if (lane < 4) { kp4[k] = *((const GAS v4u*)(qkv + (size_t)row * NQKV + C_KPE) + lane); const GAS f32x2* rt = rope + (size_t)(row & (S - 1)) * 16 + lane * 4; cs4[k][0] = rt[0]; cs4[k][1] = rt[1]; cs4[k][2] = rt[2]; cs4[k][3] = rt[3]; } }
#pragma unroll
        for (int k = 0; k < 4; ++k) { const int row = r0 + i0 + k;
            { const v2u kw = kw4[k]; const float k0 = bflo(kw.x), k1 = bfhi(kw.x), k2 = bflo(kw.y), k3 = bfhi(kw.y);
              float s2 = (k0 * k0 + k1 * k1) + (k2 * k2 + k3 * k3);
#pragma unroll
              for (int o_ = 1; o_ < 8; o_ <<= 1) s2 += __int_as_float(__builtin_amdgcn_ds_bpermute((lane ^ o_) << 2, __float_as_int(s2)));
              kmx = fmaxf(kmx, s2); }
            if (lane < 4) { GAS v4u* kp = (GAS v4u*)(qkv + (size_t)row * NQKV + C_KPE) + lane; const v4u k_ = kp4[k];
                const f32x2 c0 = cs4[k][0], c1 = cs4[k][1], c2 = cs4[k][2], c3 = cs4[k][3]; v4u ko;
                { const float a = bflo(k_.x), b = bfhi(k_.x); ko.x = pk2(a * c0.x - b * c0.y, b * c0.x + a * c0.y); }
                { const float a = bflo(k_.y), b = bfhi(k_.y); ko.y = pk2(a * c1.x - b * c1.y, b * c1.x + a * c1.y); }
                { const float a = bflo(k_.z), b = bfhi(k_.z); ko.z = pk2(a * c2.x - b * c2.y, b * c2.x + a * c2.y); }
                { const float a = bflo(k_.w), b = bfhi(k_.w); ko.w = pk2(a * c3.x - b * c3.y, b * c3.x + a * c3.y); }
                *kp = ko;
                float s2 = ((bflo(ko.x) * bflo(ko.x) + bfhi(ko.x) * bfhi(ko.x)) + (bflo(ko.y) * bflo(ko.y) + bfhi(ko.y) * bfhi(ko.y))) + ((bflo(ko.z) * bflo(ko.z) + bfhi(ko.z) * bfhi(ko.z)) + (bflo(ko.w) * bflo(ko.w) + bfhi(ko.w) * bfhi(ko.w)));
                s2 += __int_as_float(__builtin_amdgcn_ds_bpermute((lane ^ 1) << 2, __float_as_int(s2))); s2 += __int_as_float(__builtin_amdgcn_ds_bpermute((lane ^ 2) << 2, __float_as_int(s2)));
                kpm = fmaxf(kpm, s2); } } }
    if (lane == 0) __hip_atomic_fetch_max((unsigned*)gctl() + CW_KPE + layer * 4 + (r0 >> 13), __float_as_uint(kpm), __ATOMIC_RELAXED, __HIP_MEMORY_SCOPE_AGENT);
    if ((lane & 7) == 0) __hip_atomic_fetch_max((unsigned*)gctl() + CW_KMAX + layer * 32 + (r0 >> 13) * 8 + (lane >> 3), __float_as_uint(kmx), __ATOMIC_RELAXED, __HIP_MEMORY_SCOPE_AGENT);
}

__device__ __forceinline__ float xsum16(float v, int lane) {
#pragma unroll
    for (int o_ = 1; o_ < 16; o_ <<= 1) v += __int_as_float(__builtin_amdgcn_ds_bpermute((lane ^ o_) << 2, __float_as_int(v)));
    return v;
}
__device__ __forceinline__ void merge2(const bf16* pa, const bf16* pb, float la, float lb, bool two, int lane, float (&o)[4]) {
    const v2u a = *((const GAS v2u*)pa + lane); float w0 = 1.f, w1 = 0.f; v2u b = {0u, 0u};
    if (two) { b = *((const GAS v2u*)pb + lane); const float mx = fmaxf(la, lb); w0 = __builtin_amdgcn_exp2f(la - mx); w1 = __builtin_amdgcn_exp2f(lb - mx); const float inv = 1.0f / (w0 + w1); w0 *= inv; w1 *= inv; }
    o[0] = w0 * bflo(a.x) + w1 * bflo(b.x); o[1] = w0 * bfhi(a.x) + w1 * bfhi(b.x); o[2] = w0 * bflo(a.y) + w1 * bflo(b.y); o[3] = w0 * bfhi(a.y) + w1 * bfhi(b.y);
}
__device__ __forceinline__ void merge2r(const v2u a, const v2u b, float la, float lb, bool two, float (&o)[4]) {
    float w0 = 1.f, w1 = 0.f;
    if (two) { const float mx = fmaxf(la, lb); w0 = __builtin_amdgcn_exp2f(la - mx); w1 = __builtin_amdgcn_exp2f(lb - mx); const float inv = 1.0f / (w0 + w1); w0 *= inv; w1 *= inv; }
    o[0] = w0 * bflo(a.x) + w1 * bflo(b.x); o[1] = w0 * bfhi(a.x) + w1 * bfhi(b.x); o[2] = w0 * bflo(a.y) + w1 * bflo(b.y); o[3] = w0 * bfhi(a.y) + w1 * bfhi(b.y);
}
__device__ __forceinline__ void attn_combine(Frame& F, int layer) {
    const bf16* ob = (const bf16*)(gws() + WS_OB); const float* lse = (const float*)(gws() + WS_LSE); bf16* o = (bf16*)(gws() + WS_R1);
    const bf16* pa = (const bf16*)(gws() + WS_PA); const bf16* pc = (const bf16*)(gws() + WS_PC); const float* la = (const float*)(gws() + WS_LA); const float* lc = (const float*)(gws() + WS_LC);
    const int lane = F.lane, h = lane >> 4; const int r0 = F.bx * (T / 256) + F.wave * 16;
    float lam, osc;
    { const float* lp = gin(4) + layer * 128; float a = 0.f, b = 0.f;
      if (lane < 32) { a = lp[lane] * lp[32 + lane]; b = lp[64 + lane] * lp[96 + lane]; }
      a = wave_sum(a, lane); b = wave_sum(b, lane);
      const float lam_init = 0.8f - 0.6f * __expf(-0.3f * (float)layer); lam = __expf(a) - __expf(b) + lam_init; osc = 1.0f - lam_init; }
    const f32x4 sg = *((const GAS f32x4*)(gin(5) + layer * 64) + (lane & 15));
    const size_t TL = (size_t)T * 4, TO = (size_t)T * 256;
    const bool two = (r0 & (S - 1)) >= 4096;
    struct RowIn { float l[3]; v2u b[3]; float lcv[2]; v2u c[2]; float lav[4]; v2u a[4]; };
    for (int i0 = 0; i0 < 16; i0 += 4) { RowIn in[4];
#pragma unroll
        for (int k = 0; k < 4; ++k) { const int row = r0 + i0 + k; const size_t ro = (size_t)row * 256, rl = (size_t)row * 4 + h; RowIn& R = in[k];
            R.l[0] = lse[rl]; R.l[1] = lse[TL + rl]; R.l[2] = lse[2 * TL + rl];
            R.b[0] = *((const GAS v2u*)(ob + ro) + lane); R.b[1] = *((const GAS v2u*)(ob + TO + ro) + lane); R.b[2] = *((const GAS v2u*)(ob + 2 * TO + ro) + lane);
            R.lcv[0] = lc[rl]; R.c[0] = *((const GAS v2u*)(pc + ro) + lane); R.lav[0] = la[rl]; R.lav[2] = la[2 * TL + rl]; R.a[0] = *((const GAS v2u*)(pa + ro) + lane); R.a[2] = *((const GAS v2u*)(pa + 2 * TO + ro) + lane);
            R.lcv[1] = 0.f; R.lav[1] = 0.f; R.lav[3] = 0.f; R.c[1] = (v2u){0u, 0u}; R.a[1] = (v2u){0u, 0u}; R.a[3] = (v2u){0u, 0u};
            if (two) { R.lcv[1] = lc[TL + rl]; R.c[1] = *((const GAS v2u*)(pc + TO + ro) + lane); R.lav[1] = la[TL + rl]; R.lav[3] = la[3 * TL + rl]; R.a[1] = *((const GAS v2u*)(pa + TO + ro) + lane); R.a[3] = *((const GAS v2u*)(pa + 3 * TO + ro) + lane); } }
#pragma unroll
        for (int k = 0; k < 4; ++k) { const int row = r0 + i0 + k; const RowIn& R = in[k];
            { const float l0 = R.l[0], l1 = R.l[1], l2 = R.l[2];
              const float mx = fmaxf(l0, fmaxf(l1, l2)); float w0 = __builtin_amdgcn_exp2f(l0 - mx), w1 = __builtin_amdgcn_exp2f(l1 - mx), w2 = __builtin_amdgcn_exp2f(l2 - mx);
              const float inv = 1.0f / (w0 + w1 + w2); w0 *= inv; w1 *= inv; w2 *= inv;
              const v2u a = R.b[0], b = R.b[1], c = R.b[2];
              v2u r; r.x = pk2(w0 * bflo(a.x) + w1 * bflo(b.x) + w2 * bflo(c.x), w0 * bfhi(a.x) + w1 * bfhi(b.x) + w2 * bfhi(c.x));
              r.y = pk2(w0 * bflo(a.y) + w1 * bflo(b.y) + w2 * bflo(c.y), w0 * bfhi(a.y) + w1 * bfhi(b.y) + w2 * bfhi(c.y));
              *((GAS v2u*)(o + (size_t)row * D + 256) + lane) = r; }
            { float v[4]; merge2r(R.c[0], R.c[1], R.lcv[0], R.lcv[1], two, v);
              v2u r; r.x = pk2(v[0], v[1]); r.y = pk2(v[2], v[3]); *((GAS v2u*)(o + (size_t)row * D + 512) + lane) = r; }
            { float v0[4], v1[4]; merge2r(R.a[0], R.a[1], R.lav[0], R.lav[1], two, v0); merge2r(R.a[2], R.a[3], R.lav[2], R.lav[3], two, v1);
              float d[4], ss = 0.f;
#pragma unroll
              for (int e = 0; e < 4; ++e) { d[e] = v0[e] - lam * v1[e]; ss += d[e] * d[e]; }
              ss = xsum16(ss, lane); const float rs = (1.0f / sqrtf(ss * (1.0f / 64.0f) + RMS_EPS)) * osc;
              v2u r; r.x = pk2(d[0] * rs * sg.x, d[1] * rs * sg.y); r.y = pk2(d[2] * rs * sg.z, d[3] * rs * sg.w); *((GAS v2u*)(o + (size_t)row * D) + lane) = r; } } }
}

__device__ __forceinline__ void norm2_router(Frame& F, int layer, bool moe) {
    const float* x1 = gout(); bf16* h2 = (bf16*)(gws() + WS_R1); const int lane = F.lane;
    f32x4 gn[4]; load_gain(gin(11) + layer * D, lane, gn);
    const int r0 = F.bx * (T / 256) + F.wave * 16;
    f32x4 cur[4], nxt[4]; row_load(x1 + (size_t)r0 * D, lane, cur);
    if (!moe) {
        for (int i = 0; i < 16; ++i) { if (i + 1 < 16) row_load(x1 + (size_t)(r0 + i + 1) * D, lane, nxt);
            rms_fin(gn, h2 + (size_t)(r0 + i) * D, lane, cur);
#pragma unroll
            for (int j = 0; j < 4; ++j) cur[j] = nxt[j]; }
        return; }
    int* sel = (int*)(gws() + WS_RT + RT_SEL); float* gate = (float*)(gws() + WS_RT + RT_GATE);
    const float* rw = gin(15);
    volatile LAS unsigned* lh = F.MISC + 16;
    f32x4 wr[16][2];
#pragma unroll
    for (int j = 0; j < 4; ++j)
#pragma unroll
        for (int c = 0; c < 4; ++c) { const GAS f32x4* wp = (const GAS f32x4*)(rw + (size_t)(4 * lane + 256 * j + c) * 8); wr[j * 4 + c][0] = wp[0]; wr[j * 4 + c][1] = wp[1]; }
    f32x4 nx2[4]; row_load(x1 + (size_t)(r0 + 1) * D, lane, nxt);
    for (int i = 0; i < 16; ++i) { const int row = r0 + i; f32x4 v[4];
        if (i + 2 < 16) row_load(x1 + (size_t)(row + 2) * D, lane, nx2);
#pragma unroll
        for (int j = 0; j < 4; ++j) v[j] = cur[j];
        rms_fin8(gn, (unsigned char*)h2 + (size_t)row * D, lane, v);
#pragma unroll
        for (int j = 0; j < 4; ++j) { cur[j] = nxt[j]; nxt[j] = nx2[j]; }
        float lg[8];
#pragma unroll
        for (int e = 0; e < 8; ++e) lg[e] = 0.f;
#pragma unroll
        for (int j = 0; j < 4; ++j)
#pragma unroll
            for (int c = 0; c < 4; ++c) { const f32x4 wa = wr[j * 4 + c][0], wb = wr[j * 4 + c][1]; const float xv = v[j][c];
                lg[0] += xv * wa.x; lg[1] += xv * wa.y; lg[2] += xv * wa.z; lg[3] += xv * wa.w; lg[4] += xv * wb.x; lg[5] += xv * wb.y; lg[6] += xv * wb.z; lg[7] += xv * wb.w; }
#pragma unroll
        for (int e = 0; e < 8; ++e) lg[e] = wave_sum(lg[e], lane);
        int i1 = 0; float v1 = lg[0];
#pragma unroll
        for (int e = 1; e < 8; ++e) if (lg[e] > v1) { v1 = lg[e]; i1 = e; }
        int i2 = -1; float v2 = -3.0e38f;
#pragma unroll
        for (int e = 0; e < 8; ++e) if (e != i1 && lg[e] > v2) { v2 = lg[e]; i2 = e; }
        const float g1 = 1.0f / (1.0f + __expf(v2 - v1));
        if (lane == 0) { sel[row * 2] = i1; sel[row * 2 + 1] = i2; gate[row * 2] = g1; gate[row * 2 + 1] = 1.0f - g1;
            __hip_atomic_fetch_add((LAS unsigned*)lh + i1, 1u, __ATOMIC_RELAXED, __HIP_MEMORY_SCOPE_WORKGROUP); __hip_atomic_fetch_add((LAS unsigned*)lh + i2, 1u, __ATOMIC_RELAXED, __HIP_MEMORY_SCOPE_WORKGROUP); } }
    __syncthreads();
    if (F.tid < 8) __hip_atomic_store((unsigned*)gctl() + CW_HIST + F.bx * 8 + F.tid, (unsigned)lh[F.tid], RLX_AGENT);
    asm volatile("s_waitcnt vmcnt(0)" ::: "memory"); __syncthreads();
    if (F.tid == 0) { __builtin_amdgcn_fence(__ATOMIC_RELEASE, "agent"); (void)__hip_atomic_fetch_add((unsigned*)gctl() + CW_RDY, 1u, RLX_AGENT); }
}
__device__ __forceinline__ void hist_wait(Frame& F) {
    if (F.tid == 0) { unsigned sp_ = 0; while (__hip_atomic_load((unsigned*)gctl() + CW_RDY, RLX_AGENT) < (unsigned)F.G) { __builtin_amdgcn_s_sleep(2); if (++sp_ > (1u << 22)) break; }
        __builtin_amdgcn_fence(__ATOMIC_ACQUIRE, "agent"); }
    __syncthreads();
}

__device__ __forceinline__ void route_assign(Frame& F) {
    LAS int* L = (LAS int*)(F.lds + RING_OFF);
    const unsigned* hist = (const unsigned*)gctl() + CW_HIST;
    for (int i = F.tid; i < 2048; i += NWAVES * 64) L[i] = (int)__hip_atomic_load(hist + i, RLX_AGENT);
    __syncthreads();
    if (F.tid < 8) { int tot = 0, before = 0;
#pragma unroll 16
        for (int w = 0; w < 256; ++w) { const int c = L[w * 8 + F.tid]; tot += c; before += (w < F.bx) ? c : 0; } L[2048 + F.tid] = tot; L[2048 + 16 + F.tid] = before; }
    __syncthreads();
    if (F.tid == 0) { int ps = 0; for (int e = 0; e < 8; ++e) { const int c = L[2048 + e], pd = (c + 255) / 256 * 256; L[2048 + 8 + e] = ps; L[2048 + 16 + e] += ps; L[2048 + 24 + e] = pd; ps += pd; } L[2048 + 32] = ps / 256; }
    __syncthreads();
    const int* sel = (const int*)(gws() + WS_RT + RT_SEL); int* pos = (int*)(gws() + WS_RT + RT_POS); int* tokv = (int*)(gws() + WS_RT + RT_TOK); int* blk = (int*)(gws() + WS_RT + RT_BLK);
    if (F.wave == 0) {
        const int lane = F.lane; const unsigned long long lt = (1ull << lane) - 1ull;
        int run[8];
#pragma unroll
        for (int e = 0; e < 8; ++e) run[e] = L[2048 + 16 + e];
        int sl[2][2];
#pragma unroll
        for (int half = 0; half < 2; ++half) { const int row = F.bx * 128 + half * 64 + lane; sl[half][0] = sel[row * 2]; sl[half][1] = sel[row * 2 + 1]; }
#pragma unroll
        for (int half = 0; half < 2; ++half) { const int row = F.bx * 128 + half * 64 + lane; const int s0 = sl[half][0], s1 = sl[half][1]; int d0 = 0, d1 = 0;
#pragma unroll
            for (int e = 0; e < 8; ++e) { const unsigned long long m0 = __ballot(s0 == e), m1 = __ballot(s1 == e); const int rk = run[e] + __popcll(m0 & lt) + __popcll(m1 & lt);
                if (s0 == e) d0 = rk; if (s1 == e) d1 = rk; run[e] += __popcll(m0) + __popcll(m1); }
            pos[row * 2] = d0; pos[row * 2 + 1] = d1; tokv[d0] = row; tokv[d1] = row; }
    }
    if (F.bx == 0) {
        const int nblk = L[2048 + 32];
        for (int rb = F.tid; rb < 272; rb += NWAVES * 64) { int e = 0;
#pragma unroll
            for (int q = 0; q < 8; ++q) if (rb * 256 >= L[2048 + 8 + q] + L[2048 + 24 + q]) e = q + 1;
            blk[rb] = e > 7 ? 7 : e; }
        if (F.tid == 0) blk[272] = nblk;
        for (int e = 0; e < 8; ++e) { const int a = L[2048 + 8 + e] + L[2048 + e], b = L[2048 + 8 + e] + L[2048 + 24 + e]; for (int s = a + F.tid; s < b; s += NWAVES * 64) tokv[s] = 0; }
    }
}

__device__ __forceinline__ void final_combine(Frame& F, int mode, int w0) {
    const int lane = F.lane; f32x4 gn[4]; load_gain(gin(19), lane, gn);
    const int* pos = (const int*)(gws() + WS_RT + RT_POS); const float* gate = (const float*)(gws() + WS_RT + RT_GATE); const bf16* Y = (const bf16*)(gws() + WS_Y);
    const int gw = (F.bx - w0) * NWAVES + F.wave, NGW = (F.G - w0) * NWAVES; constexpr int MAINROWS = 256 * 256;
    if (gw < 0) return;
    f32x4 xc[4], xn[4]; v2u ac[4], bc[4], an[4], bn[4]; float g0c = 0.f, g1c = 0.f, g0n = 0.f, g1n = 0.f; int pmc = 0, pmn = 0;
#define FC_LOAD(row, X, A, B, G0, G1, PM) do { const int p0_ = pos[(row) * 2], p1_ = pos[(row) * 2 + 1]; PM = p0_ > p1_ ? p0_ : p1_; G0 = gate[(row) * 2]; G1 = gate[(row) * 2 + 1]; \
        const GAS f32x4* xr_ = (const GAS f32x4*)(gout() + (size_t)(row) * D) + lane; const GAS v2u* y0_ = (const GAS v2u*)(Y + (size_t)p0_ * D) + lane; const GAS v2u* y1_ = (const GAS v2u*)(Y + (size_t)p1_ * D) + lane; \
        _Pragma("unroll") for (int j = 0; j < 4; ++j) { X[j] = xr_[64 * j]; A[j] = y0_[64 * j]; B[j] = y1_[64 * j]; } } while (0)
#define FC_FINISH(row) do { f32x4 v[4]; float s = 0.f; \
        _Pragma("unroll") for (int j = 0; j < 4; ++j) { const v2u a = ac[j], b = bc[j]; f32x4 x = xc[j]; \
            x.x += g0c * bflo(a.x) + g1c * bflo(b.x); x.y += g0c * bfhi(a.x) + g1c * bfhi(b.x); x.z += g0c * bflo(a.y) + g1c * bflo(b.y); x.w += g0c * bfhi(a.y) + g1c * bfhi(b.y); \
            v[j] = x; s += (x.x * x.x + x.y * x.y) + (x.z * x.z + x.w * x.w); } \
        const float r = 1.0f / sqrtf(wave_sum(s, lane) * (1.f / D) + RMS_EPS); \
        GAS f32x4* xw = (GAS f32x4*)(gout() + (size_t)(row) * D) + lane; \
        _Pragma("unroll") for (int j = 0; j < 4; ++j) xw[64 * j] = v[j] * r * gn[j]; } while (0)
    if (mode == 0) {
        if (gw < T) FC_LOAD(gw, xc, ac, bc, g0c, g1c, pmc);
        for (int row = gw; row < T; row += NGW) {
            if (row + NGW < T) FC_LOAD(row + NGW, xn, an, bn, g0n, g1n, pmn);
            if (pmc < MAINROWS) FC_FINISH(row);
#pragma unroll
            for (int j = 0; j < 4; ++j) { xc[j] = xn[j]; ac[j] = an[j]; bc[j] = bn[j]; }
            g0c = g0n; g1c = g1n; pmc = pmn; }
    } else {
        int pm16[16];
#pragma unroll
        for (int k = 0; k < 16; ++k) { const int row = gw + k * NGW; int p0_ = 0, p1_ = 0; if (row < T) { p0_ = pos[row * 2]; p1_ = pos[row * 2 + 1]; } pm16[k] = p0_ > p1_ ? p0_ : p1_; }
#pragma unroll
        for (int k = 0; k < 16; ++k) { const int row = gw + k * NGW;
            if (pm16[k] >= MAINROWS) { FC_LOAD(row, xc, ac, bc, g0c, g1c, pmc); FC_FINISH(row); } }
        for (int row = gw + 16 * NGW; row < T; row += NGW) { const int p0_ = pos[row * 2], p1_ = pos[row * 2 + 1];
            if ((p0_ > p1_ ? p0_ : p1_) < MAINROWS) continue;
            FC_LOAD(row, xc, ac, bc, g0c, g1c, pmc); FC_FINISH(row); }
    }
#undef FC_LOAD
#undef FC_FINISH
}
__device__ __forceinline__ int q_first(Frame& F, gu32* head) {
    __syncthreads();
    if (F.tid == 0) F.MISC[24] = __hip_atomic_fetch_add(head, 1u, RLX_AGENT);
    __syncthreads(); const int u = __builtin_amdgcn_readfirstlane((int)F.MISC[24]); __syncthreads(); return u;
}
#define ATT_QARGS (unsigned*)qh_, (volatile LAS unsigned*)(F.MISC + 24), F.wave
#define ATT_LOOP(head, NUNITS, ...) do { gu32* qh_ = (head); int u_ = q_first(F, qh_); while (u_ < (NUNITS)) { bool ran_ = false; \
        { const int u = u_; __VA_ARGS__ } if (ran_) u_ = __builtin_amdgcn_readfirstlane((int)F.MISC[24]); else u_ = q_first(F, qh_); } } while (0)

#ifndef ATT_PIPE_C
#define ATT_PIPE_C 0
#endif
#ifndef ATT_PIPE_D
#define ATT_PIPE_D 0
#endif
#ifndef ATT_PIPE_B
#define ATT_PIPE_B 0
#endif
__device__ __forceinline__ void attn_phase(Frame& F, int layer, int rep = 0) {
    char* shm = (char*)F.lds + RING_OFF;
    const att::bf16_t* qkv = (const att::bf16_t*)(gws() + WS_QKV); const att::bf16_t* qm = (const att::bf16_t*)(gws() + WS_QM); const att::bf16_t* kvm = (const att::bf16_t*)(gws() + WS_KVM);
    att::bf16_t* o = (att::bf16_t*)(gws() + WS_R1); att::bf16_t* ob = (att::bf16_t*)(gws() + WS_OB); float* lse = (float*)(gws() + WS_LSE);
    att::bf16_t* pa = (att::bf16_t*)(gws() + WS_PA); att::bf16_t* pc = (att::bf16_t*)(gws() + WS_PC); float* la = (float*)(gws() + WS_LA); float* lc = (float*)(gws() + WS_LC);
    gu32* heads = gctl() + CW_Q + layer * 4 * 64 + rep * 512;
    const int BIG = 1 << 28;
    __syncthreads();
    if (F.tid < 68) { const unsigned* src = (const unsigned*)gctl() + (F.tid < 32 ? CW_KMAX + layer * 32 + F.tid : F.tid < 64 ? CW_KMAXC + layer * 32 + (F.tid - 32) : CW_KPE + layer * 4 + (F.tid - 64));
        F.MISC[32 + F.tid] = __hip_atomic_load(src, RLX_AGENT); }
#ifndef DBG_SKIP_C
#define DBG_SKIP_C 0
#endif
#ifndef PROBE_AC
#define PROBE_AC 0
#endif
  for (int pass = 0; pass < (PROBE_AC ? 2 : 1); ++pass)
    ATT_LOOP(heads + pass * 64, 1568, {
        const bool isC = (u >= 196 && u < 980);
        if (pass == 1 && (isC ? PROBE_AC != 2 : PROBE_AC != 1)) { }
        else if (isC) {
            const int i = u - 196; int qb, bh, ck;
            if (i < 272) { ck = 0; bh = i / 17; qb = 31 - (i % 17); }   else { const int j = i - 272, g = j >> 5, r = j & 31; if (r < 16) { ck = 1; qb = 31 - g; bh = r; } else { ck = 0; qb = 14 - g; bh = r - 16; } }
            if (qb >= 0 && !DBG_SKIP_C) {
                const int b_ = bh >> 2, h = bh & 3, nt = 4 * qb + 4; const long rb = (long)b_ * S;
                att::Job J; J.Q = qm + rb * 384 + h * 96; J.qs = 384; J.K0 = kvm + rb * 512 + h * 128; J.ks0 = 512; J.K1 = qkv + rb * NQKV + C_KPE; J.ks1 = NQKV;
                J.V = kvm + rb * 512 + h * 128 + 64; J.vs = 512; J.O = pc + (size_t)ck * T * 256 + rb * 256 + h * 64; J.os = 256; J.omap = 0; J.LSE = lc + (size_t)ck * T * 4 + rb * 4 + h; J.ls = 4; J.lmap = 0;
                J.q0 = qb * 256; J.t_lo = ck ? 0 : (nt > 64 ? nt - 64 : 0); J.t_hi = ck ? nt - 64 : nt; J.max_dist = BIG; J.slope2 = 0.f; J.sink2 = 0.f; J.rope = (const att::f32x2_t*)(gws() + WS_ROPE); J.kmax2[1] = 0.f;
                J.kmax2[0] = (__uint_as_float(__builtin_amdgcn_readfirstlane(F.MISC[64 + bh * 2])) + __uint_as_float(__builtin_amdgcn_readfirstlane(F.MISC[64 + bh * 2 + 1]))) + __uint_as_float(__builtin_amdgcn_readfirstlane(F.MISC[96 + b_]));
#ifndef PROBE_XP
#define PROBE_XP 0
#endif
#ifndef PROBE_STAG
#define PROBE_STAG 0
#endif
#ifndef ATT_SMAX_C
#define ATT_SMAX_C 1
#endif
#ifndef ATT_STAG_C
#define ATT_STAG_C 0
#endif
                if (pass == 1) { J.O = (att::bf16_t*)(gws() + (size_t)470 * MiB) + (size_t)ck * T * 256 + rb * 256 + h * 64; J.LSE = (float*)(gws() + (size_t)504 * MiB) + (size_t)ck * T * 4 + rb * 4 + h;
                    att::attn_unit<6, 1, false, 1, true, true, PROBE_XP, (PROBE_STAG != 0)>(J, shm, ATT_QARGS); }
                else if constexpr (ATT_PIPE_C) att::attn_unit2<6, false, 1, true>(J, shm, ATT_QARGS); else att::attn_unit<6, 1, false, 1, true, (ATT_SMAX_C != 0), 0, (ATT_STAG_C != 0)>(J, shm, ATT_QARGS);
                ran_ = true;
            }
        } else {
            const int i = u < 196 ? u : u - 784; const int h = 3 - i / 196, ii = i % 196; int qb, b_, ck;
            if (ii < 68) { ck = 0; qb = 31 - (ii >> 2); b_ = ii & 3; } else { const int j = ii - 68, g = j >> 3, r = j & 7; if (r < 4) { ck = 1; qb = 31 - g; b_ = r; } else { ck = 0; qb = 14 - g; b_ = r - 4; } }
            if (qb >= 0) {
                const int nt = 4 * qb + 4; const long rb = (long)b_ * S;
                att::Job J; J.Q = qkv + rb * NQKV + C_QA + h * 64; J.qs = NQKV; J.K0 = qkv + rb * NQKV + C_KA + h * 64; J.ks0 = NQKV; J.K1 = nullptr; J.ks1 = 0;
                J.V = qkv + rb * NQKV + C_VA + h * 64; J.vs = NQKV; J.O = pa + (size_t)ck * T * 256 + rb * 256 + h * 64; J.os = 256; J.omap = (long)2 * T * 256;
                J.LSE = la + (size_t)ck * T * 4 + rb * 4 + h; J.ls = 4; J.lmap = (long)2 * T * 4;
                J.q0 = qb * 256; J.t_lo = ck ? 0 : (nt > 64 ? nt - 64 : 0); J.t_hi = ck ? nt - 64 : nt; J.max_dist = BIG; J.slope2 = exp2f(-(2.f / 3.f) * (float)(3 * h + 1)) * LOG2E; J.sink2 = 0.f; J.rope = nullptr;
                J.kmax2[0] = __uint_as_float(__builtin_amdgcn_readfirstlane(F.MISC[32 + b_ * 8 + h * 2])); J.kmax2[1] = __uint_as_float(__builtin_amdgcn_readfirstlane(F.MISC[32 + b_ * 8 + h * 2 + 1]));
                att::attn_unit<2, 2, true, 1, false, true>(J, shm, ATT_QARGS); ran_ = true;
            }
        }
    });
    __syncthreads();
    {
        char* wl = shm + F.wave * att::BW_LDS; float* wsfb = (float*)((char*)F.lds + MISC_OFF + 1024) + F.wave * 64;
#ifndef BAND_SHARED
#define BAND_SHARED 1
#endif
#ifndef PROBE_BAND
#define PROBE_BAND 1
#endif
      for (int pass = 0; pass < PROBE_BAND; ++pass) {
        gu32* bq = heads + (2 + pass) * 64;
        int u = q_first(F, bq); int par_ = 0;
        unsigned pend_ = 0; if (BAND_SHARED && F.tid == 0) pend_ = __hip_atomic_fetch_add(bq, 1u, RLX_AGENT);
        while (u < 2048) {
            unsigned un_ = 0; if (!BAND_SHARED && F.tid == 0) un_ = __hip_atomic_fetch_add(bq, 1u, RLX_AGENT);
            const int ws_ = F.wave;
            att::Job J; J.K1 = nullptr; J.ks1 = 0; J.omap = 0; J.lmap = 0; J.rope = nullptr; J.kmax2[0] = 0.f; J.kmax2[1] = 0.f; J.t_lo = 0; J.t_hi = 0;
            if (u < 512) {
                const int qb = u >> 4, bh = u & 15, b_ = bh >> 2, h = bh & 3, g = h >> 1; const long rb = (long)b_ * S;
                J.Q = qkv + rb * NQKV + C_QD + h * 64; J.qs = NQKV; J.K0 = qkv + rb * NQKV + C_KD + g * 64; J.ks0 = NQKV; J.V = qkv + rb * NQKV + C_VD + g * 64; J.vs = NQKV;
                J.O = o + rb * D + 768 + h * 64; J.os = D; J.LSE = nullptr; J.ls = 0; J.q0 = qb * 256; J.max_dist = 127; J.slope2 = exp2f(-2.f * (float)(h + 1)) * LOG2E;
                J.sink2 = __builtin_bit_cast(float, __builtin_amdgcn_readfirstlane(__builtin_bit_cast(int, gin(10)[layer * 4 + h]))) * LOG2E;
                if (BAND_SHARED) att::band_unit<3>(J, shm, wsfb, ws_, pend_, (unsigned*)bq, F.MISC + 26 + par_); else att::band_wave<3>(J, wl, wsfb, ws_, un_, F.MISC + 26 + par_);
            } else {
                const int v = u - 512, pat = v >> 9, w2 = v & 511, bh = w2 & 15, b_ = bh >> 2, h = bh & 3, w = w2 >> 4;
                const int dsh = 2 * pat, d = 1 << dsh; const int nblk = 32 >> dsh, cls = w / nblk, qb = w % nblk; const long rb = (long)b_ * S + cls;
                J.Q = qkv + rb * NQKV + C_QB + h * 64; J.qs = NQKV * d; J.K0 = qkv + rb * NQKV + C_KB + h * 64; J.ks0 = NQKV * d; J.V = qkv + rb * NQKV + C_VB + h * 64; J.vs = NQKV * d;
                J.O = ob + (size_t)pat * T * 256 + rb * 256 + h * 64; J.os = 256 * d; J.LSE = lse + (size_t)pat * T * 4 + rb * 4 + h; J.ls = 4 * d;
                J.q0 = qb * 256; J.max_dist = 128; J.slope2 = exp2f(-(2.f / 3.f) * (float)(3 * h + 2)) * (float)d * LOG2E; J.sink2 = 0.f;
                if (BAND_SHARED) att::band_unit<1>(J, shm, wsfb, ws_, pend_, (unsigned*)bq, F.MISC + 26 + par_); else att::band_wave<1>(J, wl, wsfb, ws_, un_, F.MISC + 26 + par_);
            }
            asm volatile("s_waitcnt lgkmcnt(0)\n\ts_barrier" ::: "memory"); u = __builtin_amdgcn_readfirstlane((int)F.MISC[26 + par_]); par_ ^= 1;
        }
      }
    }
}

constexpr int G1_DEFER = 5;
struct SkipColOrder { pg8::StaticOrder s;
    __device__ __forceinline__ bool next(int i, pg8::Unit& u) const { if (!s.next(i, u)) return false; if (u.pn >= G1_DEFER) ++u.pn; return true; } };
struct OneTileOrder { int pm, pn;
    __device__ __forceinline__ bool next(int i, pg8::Unit& u) const { if (pm < 0 || i >= 1) return false; u.pm = pm; u.pa = pm; u.pn = pn; return true; } };

struct MoeUpOrder { int rbl, e, pn0, cnt;
    __device__ __forceinline__ bool next(int i, pg8::Unit& u) const { if (rbl < 0 || i >= cnt) return false; u.pm = rbl; u.pa = 0; u.pn = e * 28 + pn0 + i; return true; } };
struct MoeDownOrder { int rbl, e, pn0;
    __device__ __forceinline__ bool next(int i, pg8::Unit& u) const { if (rbl < 0 || i >= 1) return false; u.pm = rbl; u.pa = rbl; u.pn = e * 4 + pn0; return true; } };

__device__ __forceinline__ Frame fresh(const Frame& F) { Frame P = F; int lane_; asm volatile("v_mbcnt_lo_u32_b32 %0, -1, 0\n\tv_mbcnt_hi_u32_b32 %0, -1, %0" : "=v"(lane_) :: "memory"); asm volatile("" : "+s"(P.wave), "+s"(P.bx), "+s"(P.G));
    P.lane = lane_; P.tid = P.wave * 64 + lane_; P.vcu = (P.bx % 8) * (P.G / 8) + P.bx / 8; return P; }
#ifndef WGM_G4
#define WGM_G4 6
#endif
#ifndef WGM_G1
#define WGM_G1 8
#endif
#ifndef REP_P0
#define REP_P0 1
#endif
#ifndef REP_G1
#define REP_G1 1
#endif
#ifndef REP_G2
#define REP_G2 1
#endif
#ifndef REP_AT
#define REP_AT 1
#endif
#ifndef REP_CB
#define REP_CB 1
#endif
#ifndef REP_G4
#define REP_G4 1
#endif
#ifndef REP_N1
#define REP_N1 1
#endif
#ifndef REP_MW
#define REP_MW 1
#endif
#ifndef REP_G6
#define REP_G6 1
#endif
#ifndef REP_G7
#define REP_G7 1
#endif
#ifndef REP_R2
#define REP_R2 1
#endif
struct Args { const float* in[20]; float* out; unsigned char* ws; int ph_lo, ph_hi, li, pad; };
__global__ void __launch_bounds__(NWAVES * 64, 2) fwd(Args args) {
    extern __shared__ __attribute__((aligned(16))) unsigned char lds[];
    Frame F0;
    F0.lds = (LAS unsigned char*)lds;
    F0.MISC = (volatile LAS unsigned*)(F0.lds + MISC_OFF);
    F0.tid = 0; F0.lane = 0; F0.wave = __builtin_amdgcn_readfirstlane((int)threadIdx.x >> 6);
    F0.G = gridDim.x; F0.bx = blockIdx.x; F0.vcu = 0;
    for (int u = threadIdx.x; u < (LDS_BYTES - LDSCTL_OFF) / 4; u += NWAVES * 64) ((LAS unsigned*)(F0.lds + LDSCTL_OFF))[u] = 0u;
    __syncthreads();
#define KA_LO (*(const int CAS*)(kargs() + 176))
#define KA_HI (*(const int CAS*)(kargs() + 180))
#define KA_LI (*(const int CAS*)(kargs() + 184))
#define MK_BAR() XcdBarrier bar; bar.bar = (unsigned*)(gctl() + CW_BAR) + KA_LI * XCD_BAR_WORDS; bar.x = xb_xcc_id(); bar.st = (volatile LAS unsigned*)((LAS unsigned char*)lds + MISC_OFF) + 8
    if (!MK_PER_PHASE) { MK_BAR(); (void)xcd_barrier_post(bar.bar, bar.st); }
    int ph = 0;
#define PH_ON() (ph >= KA_LO && ph < KA_HI)
#define PH_END() do { if (PH_ON() && ph + 1 < KA_HI) { if (MK_PER_PHASE) { if (threadIdx.x == 0) __hip_atomic_store(gctl() + CW_TMO, 0xBADBA0u, RLX_AGENT); } else { MK_BAR(); xcd_barrier(bar); } } ++ph; } while (0)
#define ws gws()
#define R1 ((bf16*)(gws() + WS_R1))
#define QKV ((bf16*)(gws() + WS_QKV))

    if (PH_ON()) for (int rep = 0; rep < REP_P0; ++rep) { Frame F = fresh(F0); p0_prologue(F); }
    PH_END();
#ifndef PROBE_NBAR
#define PROBE_NBAR 0
#endif
    for (int xb_ = 0; xb_ < PROBE_NBAR; ++xb_) { MK_BAR(); xcd_barrier(bar); }
    for (int l = 0; l < 2; ++l) {
        if (PH_ON()) for (int rep = 0; rep < REP_G1; ++rep) { Frame F = fresh(F0); pg8::Gemm g{R1, (const bf16*)(ws + WS_WIN + l * WIN_L), D, D, nullptr}; SkipColOrder So; So.s.init(T, NQKVP - 256, F.G, F.bx, WGM_G1);
            pg8::EpiBf16Q E{QKV, NQKV, NQKV, l == 1 ? (const float*)(ws + WS_SSQ) : nullptr, (float*)(ws + WS_SSQ2)}; pg8::gemm_phase<pg8::EpiBf16Q, SkipColOrder>(F.lds + RING_OFF, g, So, E, F.wave); }
        PH_END();
        if (PH_ON()) for (int rep = 0; rep < REP_G2; ++rep) { Frame F = fresh(F0); const int half = F.G / 2;
            if (rep == 0) mla_prep(F, l);
            { pg8::Gemm g{QKV + C_CKV, (const bf16*)(ws + WS_WUKV + l * WUKV_L), 128, NQKV, nullptr}; pg8::StaticOrder So; So.init(T, 512, F.G, F.bx);
              pg8::EpiBf16K E{(bf16*)(ws + WS_KVM), (unsigned*)gctl() + CW_KMAXC + l * 32, (const float*)(ws + WS_SSQ2)}; pg8::gemm_phase<pg8::EpiBf16K, pg8::StaticOrder>(F.lds + RING_OFF, g, So, E, F.wave); }
            if (F.bx < half) {
              pg8::Gemm g{QKV + C_CQ, (const bf16*)(ws + WS_WUQ + l * WUQ_L), 384, NQKV, nullptr}; pg8::StaticOrder So; So.init(T, 512, half, F.bx);
              pg8::EpiBf16R E{(bf16*)(ws + WS_QM), (const float*)(ws + WS_SSQ2)}; pg8::gemm_phase<pg8::EpiBf16R, pg8::StaticOrder>(F.lds + RING_OFF, g, So, E, F.wave);
            } else {
              pg8::Gemm g{R1, (const bf16*)(ws + WS_WIN + l * WIN_L), D, D, nullptr}; OneTileOrder So; So.pm = F.bx - half < T / 256 ? F.bx - half : -1; So.pn = G1_DEFER;
              pg8::EpiBf16 E{QKV, NQKV, NQKV, 0, 1.0f, l == 1 ? (const float*)(ws + WS_SSQ) : nullptr}; pg8::gemm_phase<pg8::EpiBf16, OneTileOrder>(F.lds + RING_OFF, g, So, E, F.wave); }
        }
        PH_END();
        if (PH_ON()) for (int rep = 0; rep < REP_AT; ++rep) { Frame F = fresh(F0); attn_phase(F, l, rep); }
        PH_END();
        if (PH_ON()) for (int rep = 0; rep < REP_CB; ++rep) { Frame F = fresh(F0); attn_combine(F, l); }
        PH_END();
        if (PH_ON()) { Frame F = fresh(F0); pg8::Gemm g{R1, (const bf16*)(ws + WS_WOUT + l * WOUT_L), D, D, nullptr}; pg8::StaticOrder So; So.init(T, D, F.G, F.bx);
            pg8::EpiResid E{l == 0 ? gin(0) : (const float*)gout(), gout(), D, l == 0 ? (bf16*)(ws + WS_XB) : nullptr, l == 0 ? (float*)(ws + WS_SSQ) : nullptr, 1.0f, (FFN8 == 1 || FFN8 == 2)}; pg8::gemm_phase<pg8::EpiResid, pg8::StaticOrder>(F.lds + RING_OFF, g, So, E, F.wave); }
        PH_END();
        if (l == 1) {
        if (PH_ON()) { Frame F = fresh(F0); norm2_router(F, l, true); for (int rep = 0; rep < REP_MW; ++rep) moe_weights(F);
            __syncthreads(); hist_wait(F); route_assign(F); }
        PH_END();
        }
        if (l == 0) {
            if (PH_ON()) for (int rep = 0; rep < REP_G4; ++rep) { Frame F = fresh(F0); pg8::StaticOrder So; So.init(T, 2 * FF, F.G, F.bx, WGM_G4);
#if FFN8 == 1 || FFN8 == 2
                pg8::Gemm g{(const bf16*)(ws + WS_XB), (const bf16*)(ws + WS_W13), D / 2, D / 2, nullptr};
#if FFN8 == 1
                pg8::EpiSwiglu8 E{(void*)(ws + WS_G), FF, 22, 1.0f / MOE_WSCALE, (const float*)(ws + WS_SSQ)}; pg8::gemm_phase<pg8::EpiSwiglu8, pg8::StaticOrder, false, true>(F.lds + RING_OFF, g, So, E, F.wave); }
#else
                pg8::EpiSwiglu E{(void*)(ws + WS_G), FF, 22, 1.0f / MOE_WSCALE, (const float*)(ws + WS_SSQ)}; pg8::gemm_phase<pg8::EpiSwiglu, pg8::StaticOrder, false, true>(F.lds + RING_OFF, g, So, E, F.wave); }
#endif
#else
                pg8::Gemm g{(const bf16*)(ws + WS_XB), (const bf16*)(ws + WS_W13), D, D, nullptr};
#if FFN8 == 3
                pg8::EpiSwiglu8 E{(void*)(ws + WS_G), FF, 22, 1.0f, (const float*)(ws + WS_SSQ)}; pg8::gemm_phase<pg8::EpiSwiglu8, pg8::StaticOrder>(F.lds + RING_OFF, g, So, E, F.wave); }
#else
                pg8::EpiSwiglu E{(void*)(ws + WS_G), FF, 22, 1.0f, (const float*)(ws + WS_SSQ)}; pg8::gemm_phase<pg8::EpiSwiglu, pg8::StaticOrder>(F.lds + RING_OFF, g, So, E, F.wave); }
#endif
#endif
            PH_END();
            if (PH_ON()) { Frame F = fresh(F0); pg8::StaticOrder So; So.init(T, D, F.G, F.bx);
#if FFN8 == 1 || FFN8 == 3
                pg8::Gemm g{(const bf16*)(ws + WS_G), (const bf16*)(ws + WS_W2), FF / 2, FF / 2, nullptr};
                pg8::EpiResid E{(const float*)gout(), gout(), D, R1, (float*)(ws + WS_SSQ), 1.0f / MOE_WSCALE, false}; pg8::gemm_phase<pg8::EpiResid, pg8::StaticOrder, false, true>(F.lds + RING_OFF, g, So, E, F.wave); }
#else
                pg8::Gemm g{(const bf16*)(ws + WS_G), (const bf16*)(ws + WS_W2), FF, FF, nullptr};
                pg8::EpiResid E{(const float*)gout(), gout(), D, R1, (float*)(ws + WS_SSQ)}; pg8::gemm_phase<pg8::EpiResid, pg8::StaticOrder>(F.lds + RING_OFF, g, So, E, F.wave); }
#endif
            PH_END();
        } else {
            const int* blk = (const int*)(ws + WS_RT + RT_BLK); const int* tokv = (const int*)(ws + WS_RT + RT_TOK);
            for (int p = 0; p < 6; ++p) {
                if (PH_ON()) {
                    if (p >= 1) for (int rep = 0; rep < REP_G7; ++rep) { Frame F = fresh(F0); const int q = p - 1; const int nblk = __builtin_amdgcn_readfirstlane(blk[272]); const int nrem4 = nblk > 256 ? (nblk - 256) * 4 : 0;
                        const bool rem = (q == 4);
                        const int rb = rem ? 256 + (F.bx >> 2) : q * 64 + (F.vcu >> 2); MoeDownOrder So; So.rbl = rb < nblk ? (rem ? (F.bx >> 2) : (F.vcu >> 2)) : -1; So.e = rb < nblk ? __builtin_amdgcn_readfirstlane(blk[rb]) : 0; So.pn0 = rem ? (F.bx & 3) : (F.vcu & 3);
                        if (!rem || F.bx < nrem4) {
                            pg8::Gemm g{(const bf16*)(ws + WS_GM + (size_t)(q & 1) * GM_L), (const bf16*)(ws + WS_MW2), FE / 2, FE / 2, nullptr};
                            pg8::EpiBf16 E{(bf16*)(ws + WS_Y) + (size_t)q * 64 * 256 * D, D, D, 4, 1.0f / MOE_WSCALE}; pg8::gemm_phase<pg8::EpiBf16, MoeDownOrder, false, true>(F.lds + RING_OFF, g, So, E, F.wave); }
                        else final_combine(F, 0, nrem4); }
                    if (p <= 4) for (int rep = 0; rep < REP_G6; ++rep) { Frame F = fresh(F0); const int nblk = __builtin_amdgcn_readfirstlane(blk[272]);
                        const bool rem6 = (p == 4); const int lb = rem6 ? F.vcu / 28 : (F.vcu >> 2);
                        const int rb = p * 64 + lb; MoeUpOrder So; So.rbl = rb < nblk ? lb : -1; So.e = rb < nblk ? __builtin_amdgcn_readfirstlane(blk[rb]) : 0; So.pn0 = rem6 ? F.vcu % 28 : (F.vcu & 3) * 7; So.cnt = rem6 ? 1 : 7;
                        pg8::Gemm g{R1, (const bf16*)(ws + WS_MW13), D / 2, D / 2, tokv + (rb < nblk ? rb : 0) * 256};
                        pg8::EpiSwiglu8 E{(void*)(ws + WS_GM + (size_t)(p & 1) * GM_L), FE, 28, 1.0f / MOE_WSCALE}; pg8::gemm_phase<pg8::EpiSwiglu8, MoeUpOrder, true, true>(F.lds + RING_OFF, g, So, E, F.wave); }
                }
                PH_END();
            }
            if (PH_ON()) { Frame F = fresh(F0); final_combine(F, 1, 0); }
            PH_END();
        }
    }
#undef PH_ON
#undef PH_END
#undef ws
#undef R1
#undef QKV
}
static_assert(sizeof(Args) == 192 && offsetof(Args, out) == 160 && offsetof(Args, ws) == 168 && offsetof(Args, ph_lo) == 176 && offsetof(Args, ph_hi) == 180 && offsetof(Args, li) == 184, "kernarg offsets");
constexpr int N_PHASES = 1 + (5 + 2) + (5 + 1 + 6 + 1);

extern "C" void kernel_launch(void* const* d_in, const int* in_sizes, int n_in, void* d_out, int out_size, void* d_ws, size_t ws_size, hipStream_t stream) {
    static int grid = 0;
    if (grid == 0) {
        if (n_in != 20 || in_sizes[0] != T * D || out_size != T * D || ws_size < WS_END) { fprintf(stderr, "kernel_launch: unexpected shapes (n_in %d, in0 %d, out %d, ws %zu < %zu); nothing launched\n", n_in, n_in > 0 ? in_sizes[0] : -1, out_size, ws_size, (size_t)WS_END); grid = -1; return; }
        int dev = 0, cus = 0, per_cu = 0;
        if (hipGetDevice(&dev) != hipSuccess || hipDeviceGetAttribute(&cus, hipDeviceAttributeMultiprocessorCount, dev) != hipSuccess) { grid = -1; return; }
        if (hipFuncSetAttribute((const void*)fwd, hipFuncAttributeMaxDynamicSharedMemorySize, LDS_BYTES) != hipSuccess) { fprintf(stderr, "kernel_launch: hipFuncSetAttribute failed\n"); grid = -1; return; }
        if (hipOccupancyMaxActiveBlocksPerMultiprocessor(&per_cu, (const void*)fwd, NWAVES * 64, LDS_BYTES) != hipSuccess || per_cu < 1) { fprintf(stderr, "kernel_launch: occupancy query reports %d workgroups per CU\n", per_cu); }
        (void)hipGetLastError();
        if (cus < 256) { fprintf(stderr, "kernel_launch: %d CUs < 256: the 256-workgroup grid would not be resident; nothing launched\n", cus); grid = -1; return; }
        grid = 256;
    }
    if (grid < 0) return;
    if (hipMemsetAsync((char*)d_ws + WS_CTL, 0, CTL_ZERO_BYTES, stream) != hipSuccess) return;
    Args a{};
    for (int i = 0; i < 20; ++i) a.in[i] = (const float*)d_in[i];
    a.out = (float*)d_out; a.ws = (unsigned char*)d_ws; a.pad = 0;
#if MK_PER_PHASE
    for (int li = 0; li < N_PHASES; ++li) { a.ph_lo = li; a.ph_hi = li + 1; a.li = 0; hipLaunchKernelGGL(fwd, dim3(grid), dim3(NWAVES * 64), LDS_BYTES, stream, a); }
#else
#ifndef DBG_PH_HI
#define DBG_PH_HI N_PHASES
#endif
    a.ph_lo = 0; a.ph_hi = DBG_PH_HI; a.li = 0;
    hipLaunchKernelGGL(fwd, dim3(grid), dim3(NWAVES * 64), LDS_BYTES, stream, a);
#endif
    const hipError_t le = hipPeekAtLastError();
    if (le != hipSuccess) fprintf(stderr, "kernel_launch: launch failed: %s\n", hipGetErrorName(le));
}
```
